# Optimizing an MI355X kernel written in HIP

```python
import math
import jax, jax.numpy as jnp
from jax import lax
import numpy as np

D_MODEL = 1024
BATCH = 8
SEQ = 2048
DEPTH = 1

HEAD_DIM = 64
MIX_WIDTH = D_MODEL
SG_WIDTH = MIX_WIDTH // 2
FOX_WIDTH = MIX_WIDTH - SG_WIDTH
SG_HEADS = SG_WIDTH // HEAD_DIM
FOX_HEADS = FOX_WIDTH // HEAD_DIM
CHUNK = 128
Q_BLOCK = 128
IN_COLS = 2 * SG_WIDTH + 3 * FOX_WIDTH + FOX_HEADS
PEER_HEADS = 8
N_KEYS = 128
N_EXPERTS = N_KEYS * N_KEYS
PEER_TOPK = 16
D_KEY = 256
D_HALF = D_KEY // 2
TOKEN_BLOCK = 128
EPS = 1e-6

kernel_name = "hybrid_sgu_fox_peer_adaln"


def rms_norm(x, g):
    xf = x.astype(jnp.float32)
    y = xf * lax.rsqrt(jnp.mean(xf * xf, axis=-1, keepdims=True) + EPS)
    return (y * g.astype(jnp.float32)).astype(x.dtype)


def head_rms_norm(x, g, n_heads):
    b, s, w = x.shape
    xf = x.astype(jnp.float32).reshape(b, s, n_heads, w // n_heads)
    y = xf * lax.rsqrt(jnp.mean(xf * xf, axis=-1, keepdims=True) + EPS)
    return (y.reshape(b, s, w) * g.astype(jnp.float32)).astype(x.dtype)


def modulate(h, shift, scale):
    return h * (1.0 + scale[:, None, :]) + shift[:, None, :]


def spatial_gating(z_u, z_v, ln_g, ln_b, w_s, b_s):
    b, s, _ = z_v.shape
    vf = z_v.astype(jnp.float32).reshape(b, s, SG_HEADS, HEAD_DIM)
    mu = jnp.mean(vf, axis=-1, keepdims=True)
    var = jnp.mean(jnp.square(vf - mu), axis=-1, keepdims=True)
    vn = (vf - mu) * lax.rsqrt(var + EPS)
    vn = vn * ln_g.astype(jnp.float32).reshape(SG_HEADS, HEAD_DIM) + ln_b.astype(jnp.float32).reshape(SG_HEADS, HEAD_DIM)
    vn = vn.astype(z_v.dtype).reshape(b, s // CHUNK, CHUNK, SG_HEADS, HEAD_DIM)
    causal = jnp.tril(jnp.ones((CHUNK, CHUNK), dtype=w_s.dtype))
    w = w_s * causal[None]
    mixed = jnp.einsum('hts,bcshd->bcthd', w, vn)
    mixed = mixed + jnp.transpose(b_s)[None, None, :, :, None]
    return z_u * mixed.reshape(b, s, SG_WIDTH)


def forgetting_attention(q, k, v, f_logit):
    b, s, h, dh = q.shape
    nb = s // Q_BLOCK
    cum = jnp.cumsum(jax.nn.log_sigmoid(f_logit.astype(jnp.float32)), axis=1)
    cum_k = jnp.transpose(cum, (0, 2, 1))
    q_blocks = q.reshape(b, nb, Q_BLOCK, h, dh).transpose(1, 0, 2, 3, 4)
    cum_q = cum.reshape(b, nb, Q_BLOCK, h).transpose(1, 0, 3, 2)
    k_pos = jnp.arange(s)
    scale = HEAD_DIM ** -0.5

    def one_block(args):
        qi, cqi, i = args
        logits = jnp.einsum('bqhd,bkhd->bhqk', qi, k).astype(jnp.float32) * scale
        logits = logits + cqi[..., :, None] - cum_k[:, :, None, :]
        q_pos = i * Q_BLOCK + jnp.arange(Q_BLOCK)
        mask = k_pos[None, :] <= q_pos[:, None]
        logits = jnp.where(mask[None, None], logits, -jnp.inf)
        p = jax.nn.softmax(logits, axis=-1).astype(v.dtype)
        return jnp.einsum('bhqk,bkhd->bqhd', p, v)

    out = lax.map(one_block, (q_blocks, cum_q, jnp.arange(nb)))
    return out.transpose(1, 0, 2, 3, 4).reshape(b, s, h * dh)


def token_mixer(h, w_in, b_f, sg_ln_g, sg_ln_b, sg_w, sg_b, out_g_sg, out_g_fox, w_out):
    b, s, _ = h.shape
    proj = h @ w_in
    c0 = SG_WIDTH
    c1 = 2 * SG_WIDTH
    c2 = c1 + FOX_WIDTH
    c3 = c2 + FOX_WIDTH
    c4 = c3 + FOX_WIDTH
    z_u = jax.nn.gelu(proj[..., :c0], approximate=False)
    z_v = jax.nn.gelu(proj[..., c0:c1], approximate=False)
    q = proj[..., c1:c2].reshape(b, s, FOX_HEADS, HEAD_DIM)
    k = proj[..., c2:c3].reshape(b, s, FOX_HEADS, HEAD_DIM)
    v = proj[..., c3:c4].reshape(b, s, FOX_HEADS, HEAD_DIM)
    f_logit = proj[..., c4:] + b_f
    y_sg = spatial_gating(z_u, z_v, sg_ln_g, sg_ln_b, sg_w, sg_b)
    y_fox = forgetting_attention(q, k, v, f_logit)
    y = jnp.concatenate([head_rms_norm(y_sg, out_g_sg, SG_HEADS),
                         head_rms_norm(y_fox, out_g_fox, FOX_HEADS)], axis=-1)
    return y @ w_out


def peer_ffn(h, w_query, sub_keys, expert_u, expert_v):
    b, s, d = h.shape
    t = b * s
    xt = h.reshape(t, d)
    q = (xt @ w_query).reshape(t, PEER_HEADS, 2, D_HALF)
    scores = jnp.einsum('thpd,hpnd->thpn', q, sub_keys).astype(jnp.float32)
    sv, si = lax.top_k(scores, PEER_TOPK)
    cand_s = (sv[:, :, 0, :, None] + sv[:, :, 1, None, :]).reshape(t, PEER_HEADS, PEER_TOPK * PEER_TOPK)
    cand_i = (si[:, :, 0, :, None] * N_KEYS + si[:, :, 1, None, :]).reshape(t, PEER_HEADS, PEER_TOPK * PEER_TOPK)
    top_s, pos = lax.top_k(cand_s, PEER_TOPK)
    idx = jnp.take_along_axis(cand_i, pos, axis=-1)
    gate = jax.nn.softmax(top_s, axis=-1).astype(h.dtype)
    nblk = t // TOKEN_BLOCK
    n_sel = PEER_HEADS * PEER_TOPK
    x_blocks = xt.reshape(nblk, TOKEN_BLOCK, d)
    idx_blocks = idx.reshape(nblk, TOKEN_BLOCK, n_sel)
    gate_blocks = gate.reshape(nblk, TOKEN_BLOCK, n_sel)

    def one_block(args):
        xi, ii, gi = args
        u = jnp.take(expert_u, ii, axis=0)
        a = jnp.einsum('ted,td->te', u, xi)
        w = gi * jax.nn.gelu(a, approximate=False)
        vv = jnp.take(expert_v, ii, axis=0)
        return jnp.einsum('te,ted->td', w, vv)

    out = lax.map(one_block, (x_blocks, idx_blocks, gate_blocks))
    return out.reshape(b, s, d)


def setup_inputs(seed: int = 0) -> dict:
    key = jax.random.key(seed)
    ks = jax.random.split(key, 24)
    f32 = jnp.float32
    D = D_MODEL

    def nrm(k, shape, scale):
        return jax.random.normal(k, shape, f32) * scale

    x = jax.random.normal(ks[0], (BATCH, SEQ, D), f32)
    c = jax.random.normal(ks[1], (BATCH, D), f32)
    w_ada = nrm(ks[2], (DEPTH, D, 6 * D), 0.5 * D ** -0.5)
    b_ada = nrm(ks[3], (DEPTH, 6 * D), 0.02)
    norm1_g = 1.0 + nrm(ks[4], (DEPTH, D), 0.02)
    w_in = nrm(ks[5], (DEPTH, D, IN_COLS), D ** -0.5)
    b_f = jax.random.uniform(ks[6], (DEPTH, FOX_HEADS), f32, minval=1.0, maxval=5.0)
    sg_ln_g = 1.0 + nrm(ks[7], (DEPTH, SG_WIDTH), 0.02)
    sg_ln_b = nrm(ks[8], (DEPTH, SG_WIDTH), 0.02)
    sg_w = nrm(ks[9], (DEPTH, SG_HEADS, CHUNK, CHUNK), CHUNK ** -0.5)
    sg_b = 1.0 + nrm(ks[10], (DEPTH, SG_HEADS, CHUNK), 0.1)
    out_g_sg = 1.0 + nrm(ks[11], (DEPTH, SG_WIDTH), 0.02)
    out_g_fox = 1.0 + nrm(ks[12], (DEPTH, FOX_WIDTH), 0.02)
    w_out = nrm(ks[13], (DEPTH, MIX_WIDTH, D), MIX_WIDTH ** -0.5)
    norm2_g = 1.0 + nrm(ks[14], (DEPTH, D), 0.02)
    w_query = nrm(ks[15], (DEPTH, D, PEER_HEADS * D_KEY), D ** -0.5)
    sub_keys = nrm(ks[16], (DEPTH, PEER_HEADS, 2, N_KEYS, D_HALF), D_HALF ** -0.5)
    expert_u = nrm(ks[17], (DEPTH, N_EXPERTS, D), D ** -0.5)
    expert_v = nrm(ks[18], (DEPTH, N_EXPERTS, D), PEER_HEADS ** -0.5)
    final_g = 1.0 + nrm(ks[19], (D,), 0.02)
    return {"x": x, "c": c, "w_ada": w_ada, "b_ada": b_ada, "norm1_g": norm1_g,
            "w_in": w_in, "b_f": b_f, "sg_ln_g": sg_ln_g, "sg_ln_b": sg_ln_b,
            "sg_w": sg_w, "sg_b": sg_b, "out_g_sg": out_g_sg, "out_g_fox": out_g_fox,
            "w_out": w_out, "norm2_g": norm2_g, "w_query": w_query, "sub_keys": sub_keys,
            "expert_u": expert_u, "expert_v": expert_v, "final_g": final_g}


def reference(x, c, w_ada, b_ada, norm1_g, w_in, b_f, sg_ln_g, sg_ln_b, sg_w, sg_b,
              out_g_sg, out_g_fox, w_out, norm2_g, w_query, sub_keys, expert_u, expert_v,
              final_g):
    c_act = jax.nn.silu(c)
    for l in range(DEPTH):
        ada = c_act @ w_ada[l] + b_ada[l]
        shift1, scale1, gate1, shift2, scale2, gate2 = jnp.split(ada, 6, axis=-1)
        h = modulate(rms_norm(x, norm1_g[l]), shift1, scale1)
        mix = token_mixer(h, w_in[l], b_f[l], sg_ln_g[l], sg_ln_b[l], sg_w[l], sg_b[l],
                          out_g_sg[l], out_g_fox[l], w_out[l])
        x = x + gate1[:, None, :] * mix
        h = modulate(rms_norm(x, norm2_g[l]), shift2, scale2)
        ffn = peer_ffn(h, w_query[l], sub_keys[l], expert_u[l], expert_v[l])
        x = x + gate2[:, None, :] * ffn
    return rms_norm(x, final_g)
```

```cpp
#include <hip/hip_runtime.h>
#include <cstdint>
#include <cstdio>
#include <cmath>

constexpr int DM = 1024, NB = 8, SEQ = 2048, NT = NB * SEQ;
constexpr int HD = 64, SGW = 512, FOXW = 512, NH = 8, CHUNK = 128;
constexpr int INC = 2 * SGW + 3 * FOXW + NH;
constexpr int PH = 8, NKEYS = 128, NEXP = NKEYS * NKEYS, TOPK = 16, DKEY = 256, DHALF = 128;
constexpr float EPS = 1e-6f;
constexpr int NTHR = 512, NWAVE = 8;

constexpr size_t MiB = 1u << 20;
constexpr size_t WS_ADA = 0;
constexpr size_t WS_FL = 1 * MiB;
constexpr size_t WS_H = 2 * MiB;
constexpr size_t WS_ZU = WS_H + 64 * MiB;
constexpr size_t WS_ZV = WS_ZU + 32 * MiB, WS_Q = WS_ZV + 32 * MiB, WS_K = WS_Q + 32 * MiB, WS_V = WS_K + 32 * MiB;
constexpr size_t WS_IDX = WS_V + 32 * MiB;
constexpr size_t WS_GATE = WS_IDX + 8 * MiB;
constexpr size_t WS_END = WS_GATE + 8 * MiB;

struct Args {
    const float *x, *c, *w_ada, *b_ada, *norm1_g, *w_in, *b_f, *sg_ln_g, *sg_ln_b, *sg_w, *sg_b, *out_g_sg, *out_g_fox,
        *w_out, *norm2_g, *w_query, *sub_keys, *expert_u, *expert_v, *final_g;
    float* out; unsigned char* ws; int ph_lo, ph_hi;
};

#define WAVE_LDS_FENCE() do { __builtin_amdgcn_fence(__ATOMIC_ACQ_REL, "wavefront"); __builtin_amdgcn_wave_barrier(); } while (0)
__device__ __forceinline__ float wave_sum(float v) {
#pragma unroll
    for (int o = 1; o < 64; o <<= 1) v += __shfl_xor(v, o);
    return v;
}
__device__ __forceinline__ float wave_max(float v) {
#pragma unroll
    for (int o = 1; o < 64; o <<= 1) v = fmaxf(v, __shfl_xor(v, o));
    return v;
}
__device__ __forceinline__ float gelu_exact(float v) { return 0.5f * v * (1.0f + erff(v * 0.70710678118654752f)); }
__device__ __forceinline__ float log_sigmoid(float v) { return fminf(v, 0.f) - log1pf(expf(-fabsf(v))); }

template <class Epi>
__device__ __forceinline__ void gemm_naive(float* lds, const float* A, const float* Bm, int M, int N, int K, const Epi& E) {
    float* As = lds;
    float* Bs = lds + 16 * 132;
    const int tid = threadIdx.x, ty = tid >> 4, tx = tid & 15;
    const int ntn = (N + 127) / 128, ntm = M / 128;
    for (int tile = blockIdx.x; tile < ntn * ntm; tile += gridDim.x) {
        const int tm = tile / ntn, tn = tile % ntn, m0 = tm * 128, n0 = tn * 128;
        float acc[4][8];
#pragma unroll
        for (int i = 0; i < 4; ++i)
#pragma unroll
            for (int j = 0; j < 8; ++j) acc[i][j] = 0.f;
        for (int k0 = 0; k0 < K; k0 += 16) {
            {
                const int r = tid >> 2, k4 = (tid & 3) * 4;
                const float4 a = *(const float4*)(A + (size_t)(m0 + r) * K + k0 + k4);
                As[(k4 + 0) * 132 + r] = a.x; As[(k4 + 1) * 132 + r] = a.y; As[(k4 + 2) * 132 + r] = a.z; As[(k4 + 3) * 132 + r] = a.w;
                const int kk = tid >> 5, n4 = (tid & 31) * 4;
                float4 b = make_float4(0.f, 0.f, 0.f, 0.f);
                if (n0 + n4 < N) b = *(const float4*)(Bm + (size_t)(k0 + kk) * N + n0 + n4);
                *(float4*)(Bs + kk * 132 + n4) = b;
            }
            __syncthreads();
#pragma unroll
            for (int kk = 0; kk < 16; ++kk) {
                const float4 a = *(const float4*)(As + kk * 132 + ty * 4);
                const float4 b0 = *(const float4*)(Bs + kk * 132 + tx * 4);
                const float4 b1 = *(const float4*)(Bs + kk * 132 + 64 + tx * 4);
                const float av[4] = {a.x, a.y, a.z, a.w};
                const float bv[8] = {b0.x, b0.y, b0.z, b0.w, b1.x, b1.y, b1.z, b1.w};
#pragma unroll
                for (int i = 0; i < 4; ++i)
#pragma unroll
                    for (int j = 0; j < 8; ++j) acc[i][j] = fmaf(av[i], bv[j], acc[i][j]);
            }
            __syncthreads();
        }
#pragma unroll
        for (int i = 0; i < 4; ++i)
#pragma unroll
            for (int j = 0; j < 8; ++j) {
                const int row = m0 + ty * 4 + i, col = n0 + (j < 4 ? tx * 4 + j : 64 + tx * 4 + (j - 4));
                if (col < N) E(row, col, acc[i][j]);
            }
    }
}

struct EpiProj {
    float *zu, *zv, *q, *k, *v, *fl; const float* b_f;
    __device__ __forceinline__ void operator()(int row, int col, float val) const {
        if (col < 512) zu[(size_t)row * 512 + col] = gelu_exact(val);
        else if (col < 1024) zv[(size_t)row * 512 + col - 512] = gelu_exact(val);
        else if (col < 1536) q[(size_t)row * 512 + col - 1024] = val;
        else if (col < 2048) k[(size_t)row * 512 + col - 1536] = val;
        else if (col < 2560) v[(size_t)row * 512 + col - 2048] = val;
        else fl[(size_t)row * 8 + col - 2560] = log_sigmoid(val + b_f[col - 2560]);
    }
};
struct EpiRes {
    const float* x; const float* ada; float* out;
    __device__ __forceinline__ void operator()(int row, int col, float val) const {
        const int b = row / SEQ;
        out[(size_t)row * DM + col] = x[(size_t)row * DM + col] + ada[b * 6 * DM + 2 * DM + col] * val;
    }
};
struct EpiStore { float* o; int ld; __device__ __forceinline__ void operator()(int row, int col, float val) const { o[(size_t)row * ld + col] = val; } };

__device__ __forceinline__ void norm_mod_row(const float* xr, const float* g, const float* shift, const float* scale, float* o, int lane) {
    float4 v[4]; float s = 0.f;
#pragma unroll
    for (int j = 0; j < 4; ++j) { v[j] = *(const float4*)(xr + 256 * j + 4 * lane); s += v[j].x * v[j].x + v[j].y * v[j].y + v[j].z * v[j].z + v[j].w * v[j].w; }
    const float rstd = rsqrtf(wave_sum(s) * (1.f / DM) + EPS);
#pragma unroll
    for (int j = 0; j < 4; ++j) {
        const int c = 256 * j + 4 * lane;
        const float4 gg = *(const float4*)(g + c), sh = *(const float4*)(shift + c), sc = *(const float4*)(scale + c);
        float4 r;
        r.x = v[j].x * rstd * gg.x * (1.f + sc.x) + sh.x; r.y = v[j].y * rstd * gg.y * (1.f + sc.y) + sh.y;
        r.z = v[j].z * rstd * gg.z * (1.f + sc.z) + sh.z; r.w = v[j].w * rstd * gg.w * (1.f + sc.w) + sh.w;
        *(float4*)(o + c) = r;
    }
}

__global__ void __launch_bounds__(NTHR) fwd_kernel(Args a) {
    __shared__ __attribute__((aligned(16))) float lds[16384];
    const int tid = threadIdx.x, lane = tid & 63, wave = tid >> 6;
    const int gw = blockIdx.x * NWAVE + wave, ngw = gridDim.x * NWAVE;
    const int gt = blockIdx.x * NTHR + tid, ngt = gridDim.x * NTHR;
    unsigned char* ws = a.ws;
    float* ADA = (float*)(ws + WS_ADA); float* FL = (float*)(ws + WS_FL); float* H = (float*)(ws + WS_H);
    float* ZU = (float*)(ws + WS_ZU); float* ZV = (float*)(ws + WS_ZV); float* Q = (float*)(ws + WS_Q); float* K = (float*)(ws + WS_K); float* V = (float*)(ws + WS_V);
    float* QV = (float*)(ws + WS_ZU); int* IDX = (int*)(ws + WS_IDX); float* GATE = (float*)(ws + WS_GATE);
#define IN(p) (a.ph_lo <= (p) && (p) < a.ph_hi)
    if (IN(0)) {
        for (int o = gt; o < NB * 6 * DM; o += ngt) {
            const int b = o / (6 * DM), j = o % (6 * DM); float s = 0.f;
            for (int k = 0; k < DM; ++k) { const float cv = a.c[b * DM + k]; s = fmaf(cv / (1.f + expf(-cv)), a.w_ada[(size_t)k * 6 * DM + j], s); }
            ADA[o] = s + a.b_ada[j];
        }
    }
    if (IN(1)) {
        for (int t = gw; t < NT; t += ngw) { const int b = t / SEQ; norm_mod_row(a.x + (size_t)t * DM, a.norm1_g, ADA + b * 6 * DM, ADA + b * 6 * DM + DM, H + (size_t)t * DM, lane); }
    }
    if (IN(2)) { EpiProj E{ZU, ZV, Q, K, V, FL, a.b_f}; gemm_naive(lds, H, a.w_in, NT, INC, DM, E); }
    if (IN(3)) {
        if (gt < NB * NH) { const int b = gt / NH, h = gt % NH; float s = 0.f; for (int t = 0; t < SEQ; ++t) { s += FL[(size_t)(b * SEQ + t) * 8 + h]; FL[(size_t)(b * SEQ + t) * 8 + h] = s; } }
    }
    if (IN(4)) {
        float* Y = H;
        for (int task = blockIdx.x; task < NB * (SEQ / CHUNK) * NH; task += gridDim.x) {
            const int h = task % NH, bc = task / NH, t0 = bc * CHUNK;
            float* vn = lds;
            float* yb = lds + 8192;
            __syncthreads();
            if (tid < 128) {
                const float* zr = ZV + (size_t)(t0 + tid) * 512 + h * 64; float mu = 0.f;
                for (int d = 0; d < 64; ++d) mu += zr[d];
                mu *= (1.f / 64); float var = 0.f;
                for (int d = 0; d < 64; ++d) { const float dd = zr[d] - mu; var += dd * dd; }
                const float rs = rsqrtf(var * (1.f / 64) + EPS);
                for (int d = 0; d < 64; ++d) vn[tid * 64 + d] = (zr[d] - mu) * rs * a.sg_ln_g[h * 64 + d] + a.sg_ln_b[h * 64 + d];
            }
            __syncthreads();
            for (int o = tid; o < 128 * 64; o += NTHR) {
                const int t = o >> 6, d = o & 63; float s = 0.f; const float* wr = a.sg_w + ((size_t)h * 128 + t) * 128;
                for (int sidx = 0; sidx <= t; ++sidx) s = fmaf(wr[sidx], vn[sidx * 64 + d], s);
                s += a.sg_b[h * 128 + t];
                yb[o] = ZU[(size_t)(t0 + t) * 512 + h * 64 + d] * s;
            }
            __syncthreads();
            for (int o = tid; o < 128 * 64; o += NTHR) {
                const int t = o >> 6, d = o & 63; float ss = 0.f;
                for (int e = 0; e < 64; ++e) ss += yb[t * 64 + e] * yb[t * 64 + e];
                Y[(size_t)(t0 + t) * DM + h * 64 + d] = yb[o] * rsqrtf(ss * (1.f / 64) + EPS) * a.out_g_sg[h * 64 + d];
            }
        }
        __syncthreads();
        float* sc = lds + wave * 2048;
        for (int task = gw; task < NB * NH * SEQ; task += ngw) {
            const int t = task % SEQ, bh = task / SEQ, h = bh % NH, b = bh / NH;
            const size_t row = (size_t)b * SEQ + t;
            const float qd = Q[row * 512 + h * 64 + lane];
            const float Ft = FL[row * 8 + h];
            float mx = -INFINITY;
            for (int s0 = 0; s0 <= t; s0 += 64) {
                const int s = s0 + lane; float dot = 0.f;
                const float* kr = K + ((size_t)b * SEQ + (s <= t ? s : t)) * 512 + h * 64;
                for (int d = 0; d < 64; ++d) dot = fmaf(__shfl(qd, d), kr[d], dot);
                float lg = dot * 0.125f + Ft - FL[((size_t)b * SEQ + (s <= t ? s : t)) * 8 + h];
                if (s > t) lg = -INFINITY;
                sc[s] = lg; mx = fmaxf(mx, lg);
            }
            WAVE_LDS_FENCE();
            mx = wave_max(mx);
            float sum = 0.f;
            for (int s0 = 0; s0 <= t; s0 += 64) { const int s = s0 + lane; const float p = (s <= t) ? expf(sc[s] - mx) : 0.f; sc[s] = p; sum += p; }
            sum = wave_sum(sum);
            WAVE_LDS_FENCE();
            float o = 0.f;
            const int smax = ((t >> 6) + 1) << 6;
            for (int s = 0; s < smax; ++s) { const int ss = s <= t ? s : t; o = fmaf(sc[s], V[((size_t)b * SEQ + ss) * 512 + h * 64 + lane], o); }
            o /= sum;
            const float r = rsqrtf(wave_sum(o * o) * (1.f / 64) + EPS);
            Y[row * DM + 512 + h * 64 + lane] = o * r * a.out_g_fox[h * 64 + lane];
            WAVE_LDS_FENCE();
        }
    }
    if (IN(5)) { EpiRes E{a.x, ADA, a.out}; gemm_naive(lds, H, a.w_out, NT, DM, DM, E); }
    if (IN(6)) {
        for (int t = gw; t < NT; t += ngw) { const int b = t / SEQ; norm_mod_row(a.out + (size_t)t * DM, a.norm2_g, ADA + b * 6 * DM + 3 * DM, ADA + b * 6 * DM + 4 * DM, H + (size_t)t * DM, lane); }
    }
    if (IN(7)) { EpiStore E{QV, PH * DKEY}; gemm_naive(lds, H, a.w_query, NT, PH * DKEY, DM, E); }
    if (IN(8)) {
        float* qs = lds + wave * 256;
        for (int task = gw; task < NT * PH; task += ngw) {
            const int t = task / PH, h = task % PH;
            WAVE_LDS_FENCE();
            for (int i = lane; i < 256; i += 64) qs[i] = QV[(size_t)t * 2048 + h * 256 + i];
            WAVE_LDS_FENCE();
            float sv[2]; int si[2];
            sv[0] = sv[1] = 0.f; si[0] = si[1] = 0;
#pragma unroll
            for (int p = 0; p < 2; ++p) {
                float s0 = 0.f, s1 = 0.f;
                const float* k0 = a.sub_keys + (((size_t)h * 2 + p) * NKEYS + lane) * DHALF;
                const float* k1 = k0 + 64 * DHALF;
                for (int d = 0; d < DHALF; ++d) { const float qq = qs[p * 128 + d]; s0 = fmaf(qq, k0[d], s0); s1 = fmaf(qq, k1[d], s1); }
                for (int r = 0; r < TOPK; ++r) {
                    float bv; int bi;
                    if (s0 >= s1) { bv = s0; bi = lane; } else { bv = s1; bi = lane + 64; }
#pragma unroll
                    for (int o = 1; o < 64; o <<= 1) { const float ov = __shfl_xor(bv, o); const int oi = __shfl_xor(bi, o); if (ov > bv || (ov == bv && oi < bi)) { bv = ov; bi = oi; } }
                    if (lane == r) { sv[p] = bv; si[p] = bi; }
                    if (bi == lane) s0 = -INFINITY; if (bi == lane + 64) s1 = -INFINITY;
                }
            }
            float cv[4];
#pragma unroll
            for (int j = 0; j < 4; ++j) { const int c = lane + 64 * j; cv[j] = __shfl(sv[0], c >> 4) + __shfl(sv[1], c & 15); }
            float ts = 0.f; int tpos = 0;
            for (int r = 0; r < TOPK; ++r) {
                float bv = cv[0]; int bi = lane;
#pragma unroll
                for (int j = 1; j < 4; ++j) if (cv[j] > bv) { bv = cv[j]; bi = lane + 64 * j; }
#pragma unroll
                for (int o = 1; o < 64; o <<= 1) { const float ov = __shfl_xor(bv, o); const int oi = __shfl_xor(bi, o); if (ov > bv || (ov == bv && oi < bi)) { bv = ov; bi = oi; } }
                if (lane == r) { ts = bv; tpos = bi; }
#pragma unroll
                for (int j = 0; j < 4; ++j) if (bi == lane + 64 * j) cv[j] = -INFINITY;
            }
            const float tmax = __shfl(ts, 0);
            float e = lane < 16 ? expf(ts - tmax) : 0.f;
            const float esum = wave_sum(e);
            const int ia = __shfl(si[0], tpos >> 4), ib = __shfl(si[1], tpos & 15);
            if (lane < 16) { IDX[(size_t)t * 128 + h * 16 + lane] = ia * NKEYS + ib; GATE[(size_t)t * 128 + h * 16 + lane] = e / esum; }
        }
    }
    if (IN(9)) {
        for (int t = gw; t < NT; t += ngw) {
            const int b = t / SEQ;
            float4 hv[4], acc[4];
#pragma unroll
            for (int j = 0; j < 4; ++j) { hv[j] = *(const float4*)(H + (size_t)t * DM + 256 * j + 4 * lane); acc[j] = make_float4(0.f, 0.f, 0.f, 0.f); }
            for (int e = 0; e < 128; ++e) {
                const int idx = IDX[(size_t)t * 128 + e]; const float g = GATE[(size_t)t * 128 + e];
                const float* ur = a.expert_u + (size_t)idx * DM; const float* vr = a.expert_v + (size_t)idx * DM;
                float s = 0.f;
#pragma unroll
                for (int j = 0; j < 4; ++j) { const float4 u = *(const float4*)(ur + 256 * j + 4 * lane); s += u.x * hv[j].x + u.y * hv[j].y + u.z * hv[j].z + u.w * hv[j].w; }
                s = wave_sum(s);
                const float w = g * gelu_exact(s);
#pragma unroll
                for (int j = 0; j < 4; ++j) { const float4 v = *(const float4*)(vr + 256 * j + 4 * lane); acc[j].x = fmaf(w, v.x, acc[j].x); acc[j].y = fmaf(w, v.y, acc[j].y); acc[j].z = fmaf(w, v.z, acc[j].z); acc[j].w = fmaf(w, v.w, acc[j].w); }
            }
            float ss = 0.f; float4 x2[4];
#pragma unroll
            for (int j = 0; j < 4; ++j) {
                const int c = 256 * j + 4 * lane; const float4 x1 = *(const float4*)(a.out + (size_t)t * DM + c); const float4 g2 = *(const float4*)(ADA + b * 6 * DM + 5 * DM + c);
                x2[j].x = x1.x + g2.x * acc[j].x; x2[j].y = x1.y + g2.y * acc[j].y; x2[j].z = x1.z + g2.z * acc[j].z; x2[j].w = x1.w + g2.w * acc[j].w;
                ss += x2[j].x * x2[j].x + x2[j].y * x2[j].y + x2[j].z * x2[j].z + x2[j].w * x2[j].w;
            }
            const float rstd = rsqrtf(wave_sum(ss) * (1.f / DM) + EPS);
#pragma unroll
            for (int j = 0; j < 4; ++j) {
                const int c = 256 * j + 4 * lane; const float4 fg = *(const float4*)(a.final_g + c); float4 o;
                o.x = x2[j].x * rstd * fg.x; o.y = x2[j].y * rstd * fg.y; o.z = x2[j].z * rstd * fg.z; o.w = x2[j].w * rstd * fg.w;
                *(float4*)(a.out + (size_t)t * DM + c) = o;
            }
        }
    }
#undef IN
}

extern "C" void kernel_launch(void* const* d_in, const int* in_sizes, int n_in, void* d_out, int out_size, void* d_ws, size_t ws_size, hipStream_t stream) {
    if (n_in != 20 || ws_size < WS_END) { fprintf(stderr, "kernel_launch: unexpected n_in %d or ws_size %zu\n", n_in, ws_size); return; }
    Args a{};
    const float** p = (const float**)&a;
    for (int i = 0; i < 20; ++i) p[i] = (const float*)d_in[i];
    a.out = (float*)d_out; a.ws = (unsigned char*)d_ws;
    for (int ph = 0; ph < 10; ++ph) {
        a.ph_lo = ph; a.ph_hi = ph + 1;
        hipLaunchKernelGGL(fwd_kernel, dim3(1024), dim3(NTHR), 0, stream, a);
    }
}
```

```cpp
#include <hip/hip_runtime.h>
#include <cstdint>
#include <cstdio>
#include <cmath>

constexpr int DM = 1024, NB = 8, SEQ = 2048, NT = NB * SEQ;
constexpr int HD = 64, SGW = 512, FOXW = 512, NH = 8, CHUNK = 128;
constexpr int INC = 2 * SGW + 3 * FOXW + NH;
constexpr int PH = 8, NKEYS = 128, NEXP = NKEYS * NKEYS, TOPK = 16, DKEY = 256, DHALF = 128;
constexpr float EPS = 1e-6f;
constexpr int NTHR = 512, NWAVE = 8;

constexpr size_t MiB = 1u << 20;
constexpr size_t WS_ADA = 256 * 1024;
constexpr size_t WS_FL = 1 * MiB;
constexpr size_t WS_H = 2 * MiB;
constexpr size_t WS_ZU = WS_H + 64 * MiB;
constexpr size_t WS_ZV = WS_ZU + 32 * MiB, WS_Q = WS_ZV + 32 * MiB, WS_K = WS_Q + 32 * MiB, WS_V = WS_K + 32 * MiB;
constexpr size_t WS_IDX = WS_V + 32 * MiB;
constexpr size_t WS_GATE = WS_IDX + 8 * MiB;
constexpr size_t WS_END = WS_GATE + 8 * MiB;

struct Args {
    const float *x, *c, *w_ada, *b_ada, *norm1_g, *w_in, *b_f, *sg_ln_g, *sg_ln_b, *sg_w, *sg_b, *out_g_sg, *out_g_fox,
        *w_out, *norm2_g, *w_query, *sub_keys, *expert_u, *expert_v, *final_g;
    float* out; unsigned char* ws; int ph_lo, ph_hi;
};

#define WAVE_LDS_FENCE() do { __builtin_amdgcn_fence(__ATOMIC_ACQ_REL, "wavefront"); __builtin_amdgcn_wave_barrier(); } while (0)
__device__ __forceinline__ float wave_sum(float v) {
#pragma unroll
    for (int o = 1; o < 64; o <<= 1) v += __shfl_xor(v, o);
    return v;
}
__device__ __forceinline__ float wave_max(float v) {
#pragma unroll
    for (int o = 1; o < 64; o <<= 1) v = fmaxf(v, __shfl_xor(v, o));
    return v;
}
__device__ __forceinline__ float gelu_exact(float v) { return 0.5f * v * (1.0f + erff(v * 0.70710678118654752f)); }
__device__ __forceinline__ float log_sigmoid(float v) { return fminf(v, 0.f) - log1pf(expf(-fabsf(v))); }

template <class Epi>
__device__ __forceinline__ void gemm_naive(float* lds, const float* A, const float* Bm, int M, int N, int K, const Epi& E) {
    float* As = lds;
    float* Bs = lds + 16 * 132;
    const int tid = threadIdx.x, ty = tid >> 4, tx = tid & 15;
    const int ntn = (N + 127) / 128, ntm = M / 128;
    for (int tile = blockIdx.x; tile < ntn * ntm; tile += gridDim.x) {
        const int tm = tile / ntn, tn = tile % ntn, m0 = tm * 128, n0 = tn * 128;
        float acc[4][8];
#pragma unroll
        for (int i = 0; i < 4; ++i)
#pragma unroll
            for (int j = 0; j < 8; ++j) acc[i][j] = 0.f;
        for (int k0 = 0; k0 < K; k0 += 16) {
            {
                const int r = tid >> 2, k4 = (tid & 3) * 4;
                const float4 a = *(const float4*)(A + (size_t)(m0 + r) * K + k0 + k4);
                As[(k4 + 0) * 132 + r] = a.x; As[(k4 + 1) * 132 + r] = a.y; As[(k4 + 2) * 132 + r] = a.z; As[(k4 + 3) * 132 + r] = a.w;
                const int kk = tid >> 5, n4 = (tid & 31) * 4;
                float4 b = make_float4(0.f, 0.f, 0.f, 0.f);
                if (n0 + n4 < N) b = *(const float4*)(Bm + (size_t)(k0 + kk) * N + n0 + n4);
                *(float4*)(Bs + kk * 132 + n4) = b;
            }
            __syncthreads();
#pragma unroll
            for (int kk = 0; kk < 16; ++kk) {
                const float4 a = *(const float4*)(As + kk * 132 + ty * 4);
                const float4 b0 = *(const float4*)(Bs + kk * 132 + tx * 4);
                const float4 b1 = *(const float4*)(Bs + kk * 132 + 64 + tx * 4);
                const float av[4] = {a.x, a.y, a.z, a.w};
                const float bv[8] = {b0.x, b0.y, b0.z, b0.w, b1.x, b1.y, b1.z, b1.w};
#pragma unroll
                for (int i = 0; i < 4; ++i)
#pragma unroll
                    for (int j = 0; j < 8; ++j) acc[i][j] = fmaf(av[i], bv[j], acc[i][j]);
            }
            __syncthreads();
        }
#pragma unroll
        for (int i = 0; i < 4; ++i)
#pragma unroll
            for (int j = 0; j < 8; ++j) {
                const int row = m0 + ty * 4 + i, col = n0 + (j < 4 ? tx * 4 + j : 64 + tx * 4 + (j - 4));
                if (col < N) E(row, col, acc[i][j]);
            }
    }
}

struct EpiProj {
    float *zu, *zv, *q, *k, *v, *fl; const float* b_f;
    __device__ __forceinline__ void operator()(int row, int col, float val) const {
        if (col < 512) zu[(size_t)row * 512 + col] = gelu_exact(val);
        else if (col < 1024) zv[(size_t)row * 512 + col - 512] = gelu_exact(val);
        else if (col < 1536) q[(size_t)row * 512 + col - 1024] = val;
        else if (col < 2048) k[(size_t)row * 512 + col - 1536] = val;
        else if (col < 2560) v[(size_t)row * 512 + col - 2048] = val;
        else fl[(size_t)row * 8 + col - 2560] = log_sigmoid(val + b_f[col - 2560]);
    }
};
struct EpiRes {
    const float* x; const float* ada; float* out;
    __device__ __forceinline__ void operator()(int row, int col, float val) const {
        const int b = row / SEQ;
        out[(size_t)row * DM + col] = x[(size_t)row * DM + col] + ada[b * 6 * DM + 2 * DM + col] * val;
    }
};
struct EpiStore { float* o; int ld; __device__ __forceinline__ void operator()(int row, int col, float val) const { o[(size_t)row * ld + col] = val; } };

__device__ __forceinline__ void norm_mod_row(const float* xr, const float* g, const float* shift, const float* scale, float* o, int lane) {
    float4 v[4]; float s = 0.f;
#pragma unroll
    for (int j = 0; j < 4; ++j) { v[j] = *(const float4*)(xr + 256 * j + 4 * lane); s += v[j].x * v[j].x + v[j].y * v[j].y + v[j].z * v[j].z + v[j].w * v[j].w; }
    const float rstd = rsqrtf(wave_sum(s) * (1.f / DM) + EPS);
#pragma unroll
    for (int j = 0; j < 4; ++j) {
        const int c = 256 * j + 4 * lane;
        const float4 gg = *(const float4*)(g + c), sh = *(const float4*)(shift + c), sc = *(const float4*)(scale + c);
        float4 r;
        r.x = v[j].x * rstd * gg.x * (1.f + sc.x) + sh.x; r.y = v[j].y * rstd * gg.y * (1.f + sc.y) + sh.y;
        r.z = v[j].z * rstd * gg.z * (1.f + sc.z) + sh.z; r.w = v[j].w * rstd * gg.w * (1.f + sc.w) + sh.w;
        *(float4*)(o + c) = r;
    }
}


#define GAS __attribute__((address_space(1)))
#define LAS __attribute__((address_space(3)))
#define XB_TMO      128
#define XB_XCNT(j)  (256  + 64 * (j))
#define XB_XSUB(j)  (1280 + 64 * (j))
#define XB_XGEN(j)  (2304 + 64 * (j))
#define XB_TOP      3328
#define XB_TOPGEN   3392
#define XCD_BAR_WORDS 3456
#define XB_SPIN_CAP (1u << 18)
__device__ __forceinline__ unsigned xb_ld(unsigned* p)              { return __hip_atomic_load(p, __ATOMIC_RELAXED, __HIP_MEMORY_SCOPE_AGENT); }
__device__ __forceinline__ unsigned xb_add(unsigned* p, unsigned v) { return __hip_atomic_fetch_add(p, v, __ATOMIC_RELAXED, __HIP_MEMORY_SCOPE_AGENT); }
__device__ __forceinline__ unsigned xb_xcc_id() { return (unsigned)__builtin_amdgcn_s_getreg((3 << 11) | 20) & 0xFu; }
#define XB_SPIN(cond, bar) do { unsigned _sp = 0; while (cond) { __builtin_amdgcn_s_sleep(1); \
    if ((++_sp & 255u) == 0u) { if (xb_ld(&(bar)[XB_TMO])) break; if (_sp > XB_SPIN_CAP) { atomicAdd(&(bar)[XB_TMO], 1u); break; } } } } while (0)
struct XcdBarrier { unsigned* bar; unsigned x; volatile LAS unsigned* st; };
__device__ __forceinline__ XcdBarrier xcd_barrier_post(unsigned* bar, volatile LAS unsigned* st) {
    XcdBarrier b; b.bar = bar; b.x = xb_xcc_id(); b.st = st;
    if (threadIdx.x == 0) (void)xb_add(&bar[XB_XCNT(b.x)], 1u);
    return b;
}
__device__ __forceinline__ void xcd_barrier_complete(unsigned* bar, unsigned x, unsigned& nloc, unsigned& nx) {
    const unsigned G = gridDim.x * gridDim.y * gridDim.z;
    unsigned sum, cnt, mine, sp = 0u;
    for (;;) {
        sum = 0u; cnt = 0u; mine = 0u;
#pragma unroll
        for (unsigned j = 0; j < 16; ++j) { const unsigned c = xb_ld(&bar[XB_XCNT(j)]); sum += c; cnt += (c > 0u) ? 1u : 0u; mine = (j == x) ? c : mine; }
        if (sum == G) break;
        __builtin_amdgcn_s_sleep(1);
        if ((++sp & 255u) == 0u) { if (xb_ld(&bar[XB_TMO])) break; if (sp > XB_SPIN_CAP) { atomicAdd(&bar[XB_TMO], 1u); break; } }
    }
    nloc = mine > 0u ? mine : 1u; nx = cnt > 0u ? cnt : 1u;
}
__device__ __forceinline__ void xcd_barrier(const XcdBarrier& b) {
    asm volatile("s_waitcnt vmcnt(0)" ::: "memory");
    __syncthreads();
    if (threadIdx.x == 0) {
        unsigned* bar = b.bar;
        __builtin_amdgcn_s_waitcnt(0);
        unsigned nloc = b.st[0], nx = b.st[1];
        if (nloc == 0u) { xcd_barrier_complete(bar, b.x, nloc, nx); b.st[0] = nloc; b.st[1] = nx; }
        const unsigned old = xb_add(&bar[XB_XSUB(b.x)], 1u);
        const unsigned gen = old / nloc;
        if (old + 1u == (gen + 1u) * nloc) {
            __builtin_amdgcn_fence(__ATOMIC_RELEASE, "agent");
            asm volatile("s_waitcnt vmcnt(0)" ::: "memory");
            const unsigned og = xb_add(&bar[XB_TOP], 1u);
            const unsigned tg = og / nx;
            if (og + 1u == (tg + 1u) * nx) xb_add(&bar[XB_TOPGEN], 1u);
            else XB_SPIN(xb_ld(&bar[XB_TOPGEN]) == tg, bar);
            __builtin_amdgcn_fence(__ATOMIC_ACQUIRE, "agent");
            xb_add(&bar[XB_XGEN(b.x)], 1u);
            asm volatile("s_waitcnt vmcnt(0)" ::: "memory");
        } else {
            XB_SPIN(xb_ld(&bar[XB_XGEN(b.x)]) == gen, bar);
            __builtin_amdgcn_fence(__ATOMIC_ACQUIRE, "agent");
            asm volatile("s_waitcnt vmcnt(0)" ::: "memory");
        }
    }
    __syncthreads();
}
constexpr int LDS_BYTES = 147456, LDSCTL_OFF = 131072, MISC_OFF = LDSCTL_OFF + 320;
constexpr size_t WS_CTL = 0, CTL_ZERO_BYTES = 64 * 1024;

__global__ void __launch_bounds__(NTHR) fwd_kernel(Args a) {
    extern __shared__ __attribute__((aligned(16))) unsigned char lds_raw[];
    float* lds = (float*)lds_raw;
    const int tid = threadIdx.x, lane = tid & 63, wave = tid >> 6;
    const int gw = blockIdx.x * NWAVE + wave, ngw = gridDim.x * NWAVE;
    const int gt = blockIdx.x * NTHR + tid, ngt = gridDim.x * NTHR;
    unsigned char* ws = a.ws;
    float* ADA = (float*)(ws + WS_ADA); float* FL = (float*)(ws + WS_FL); float* H = (float*)(ws + WS_H);
    float* ZU = (float*)(ws + WS_ZU); float* ZV = (float*)(ws + WS_ZV); float* Q = (float*)(ws + WS_Q); float* K = (float*)(ws + WS_K); float* V = (float*)(ws + WS_V);
    float* QV = (float*)(ws + WS_ZU); int* IDX = (int*)(ws + WS_IDX); float* GATE = (float*)(ws + WS_GATE);
#define IN(p) (a.ph_lo <= (p) && (p) < a.ph_hi)
    for (int u = tid; u < (LDS_BYTES - LDSCTL_OFF) / 4; u += NTHR) ((LAS unsigned*)((LAS unsigned char*)lds_raw + LDSCTL_OFF))[u] = 0u;
    __syncthreads();
    XcdBarrier bar = xcd_barrier_post((unsigned*)(ws + WS_CTL), (volatile LAS unsigned*)((LAS unsigned char*)lds_raw + MISC_OFF) + 8);
#define GRID_BAR() xcd_barrier(bar)
    if (IN(0)) {
        for (int o = gt; o < NB * 6 * DM; o += ngt) {
            const int b = o / (6 * DM), j = o % (6 * DM); float s = 0.f;
            for (int k = 0; k < DM; ++k) { const float cv = a.c[b * DM + k]; s = fmaf(cv / (1.f + expf(-cv)), a.w_ada[(size_t)k * 6 * DM + j], s); }
            ADA[o] = s + a.b_ada[j];
        }
    }
    GRID_BAR();
    if (IN(1)) {
        for (int t = gw; t < NT; t += ngw) { const int b = t / SEQ; norm_mod_row(a.x + (size_t)t * DM, a.norm1_g, ADA + b * 6 * DM, ADA + b * 6 * DM + DM, H + (size_t)t * DM, lane); }
    }
    GRID_BAR();
    if (IN(2)) { EpiProj E{ZU, ZV, Q, K, V, FL, a.b_f}; gemm_naive(lds, H, a.w_in, NT, INC, DM, E); }
    GRID_BAR();
    if (IN(3)) {
        if (gt < NB * NH) { const int b = gt / NH, h = gt % NH; float s = 0.f; for (int t = 0; t < SEQ; ++t) { s += FL[(size_t)(b * SEQ + t) * 8 + h]; FL[(size_t)(b * SEQ + t) * 8 + h] = s; } }
    }
    GRID_BAR();
    if (IN(4)) {
        float* Y = H;
        for (int task = blockIdx.x; task < NB * (SEQ / CHUNK) * NH; task += gridDim.x) {
            const int h = task % NH, bc = task / NH, t0 = bc * CHUNK;
            float* vn = lds;
            float* yb = lds + 8192;
            __syncthreads();
            if (tid < 128) {
                const float* zr = ZV + (size_t)(t0 + tid) * 512 + h * 64; float mu = 0.f;
                for (int d = 0; d < 64; ++d) mu += zr[d];
                mu *= (1.f / 64); float var = 0.f;
                for (int d = 0; d < 64; ++d) { const float dd = zr[d] - mu; var += dd * dd; }
                const float rs = rsqrtf(var * (1.f / 64) + EPS);
                for (int d = 0; d < 64; ++d) vn[tid * 64 + d] = (zr[d] - mu) * rs * a.sg_ln_g[h * 64 + d] + a.sg_ln_b[h * 64 + d];
            }
            __syncthreads();
            for (int o = tid; o < 128 * 64; o += NTHR) {
                const int t = o >> 6, d = o & 63; float s = 0.f; const float* wr = a.sg_w + ((size_t)h * 128 + t) * 128;
                for (int sidx = 0; sidx <= t; ++sidx) s = fmaf(wr[sidx], vn[sidx * 64 + d], s);
                s += a.sg_b[h * 128 + t];
                yb[o] = ZU[(size_t)(t0 + t) * 512 + h * 64 + d] * s;
            }
            __syncthreads();
            for (int o = tid; o < 128 * 64; o += NTHR) {
                const int t = o >> 6, d = o & 63; float ss = 0.f;
                for (int e = 0; e < 64; ++e) ss += yb[t * 64 + e] * yb[t * 64 + e];
                Y[(size_t)(t0 + t) * DM + h * 64 + d] = yb[o] * rsqrtf(ss * (1.f / 64) + EPS) * a.out_g_sg[h * 64 + d];
            }
        }
        __syncthreads();
        float* sc = lds + wave * 2048;
        for (int task = gw; task < NB * NH * SEQ; task += ngw) {
            const int t = task % SEQ, bh = task / SEQ, h = bh % NH, b = bh / NH;
            const size_t row = (size_t)b * SEQ + t;
            const float qd = Q[row * 512 + h * 64 + lane];
            const float Ft = FL[row * 8 + h];
            float mx = -INFINITY;
            for (int s0 = 0; s0 <= t; s0 += 64) {
                const int s = s0 + lane; float dot = 0.f;
                const float* kr = K + ((size_t)b * SEQ + (s <= t ? s : t)) * 512 + h * 64;
                for (int d = 0; d < 64; ++d) dot = fmaf(__shfl(qd, d), kr[d], dot);
                float lg = dot * 0.125f + Ft - FL[((size_t)b * SEQ + (s <= t ? s : t)) * 8 + h];
                if (s > t) lg = -INFINITY;
                sc[s] = lg; mx = fmaxf(mx, lg);
            }
            WAVE_LDS_FENCE();
            mx = wave_max(mx);
            float sum = 0.f;
            for (int s0 = 0; s0 <= t; s0 += 64) { const int s = s0 + lane; const float p = (s <= t) ? expf(sc[s] - mx) : 0.f; sc[s] = p; sum += p; }
            sum = wave_sum(sum);
            WAVE_LDS_FENCE();
            float o = 0.f;
            const int smax = ((t >> 6) + 1) << 6;
            for (int s = 0; s < smax; ++s) { const int ss = s <= t ? s : t; o = fmaf(sc[s], V[((size_t)b * SEQ + ss) * 512 + h * 64 + lane], o); }
            o /= sum;
            const float r = rsqrtf(wave_sum(o * o) * (1.f / 64) + EPS);
            Y[row * DM + 512 + h * 64 + lane] = o * r * a.out_g_fox[h * 64 + lane];
            WAVE_LDS_FENCE();
        }
    }
    GRID_BAR();
    if (IN(5)) { EpiRes E{a.x, ADA, a.out}; gemm_naive(lds, H, a.w_out, NT, DM, DM, E); }
    GRID_BAR();
    if (IN(6)) {
        for (int t = gw; t < NT; t += ngw) { const int b = t / SEQ; norm_mod_row(a.out + (size_t)t * DM, a.norm2_g, ADA + b * 6 * DM + 3 * DM, ADA + b * 6 * DM + 4 * DM, H + (size_t)t * DM, lane); }
    }
    GRID_BAR();
    if (IN(7)) { EpiStore E{QV, PH * DKEY}; gemm_naive(lds, H, a.w_query, NT, PH * DKEY, DM, E); }
    GRID_BAR();
    if (IN(8)) {
        float* qs = lds + wave * 256;
        for (int task = gw; task < NT * PH; task += ngw) {
            const int t = task / PH, h = task % PH;
            WAVE_LDS_FENCE();
            for (int i = lane; i < 256; i += 64) qs[i] = QV[(size_t)t * 2048 + h * 256 + i];
            WAVE_LDS_FENCE();
            float sv[2]; int si[2];
            sv[0] = sv[1] = 0.f; si[0] = si[1] = 0;
#pragma unroll
            for (int p = 0; p < 2; ++p) {
                float s0 = 0.f, s1 = 0.f;
                const float* k0 = a.sub_keys + (((size_t)h * 2 + p) * NKEYS + lane) * DHALF;
                const float* k1 = k0 + 64 * DHALF;
                for (int d = 0; d < DHALF; ++d) { const float qq = qs[p * 128 + d]; s0 = fmaf(qq, k0[d], s0); s1 = fmaf(qq, k1[d], s1); }
                for (int r = 0; r < TOPK; ++r) {
                    float bv; int bi;
                    if (s0 >= s1) { bv = s0; bi = lane; } else { bv = s1; bi = lane + 64; }
#pragma unroll
                    for (int o = 1; o < 64; o <<= 1) { const float ov = __shfl_xor(bv, o); const int oi = __shfl_xor(bi, o); if (ov > bv || (ov == bv && oi < bi)) { bv = ov; bi = oi; } }
                    if (lane == r) { sv[p] = bv; si[p] = bi; }
                    if (bi == lane) s0 = -INFINITY; if (bi == lane + 64) s1 = -INFINITY;
                }
            }
            float cv[4];
#pragma unroll
            for (int j = 0; j < 4; ++j) { const int c = lane + 64 * j; cv[j] = __shfl(sv[0], c >> 4) + __shfl(sv[1], c & 15); }
            float ts = 0.f; int tpos = 0;
            for (int r = 0; r < TOPK; ++r) {
                float bv = cv[0]; int bi = lane;
#pragma unroll
                for (int j = 1; j < 4; ++j) if (cv[j] > bv) { bv = cv[j]; bi = lane + 64 * j; }
#pragma unroll
                for (int o = 1; o < 64; o <<= 1) { const float ov = __shfl_xor(bv, o); const int oi = __shfl_xor(bi, o); if (ov > bv || (ov == bv && oi < bi)) { bv = ov; bi = oi; } }
                if (lane == r) { ts = bv; tpos = bi; }
#pragma unroll
                for (int j = 0; j < 4; ++j) if (bi == lane + 64 * j) cv[j] = -INFINITY;
            }
            const float tmax = __shfl(ts, 0);
            float e = lane < 16 ? expf(ts - tmax) : 0.f;
            const float esum = wave_sum(e);
            const int ia = __shfl(si[0], tpos >> 4), ib = __shfl(si[1], tpos & 15);
            if (lane < 16) { IDX[(size_t)t * 128 + h * 16 + lane] = ia * NKEYS + ib; GATE[(size_t)t * 128 + h * 16 + lane] = e / esum; }
        }
    }
    GRID_BAR();
    if (IN(9)) {
        for (int t = gw; t < NT; t += ngw) {
            const int b = t / SEQ;
            float4 hv[4], acc[4];
#pragma unroll
            for (int j = 0; j < 4; ++j) { hv[j] = *(const float4*)(H + (size_t)t * DM + 256 * j + 4 * lane); acc[j] = make_float4(0.f, 0.f, 0.f, 0.f); }
            for (int e = 0; e < 128; ++e) {
                const int idx = IDX[(size_t)t * 128 + e]; const float g = GATE[(size_t)t * 128 + e];
                const float* ur = a.expert_u + (size_t)idx * DM; const float* vr = a.expert_v + (size_t)idx * DM;
                float s = 0.f;
#pragma unroll
                for (int j = 0; j < 4; ++j) { const float4 u = *(const float4*)(ur + 256 * j + 4 * lane); s += u.x * hv[j].x + u.y * hv[j].y + u.z * hv[j].z + u.w * hv[j].w; }
                s = wave_sum(s);
                const float w = g * gelu_exact(s);
#pragma unroll
                for (int j = 0; j < 4; ++j) { const float4 v = *(const float4*)(vr + 256 * j + 4 * lane); acc[j].x = fmaf(w, v.x, acc[j].x); acc[j].y = fmaf(w, v.y, acc[j].y); acc[j].z = fmaf(w, v.z, acc[j].z); acc[j].w = fmaf(w, v.w, acc[j].w); }
            }
            float ss = 0.f; float4 x2[4];
#pragma unroll
            for (int j = 0; j < 4; ++j) {
                const int c = 256 * j + 4 * lane; const float4 x1 = *(const float4*)(a.out + (size_t)t * DM + c); const float4 g2 = *(const float4*)(ADA + b * 6 * DM + 5 * DM + c);
                x2[j].x = x1.x + g2.x * acc[j].x; x2[j].y = x1.y + g2.y * acc[j].y; x2[j].z = x1.z + g2.z * acc[j].z; x2[j].w = x1.w + g2.w * acc[j].w;
                ss += x2[j].x * x2[j].x + x2[j].y * x2[j].y + x2[j].z * x2[j].z + x2[j].w * x2[j].w;
            }
            const float rstd = rsqrtf(wave_sum(ss) * (1.f / DM) + EPS);
#pragma unroll
            for (int j = 0; j < 4; ++j) {
                const int c = 256 * j + 4 * lane; const float4 fg = *(const float4*)(a.final_g + c); float4 o;
                o.x = x2[j].x * rstd * fg.x; o.y = x2[j].y * rstd * fg.y; o.z = x2[j].z * rstd * fg.z; o.w = x2[j].w * rstd * fg.w;
                *(float4*)(a.out + (size_t)t * DM + c) = o;
            }
        }
    }
#undef IN
}

extern "C" void kernel_launch(void* const* d_in, const int* in_sizes, int n_in, void* d_out, int out_size, void* d_ws, size_t ws_size, hipStream_t stream) {
    if (n_in != 20 || ws_size < WS_END) { fprintf(stderr, "kernel_launch: unexpected n_in %d or ws_size %zu\n", n_in, ws_size); return; }
    Args a{};
    const float** p = (const float**)&a;
    for (int i = 0; i < 20; ++i) p[i] = (const float*)d_in[i];
    a.out = (float*)d_out; a.ws = (unsigned char*)d_ws;
    static int grid = 0;
    if (grid == 0) {
        int dev = 0, cus = 0, per_cu = 0;
        hipGetDevice(&dev); hipDeviceGetAttribute(&cus, hipDeviceAttributeMultiprocessorCount, dev);
        hipFuncSetAttribute((const void*)fwd_kernel, hipFuncAttributeMaxDynamicSharedMemorySize, LDS_BYTES);
        hipOccupancyMaxActiveBlocksPerMultiprocessor(&per_cu, (const void*)fwd_kernel, NTHR, LDS_BYTES);
        (void)hipGetLastError();
        if (per_cu < 1) { fprintf(stderr, "kernel_launch: occupancy query says %d blocks/CU\n", per_cu); grid = -1; }
        else grid = cus;
    }
    if (grid < 0) return;
    hipMemsetAsync((char*)d_ws + WS_CTL, 0, CTL_ZERO_BYTES, stream);
    a.ph_lo = 0; a.ph_hi = 10;
    hipLaunchKernelGGL(fwd_kernel, dim3(grid), dim3(NTHR), LDS_BYTES, stream, a);
}
```

```cpp
#include <hip/hip_runtime.h>
#include <cstdint>
#include <cstdio>
#include <cmath>

constexpr int DM = 1024, NB = 8, SEQ = 2048, NT = NB * SEQ;
constexpr int HD = 64, SGW = 512, FOXW = 512, NH = 8, CHUNK = 128;
constexpr int INC = 2 * SGW + 3 * FOXW + NH;
constexpr int NPROJ = 2560;
constexpr int PH = 8, NKEYS = 128, NEXP = NKEYS * NKEYS, TOPK = 16, DKEY = 256, DHALF = 128, NQ = PH * DKEY;
constexpr float EPS = 1e-6f;
constexpr int NTHR = 512, NWAVE = 8;
constexpr float LOG2E = 1.4426950408889634f;
constexpr float C2 = 0.125f * LOG2E;

typedef unsigned short bf16_t;

constexpr size_t MiB = 1u << 20;
constexpr size_t WS_CTL = 0, CTL_ZERO_BYTES = 64 * 1024;
constexpr size_t WS_ADA = 256 * 1024;
constexpr size_t WS_SQB = 512 * 1024;
constexpr size_t WS_FL = 1 * MiB;
constexpr size_t WS_GQ = WS_FL + MiB / 2;
constexpr size_t WS_SSQ = 2 * MiB;
constexpr size_t WS_WIN = 3 * MiB;
constexpr size_t WS_WOUT = WS_WIN + 5 * MiB;
constexpr size_t WS_WQ = WS_WOUT + 2 * MiB;
constexpr size_t WS_SUBK = WS_WQ + 4 * MiB;
constexpr size_t WS_SGW = WS_SUBK + MiB;
constexpr size_t WS_GX = WS_SGW + MiB;
constexpr size_t WS_EU = 20 * MiB;
constexpr size_t WS_EV = WS_EU + 32 * MiB;
constexpr size_t WS_HB = WS_EV + 32 * MiB;
constexpr size_t WS_ZU = WS_HB + 32 * MiB;
constexpr size_t WS_ZV = WS_ZU + 16 * MiB, WS_Q = WS_ZV + 16 * MiB, WS_K = WS_Q + 16 * MiB, WS_V = WS_K + 16 * MiB;
constexpr size_t WS_XG = WS_K;
constexpr size_t WS_QV = WS_HB;
constexpr size_t WS_IDX = WS_V + 16 * MiB;
constexpr size_t WS_GATE = WS_IDX + 8 * MiB;
constexpr size_t WS_END = WS_GATE + 8 * MiB;

struct Args {
    const float *x, *c, *w_ada, *b_ada, *norm1_g, *w_in, *b_f, *sg_ln_g, *sg_ln_b, *sg_w, *sg_b, *out_g_sg, *out_g_fox,
        *w_out, *norm2_g, *w_query, *sub_keys, *expert_u, *expert_v, *final_g;
    float* out; unsigned char* ws; int ph_lo, ph_hi;
};

#define GAS __attribute__((address_space(1)))
#define LAS __attribute__((address_space(3)))
#define WAVE_LDS_FENCE() do { __builtin_amdgcn_fence(__ATOMIC_ACQ_REL, "wavefront"); __builtin_amdgcn_wave_barrier(); } while (0)
__device__ __forceinline__ float wave_sum(float v) {
#pragma unroll
    for (int o = 1; o < 64; o <<= 1) v += __shfl_xor(v, o);
    return v;
}
__device__ __forceinline__ float wave_max(float v) {
#pragma unroll
    for (int o = 1; o < 64; o <<= 1) v = fmaxf(v, __shfl_xor(v, o));
    return v;
}
__device__ __forceinline__ float gelu_exact(float v) { return 0.5f * v * (1.0f + erff(v * 0.70710678118654752f)); }
__device__ __forceinline__ float log_sigmoid(float v) { return fminf(v, 0.f) - log1pf(expf(-fabsf(v))); }
__device__ __forceinline__ float bf2f(bf16_t v) { return __uint_as_float((unsigned)v << 16); }
__device__ __forceinline__ unsigned f2bf(float f) { unsigned u = __builtin_bit_cast(unsigned, f); return (u + 0x7fffu + ((u >> 16) & 1u)) >> 16; }
__device__ __forceinline__ unsigned pk2(float lo, float hi) { return f2bf(lo) | (f2bf(hi) << 16); }

namespace pg8 {
#define PG8_LAS __attribute__((address_space(3)))
typedef unsigned short bf16_t;
typedef short bf16x8 __attribute__((ext_vector_type(8)));
typedef float f32x4 __attribute__((ext_vector_type(4)));
typedef unsigned u32x4 __attribute__((ext_vector_type(4)));
constexpr int BM = 256, BK = 64, HALF = 128, HTB = HALF * BK * 2  , STAGE_BYTES = 8 * HTB, NXCD = 8, WGM = 8;

__host__ __device__ __forceinline__ int lds_byte(int r, int c) { const int st = (r >> 4) * 2 + (c >> 5), rr = r & 15, cc = c & 31, ob = rr * 64 + cc * 2; return st * 1024 + (ob ^ (((ob >> 9) & 1) << 5)); }
__host__ __device__ __forceinline__ void stage_rc(int b, int& R, int& C) { const int st = b / 1024, sb = b % 1024, swz = sb ^ (((sb >> 9) & 1) << 5); R = (st >> 1) * 16 + swz / 64; C = (st & 1) * 32 + (swz % 64) / 2; }
__host__ __device__ __forceinline__ int perm32(int rho) { const int n = rho >> 4, i = rho & 15; return 8 * (i >> 2) + 4 * n + (i & 3); }

struct Unit { int pm, pn; };
struct Gemm { const bf16_t* A; const bf16_t* Bt; int M, N, K; };

struct StaticOrder {
    int nM, nN, nwg, G, c;
    __host__ __device__ void init(int M, int N, int G_, int c_) { nM = M / BM; nN = N / BM; nwg = nM * nN; G = G_; c = c_; }
    __host__ __device__ bool next(int i, Unit& u) const {
        const long L = (long)i * G + c; if (L >= nwg) return false;
        int wgid = (int)L; { const int q = nwg / NXCD, r = nwg % NXCD, xcd = wgid % NXCD, off = wgid / NXCD; wgid = (xcd < r ? xcd * (q + 1) : r * (q + 1) + (xcd - r) * q) + off; }
        const int nig = WGM * nN, gid = wgid / nig, fm = gid * WGM, gsz = (nM - fm) < WGM ? (nM - fm) : WGM;
        u.pm = fm + ((wgid % nig) % gsz); u.pn = (wgid % nig) / gsz; return true;
    }
    __device__ __forceinline__ void a_ready(const Unit&) const {}
    __device__ __forceinline__ void done(const Unit&) const {}
};


__device__ __forceinline__ unsigned cvt_pk_bf16(float lo, float hi) { unsigned r; asm volatile("v_cvt_pk_bf16_f32 %0, %1, %2" : "=v"(r) : "v"(lo), "v"(hi)); return r; }
typedef float f32x2 __attribute__((ext_vector_type(2)));
__device__ __forceinline__ f32x2 gelu_pk(f32x2 v) {
    const f32x2 av = __builtin_elementwise_abs(v), d = av * 0.2316418882f + 1.0f;
    f32x2 t; t.x = __builtin_amdgcn_rcpf(d.x); t.y = __builtin_amdgcn_rcpf(d.y);
    f32x2 q = t * 0.5307027145f + (-0.7265760135f); q = q * t + 0.7107068705f; q = q * t + (-0.142248368f); q = q * t + 0.127414796f; q = q * t;
    const f32x2 s = (v * v) * (-0.72134752044f);
    f32x2 e; e.x = __builtin_amdgcn_exp2f(s.x); e.y = __builtin_amdgcn_exp2f(s.y);
    const f32x2 m = v * (q * e), r = v - m;
    f32x2 o; o.x = v.x < 0.f ? m.x : r.x; o.y = v.y < 0.f ? m.y : r.y; return o;
}


typedef unsigned u32x4 __attribute__((ext_vector_type(4)));
struct EpiProj {
    static constexpr bool PERM = true, AFTER_DRAIN = false;
    bf16_t* base;
    __device__ __forceinline__ void operator()(const f32x4 (&acc)[2][2][4][2], const Unit& u, int wr, int wc, int fr, int fq) const {
        const int t = u.pn >> 1;
        bf16_t* O = base + (size_t)t * NT * 512;
        const bool act = t < 2; const float sc = (t == 2) ? C2 : 1.f;
        const int row0 = u.pm * BM + wr * 64 + fr, col0 = (u.pn & 1) * 256 + wc * 32 + 8 * fq;
#pragma unroll
        for (int ai = 0; ai < 2; ++ai)
#pragma unroll
            for (int m = 0; m < 4; ++m) { bf16_t* rowp = O + (size_t)(row0 + ai * HALF + m * 16) * 512 + col0;
#pragma unroll
                for (int bj = 0; bj < 2; ++bj) { f32x4 v0 = acc[ai][bj][m][0], v1 = acc[ai][bj][m][1];
                    if (act) { f32x2 a = gelu_pk((f32x2){v0[0], v0[1]}), b = gelu_pk((f32x2){v0[2], v0[3]}), c = gelu_pk((f32x2){v1[0], v1[1]}), d = gelu_pk((f32x2){v1[2], v1[3]});
                        v0 = (f32x4){a.x, a.y, b.x, b.y}; v1 = (f32x4){c.x, c.y, d.x, d.y}; }
                    v0 = v0 * sc; v1 = v1 * sc; u32x4 w; w.x = cvt_pk_bf16(v0[0], v0[1]); w.y = cvt_pk_bf16(v0[2], v0[3]); w.z = cvt_pk_bf16(v1[0], v1[1]); w.w = cvt_pk_bf16(v1[2], v1[3]);
                    *(u32x4*)(rowp + bj * HALF) = w; } }
    }
};
struct EpiOut {
    static constexpr bool PERM = true, AFTER_DRAIN = true;
    const float* x; const float* ada; const float* norm2_g; float* x1out; bf16_t* xg; float* ssq4;
    __device__ __forceinline__ void fused(f32x4 (&acc)[2][2][4][2], const Unit& u, int wr, int wc, int fr, int fq, PG8_LAS unsigned char* lds, int wid, int lane) const {
        const int b = (u.pm * BM) / SEQ;
        const float* gate1 = ada + b * 6 * DM + 2 * DM; const float* scale2 = ada + b * 6 * DM + 4 * DM;
        const int col0 = u.pn * BM + wc * 32 + 8 * fq;
        PG8_LAS float* P = (PG8_LAS float*)lds;
        f32x4 gt[2][2], g2[2][2];
#pragma unroll
        for (int bj = 0; bj < 2; ++bj)
#pragma unroll
            for (int n = 0; n < 2; ++n) { const int c = col0 + bj * HALF + 4 * n; gt[bj][n] = *(const f32x4*)(gate1 + c); g2[bj][n] = *(const f32x4*)(norm2_g + c) * (*(const f32x4*)(scale2 + c) + 1.0f); }
#pragma unroll
        for (int ai = 0; ai < 2; ++ai)
#pragma unroll
            for (int m = 0; m < 4; ++m) { const int rl = ai * HALF + wr * 64 + m * 16 + fr; const size_t off = (size_t)(u.pm * BM + rl) * DM + col0; float ss = 0.f;
#pragma unroll
                for (int bj = 0; bj < 2; ++bj) {
                    const f32x4 x0 = *(const f32x4*)(x + off + bj * HALF), x1 = *(const f32x4*)(x + off + bj * HALF + 4);
                    const f32x4 v0 = x0 + gt[bj][0] * acc[ai][bj][m][0], v1 = x1 + gt[bj][1] * acc[ai][bj][m][1];
                    *(f32x4*)(x1out + off + bj * HALF) = v0; *(f32x4*)(x1out + off + bj * HALF + 4) = v1;
                    ss += (v0[0] * v0[0] + v0[1] * v0[1]) + (v0[2] * v0[2] + v0[3] * v0[3]) + (v1[0] * v1[0] + v1[1] * v1[1]) + (v1[2] * v1[2] + v1[3] * v1[3]);
                    const f32x4 w0 = v0 * g2[bj][0], w1 = v1 * g2[bj][1];
                    u32x4 w; w.x = cvt_pk_bf16(w0[0], w0[1]); w.y = cvt_pk_bf16(w0[2], w0[3]); w.z = cvt_pk_bf16(w1[0], w1[1]); w.w = cvt_pk_bf16(w1[2], w1[3]);
                    *(u32x4*)(xg + off + bj * HALF) = w; }
                ss += __shfl_xor(ss, 16); ss += __shfl_xor(ss, 32);
                if (fq == 0) P[rl * 4 + wc] = ss; }
        asm volatile("s_waitcnt lgkmcnt(0)" ::: "memory"); __builtin_amdgcn_s_barrier(); asm volatile("" ::: "memory");
        const int tid = wid * 64 + lane;
        if (tid < 256) ssq4[(size_t)(u.pm * BM + tid) * 4 + u.pn] = (P[tid * 4 + 0] + P[tid * 4 + 1]) + (P[tid * 4 + 2] + P[tid * 4 + 3]);
        asm volatile("s_waitcnt lgkmcnt(0)" ::: "memory"); __builtin_amdgcn_s_barrier(); asm volatile("" ::: "memory");
    }
};
struct EpiQuery {
    static constexpr bool PERM = true, AFTER_DRAIN = false;
    const float* ssq4; const float* sqb; bf16_t* qv;
    __device__ __forceinline__ void operator()(const f32x4 (&acc)[2][2][4][2], const Unit& u, int wr, int wc, int fr, int fq) const {
        const int b = (u.pm * BM) / SEQ;
        const int row0 = u.pm * BM + wr * 64 + fr, col0 = u.pn * BM + wc * 32 + 8 * fq;
        f32x4 bv[2][2];
#pragma unroll
        for (int bj = 0; bj < 2; ++bj)
#pragma unroll
            for (int n = 0; n < 2; ++n) bv[bj][n] = *(const f32x4*)(sqb + b * NQ + col0 + bj * HALF + 4 * n);
#pragma unroll
        for (int ai = 0; ai < 2; ++ai)
#pragma unroll
            for (int m = 0; m < 4; ++m) { const int row = row0 + ai * HALF + m * 16; const f32x4 s4 = *(const f32x4*)(ssq4 + (size_t)row * 4);
                const float rstd = rsqrtf(((s4[0] + s4[1]) + (s4[2] + s4[3])) * (1.f / DM) + EPS);
                bf16_t* rowp = qv + (size_t)row * NQ + col0;
#pragma unroll
                for (int bj = 0; bj < 2; ++bj) { const f32x4 v0 = acc[ai][bj][m][0] * rstd + bv[bj][0], v1 = acc[ai][bj][m][1] * rstd + bv[bj][1];
                    u32x4 w; w.x = cvt_pk_bf16(v0[0], v0[1]); w.y = cvt_pk_bf16(v0[2], v0[3]); w.z = cvt_pk_bf16(v1[0], v1[1]); w.w = cvt_pk_bf16(v1[2], v1[3]);
                    *(u32x4*)(rowp + bj * HALF) = w; } }
    }
};

template <class Epi, class Sched, bool ALIGN_EPI = false, bool SP2 = false>
__device__ __forceinline__ void gemm_phase(PG8_LAS unsigned char* lds, const Gemm g, const Sched& S, const Epi& E) {
    const int tid = threadIdx.x, wid = __builtin_amdgcn_readfirstlane(tid >> 6), lane = tid & 63, wr = wid >> 2, wc = wid & 3, fr = lane & 15, fq = lane >> 4;
    const int K = g.K, nt = K / BK;
    unsigned voffA[2], voffB[2];
#pragma unroll
    for (int i = 0; i < 2; ++i) { int R, C; stage_rc(tid * 16 + i * 8192, R, C); const int Rb = Epi::PERM ? ((R & ~31) + perm32(R & 31)) : R;
        voffA[i] = (unsigned)(R * K + C) * 2u; voffB[i] = (unsigned)(Rb * K + C) * 2u; }
    const size_t kstep = (size_t)(BK * 2);
    const size_t hstep = (size_t)HALF * K * 2;
    const size_t tstep = 2 * hstep;
    const unsigned ldsw = (unsigned)wid * 1024u;
    const int aoff = lds_byte(wr * 64 + fr, fq * 8), boff = lds_byte(wc * 32 + fr, fq * 8);
#define PG8_SA(b, h) (((b) * 2 + (h)) * HTB)
#define PG8_SB(b, h) ((4 + (b) * 2 + (h)) * HTB)
#define PG8_STAGE(bufoff, gbase, voff) do { _Pragma("unroll") for (int _i = 0; _i < 2; ++_i) \
        __builtin_amdgcn_global_load_lds((const unsigned*)((const char*)(gbase) + (voff)[_i]), (PG8_LAS unsigned*)(lds + (bufoff) + ldsw + _i * 8192), 16, 0, 0); } while (0)
#define PG8_LDA(dst, b, h) do { _Pragma("unroll") for (int m = 0; m < 4; ++m) _Pragma("unroll") for (int k = 0; k < 2; ++k) dst[m][k] = *(const PG8_LAS bf16x8*)(lds + PG8_SA(b, h) + aoff + m * 2048 + k * 1024); } while (0)
#define PG8_LDB(dst, b, h) do { _Pragma("unroll") for (int n = 0; n < 2; ++n) _Pragma("unroll") for (int k = 0; k < 2; ++k) dst[n][k] = *(const PG8_LAS bf16x8*)(lds + PG8_SB(b, h) + boff + n * 2048 + k * 1024); } while (0)
#define PG8_MMA(ai, bj, At, Bt) do { __builtin_amdgcn_s_setprio(1); _Pragma("unroll") for (int m = 0; m < 4; ++m) _Pragma("unroll") for (int n = 0; n < 2; ++n) _Pragma("unroll") for (int k = 0; k < 2; ++k) \
        acc[ai][bj][m][n] = __builtin_amdgcn_mfma_f32_16x16x32_bf16(Bt[n][k], At[m][k], acc[ai][bj][m][n], 0, 0, 0); __builtin_amdgcn_s_setprio(0); } while (0)
#define PG8_WAIT_V(n) asm volatile("s_waitcnt vmcnt(" #n ")" ::: "memory")
#define PG8_WAIT_L(n) asm volatile("s_waitcnt lgkmcnt(" #n ")" ::: "memory")
#define PG8_BAR __builtin_amdgcn_s_barrier()
#define PG8_SCHED __builtin_amdgcn_sched_barrier(0)
    Unit cur, nxt; int ui = 0;
    if (!S.next(0, cur)) return;
    f32x4 acc[2][2][4][2];
#pragma unroll
    for (int a = 0; a < 2; ++a)
#pragma unroll
        for (int b = 0; b < 2; ++b)
#pragma unroll
            for (int m = 0; m < 4; ++m)
#pragma unroll
                for (int n = 0; n < 2; ++n) acc[a][b][m][n] = (f32x4){0.f, 0.f, 0.f, 0.f};
    bf16x8 At[4][2], B0[2][2], B1[2][2];
    const char* cA = (const char*)g.A + (size_t)cur.pm * tstep; const char* cB = (const char*)g.Bt + (size_t)cur.pn * tstep;
    S.a_ready(cur);
    if constexpr (SP2) {
        PG8_STAGE(PG8_SB(0, 0), cB, voffB); PG8_STAGE(PG8_SB(0, 1), cB + hstep, voffB); PG8_STAGE(PG8_SA(0, 0), cA, voffA); PG8_STAGE(PG8_SA(0, 1), cA + hstep, voffA);
        if (wr == 1) PG8_BAR;
        PG8_WAIT_V(2); PG8_BAR;
        PG8_STAGE(PG8_SB(1, 0), cB + kstep, voffB); PG8_STAGE(PG8_SA(1, 0), cA + kstep, voffA); PG8_STAGE(PG8_SB(1, 1), cB + hstep + kstep, voffB);
        PG8_WAIT_V(6); PG8_BAR;
    } else {
        PG8_STAGE(PG8_SB(0, 0), cB, voffB); PG8_STAGE(PG8_SA(0, 0), cA, voffA); PG8_STAGE(PG8_SB(0, 1), cB + hstep, voffB); PG8_STAGE(PG8_SA(0, 1), cA + hstep, voffA);
        if (wr == 1) PG8_BAR;
        PG8_WAIT_V(4); PG8_BAR;
        PG8_STAGE(PG8_SB(1, 0), cB + kstep, voffB); PG8_STAGE(PG8_SA(1, 0), cA + kstep, voffA); PG8_STAGE(PG8_SB(1, 1), cB + hstep + kstep, voffB);
        PG8_WAIT_V(6); PG8_BAR;
    }
    for (;;) {
        const bool has_next = S.next(ui + 1, nxt);
        const char* nA = has_next ? (const char*)g.A + (size_t)nxt.pm * tstep : cA; const char* nB = has_next ? (const char*)g.Bt + (size_t)nxt.pn * tstep : cB;
        for (int t = 0; t < nt; t += 2) {
            const bool last = (t == nt - 2);
            const char* a1 = cA + (size_t)(t + 1) * kstep;
            const char* a2 = last ? nA : cA + (size_t)(t + 2) * kstep; const char* b2 = last ? nB : cB + (size_t)(t + 2) * kstep;
            const char* a3 = a2 + kstep; const char* b3 = b2 + kstep;
            if (last && has_next) S.a_ready(nxt);
            if constexpr (SP2) {
            PG8_LDB(B0, 0, 0); PG8_LDB(B1, 0, 1); PG8_SCHED; PG8_LDA(At, 0, 0); PG8_STAGE(PG8_SA(1, 1), a1 + hstep, voffA);
            PG8_WAIT_V(8); PG8_WAIT_L(0); PG8_BAR; PG8_MMA(0, 0, At, B0); PG8_MMA(0, 1, At, B1); PG8_BAR; PG8_SCHED;
            PG8_LDA(At, 0, 1); PG8_STAGE(PG8_SB(0, 0), b2, voffB); PG8_STAGE(PG8_SB(0, 1), b2 + hstep, voffB); PG8_STAGE(PG8_SA(0, 0), a2, voffA);
            PG8_WAIT_V(8); PG8_WAIT_L(0); PG8_BAR; PG8_MMA(1, 0, At, B0); PG8_MMA(1, 1, At, B1); PG8_BAR; PG8_SCHED;
            PG8_LDB(B0, 1, 0); PG8_LDB(B1, 1, 1); PG8_SCHED; PG8_LDA(At, 1, 0); PG8_STAGE(PG8_SA(0, 1), a2 + hstep, voffA);
            PG8_WAIT_V(8); PG8_WAIT_L(0); PG8_BAR; PG8_MMA(0, 0, At, B0); PG8_MMA(0, 1, At, B1); PG8_BAR; PG8_SCHED;
            PG8_LDA(At, 1, 1); PG8_STAGE(PG8_SB(1, 0), b3, voffB); PG8_STAGE(PG8_SB(1, 1), b3 + hstep, voffB); PG8_STAGE(PG8_SA(1, 0), a3, voffA);
            PG8_WAIT_V(8); PG8_WAIT_L(0); PG8_BAR; PG8_MMA(1, 0, At, B0); PG8_MMA(1, 1, At, B1); PG8_BAR; PG8_SCHED;
            } else {
            PG8_LDB(B0, 0, 0); PG8_SCHED; PG8_LDA(At, 0, 0); PG8_STAGE(PG8_SA(1, 1), a1 + hstep, voffA);
            PG8_WAIT_L(8); PG8_BAR; PG8_WAIT_L(0); PG8_MMA(0, 0, At, B0); PG8_BAR; PG8_SCHED;
            PG8_LDB(B1, 0, 1); PG8_STAGE(PG8_SB(0, 0), b2, voffB);
            PG8_BAR; PG8_WAIT_L(0); PG8_MMA(0, 1, At, B1); PG8_BAR;
            PG8_LDA(At, 0, 1); PG8_STAGE(PG8_SA(0, 0), a2, voffA);
            PG8_BAR; PG8_WAIT_L(0); PG8_MMA(1, 0, At, B0); PG8_BAR; PG8_SCHED;
            PG8_STAGE(PG8_SB(0, 1), b2 + hstep, voffB);
            PG8_WAIT_V(6); PG8_BAR; PG8_MMA(1, 1, At, B1); PG8_BAR;
            PG8_LDB(B0, 1, 0); PG8_SCHED; PG8_LDA(At, 1, 0); PG8_STAGE(PG8_SA(0, 1), a2 + hstep, voffA);
            PG8_WAIT_L(8); PG8_BAR; PG8_WAIT_L(0); PG8_MMA(0, 0, At, B0); PG8_BAR; PG8_SCHED;
            PG8_LDB(B1, 1, 1); PG8_STAGE(PG8_SB(1, 0), b3, voffB);
            PG8_BAR; PG8_WAIT_L(0); PG8_MMA(0, 1, At, B1); PG8_BAR;
            PG8_LDA(At, 1, 1); PG8_STAGE(PG8_SA(1, 0), a3, voffA);
            PG8_BAR; PG8_WAIT_L(0); PG8_MMA(1, 0, At, B0); PG8_BAR; PG8_SCHED;
            PG8_STAGE(PG8_SB(1, 1), b3 + hstep, voffB);
            PG8_WAIT_V(6); PG8_BAR; PG8_MMA(1, 1, At, B1); PG8_BAR;
            }
        }
        if constexpr (ALIGN_EPI) { if (wr == 0) PG8_BAR; }
        if constexpr (!Epi::AFTER_DRAIN) { E(acc, cur, wr, wc, fr, fq); S.done(cur); }
        if (!has_next) break;
#pragma unroll
        for (int a = 0; a < 2; ++a)
#pragma unroll
            for (int b = 0; b < 2; ++b)
#pragma unroll
                for (int m = 0; m < 4; ++m)
#pragma unroll
                    for (int n = 0; n < 2; ++n) acc[a][b][m][n] = (f32x4){0.f, 0.f, 0.f, 0.f};
        cur = nxt; cA = nA; cB = nB; ++ui;
        if constexpr (ALIGN_EPI) { if (wr == 1) PG8_BAR; }
    }
    PG8_WAIT_V(0);
    if constexpr (!ALIGN_EPI) { if (wr == 0) PG8_BAR; }
    PG8_BAR;
    if constexpr (Epi::AFTER_DRAIN) { E.fused(acc, cur, wr, wc, fr, fq, lds, wid, lane); S.done(cur); }
#undef PG8_SA
#undef PG8_SB
#undef PG8_STAGE
#undef PG8_LDA
#undef PG8_LDB
#undef PG8_MMA
#undef PG8_WAIT_V
#undef PG8_WAIT_L
#undef PG8_BAR
#undef PG8_SCHED
}
}

using pg8::bf16x8; using pg8::f32x4;
#define XB_TMO      128
#define XB_XCNT(j)  (256  + 64 * (j))
#define XB_XSUB(j)  (1280 + 64 * (j))
#define XB_XGEN(j)  (2304 + 64 * (j))
#define XB_TOP      3328
#define XB_TOPGEN   3392
#define XCD_BAR_WORDS 3456
#define XB_SPIN_CAP (1u << 18)
__device__ __forceinline__ unsigned xb_ld(unsigned* p)              { return __hip_atomic_load(p, __ATOMIC_RELAXED, __HIP_MEMORY_SCOPE_AGENT); }
__device__ __forceinline__ unsigned xb_add(unsigned* p, unsigned v) { return __hip_atomic_fetch_add(p, v, __ATOMIC_RELAXED, __HIP_MEMORY_SCOPE_AGENT); }
__device__ __forceinline__ unsigned xb_xcc_id() { return (unsigned)__builtin_amdgcn_s_getreg((3 << 11) | 20) & 0xFu; }
#define XB_SPIN(cond, bar) do { unsigned _sp = 0; while (cond) { __builtin_amdgcn_s_sleep(1); \
    if ((++_sp & 255u) == 0u) { if (xb_ld(&(bar)[XB_TMO])) break; if (_sp > XB_SPIN_CAP) { atomicAdd(&(bar)[XB_TMO], 1u); break; } } } } while (0)
struct XcdBarrier { unsigned* bar; unsigned x; volatile LAS unsigned* st; };
__device__ __forceinline__ XcdBarrier xcd_barrier_post(unsigned* bar, volatile LAS unsigned* st) {
    XcdBarrier b; b.bar = bar; b.x = xb_xcc_id(); b.st = st;
    if (threadIdx.x == 0) (void)xb_add(&bar[XB_XCNT(b.x)], 1u);
    return b;
}
__device__ __forceinline__ void xcd_barrier_complete(unsigned* bar, unsigned x, unsigned& nloc, unsigned& nx) {
    const unsigned G = gridDim.x * gridDim.y * gridDim.z;
    unsigned sum, cnt, mine, sp = 0u;
    for (;;) {
        sum = 0u; cnt = 0u; mine = 0u;
#pragma unroll
        for (unsigned j = 0; j < 16; ++j) { const unsigned c = xb_ld(&bar[XB_XCNT(j)]); sum += c; cnt += (c > 0u) ? 1u : 0u; mine = (j == x) ? c : mine; }
        if (sum == G) break;
        __builtin_amdgcn_s_sleep(1);
        if ((++sp & 255u) == 0u) { if (xb_ld(&bar[XB_TMO])) break; if (sp > XB_SPIN_CAP) { atomicAdd(&bar[XB_TMO], 1u); break; } }
    }
    nloc = mine > 0u ? mine : 1u; nx = cnt > 0u ? cnt : 1u;
}
__device__ __forceinline__ void xcd_barrier(const XcdBarrier& b) {
    asm volatile("s_waitcnt vmcnt(0)" ::: "memory");
    __syncthreads();
    if (threadIdx.x == 0) {
        unsigned* bar = b.bar;
        __builtin_amdgcn_s_waitcnt(0);
        unsigned nloc = b.st[0], nx = b.st[1];
        if (nloc == 0u) { xcd_barrier_complete(bar, b.x, nloc, nx); b.st[0] = nloc; b.st[1] = nx; }
        const unsigned old = xb_add(&bar[XB_XSUB(b.x)], 1u);
        const unsigned gen = old / nloc;
        if (old + 1u == (gen + 1u) * nloc) {
            __builtin_amdgcn_fence(__ATOMIC_RELEASE, "agent");
            asm volatile("s_waitcnt vmcnt(0)" ::: "memory");
            const unsigned og = xb_add(&bar[XB_TOP], 1u);
            const unsigned tg = og / nx;
            if (og + 1u == (tg + 1u) * nx) xb_add(&bar[XB_TOPGEN], 1u);
            else XB_SPIN(xb_ld(&bar[XB_TOPGEN]) == tg, bar);
            __builtin_amdgcn_fence(__ATOMIC_ACQUIRE, "agent");
            xb_add(&bar[XB_XGEN(b.x)], 1u);
            asm volatile("s_waitcnt vmcnt(0)" ::: "memory");
        } else {
            XB_SPIN(xb_ld(&bar[XB_XGEN(b.x)]) == gen, bar);
            __builtin_amdgcn_fence(__ATOMIC_ACQUIRE, "agent");
            asm volatile("s_waitcnt vmcnt(0)" ::: "memory");
        }
    }
    __syncthreads();
}
constexpr int LDS_BYTES = 147456, LDSCTL_OFF = 131072, MISC_OFF = LDSCTL_OFF + 320;

__device__ __forceinline__ void gemv8_task(float* lds, const float* W, int ldw, int n0, const float* bias, float* out, int ldo, int tid) {
    const int wave = tid >> 6, lane = tid & 63;
    float acc[8];
#pragma unroll
    for (int b = 0; b < 8; ++b) acc[b] = 0.f;
    const float* wp = W + (size_t)(wave * 128) * ldw + n0 + lane;
    const float* As = lds + wave * 128;
    for (int k = 0; k < 128; k += 8) {
        float wv[8];
#pragma unroll
        for (int i = 0; i < 8; ++i) wv[i] = wp[(size_t)(k + i) * ldw];
#pragma unroll
        for (int i = 0; i < 8; ++i)
#pragma unroll
            for (int b = 0; b < 8; ++b) acc[b] = fmaf(As[b * 1024 + k + i], wv[i], acc[b]);
    }
    float* red = lds + 8192;
#pragma unroll
    for (int b = 0; b < 8; ++b) red[(wave * 8 + b) * 64 + lane] = acc[b];
    __syncthreads();
    { const int b = tid >> 6; float s = 0.f;
#pragma unroll
      for (int w = 0; w < 8; ++w) s += red[(w * 8 + b) * 64 + lane];
      out[b * ldo + n0 + lane] = s + (bias ? bias[n0 + lane] : 0.f); }
    __syncthreads();
}
__device__ __forceinline__ void transpose_item(const float* W, int K, int ldw, int nblk, bf16_t* WT, float* scr, int item, int lane) {
    const int kb = item / nblk, nb = item % nblk, k0 = 64 * kb, n0 = 32 * nb;
#pragma unroll 8
    for (int i = 0; i < 32; ++i) { const int kk = 2 * i + (lane >> 5); scr[kk * 33 + (lane & 31)] = W[(size_t)(k0 + kk) * ldw + n0 + (lane & 31)]; }
    WAVE_LDS_FENCE();
    const int c = lane & 7;
#pragma unroll
    for (int j = 0; j < 4; ++j) { const int n = (lane >> 3) + 8 * j; const float* s = scr + (8 * c) * 33 + n;
        uint4 o; o.x = pk2(s[0 * 33], s[1 * 33]); o.y = pk2(s[2 * 33], s[3 * 33]); o.z = pk2(s[4 * 33], s[5 * 33]); o.w = pk2(s[6 * 33], s[7 * 33]);
        *(uint4*)(WT + (size_t)(n0 + n) * K + k0 + 8 * c) = o; }
    WAVE_LDS_FENCE();
}
__device__ __forceinline__ void cvt512(const float* src, bf16_t* dst, int lane) {
    const float4 a = *(const float4*)(src + 8 * lane), b = *(const float4*)(src + 8 * lane + 4);
    uint4 o; o.x = pk2(a.x, a.y); o.y = pk2(a.z, a.w); o.z = pk2(b.x, b.y); o.w = pk2(b.z, b.w);
    *(uint4*)(dst + 8 * lane) = o;
}

__global__ void __launch_bounds__(NTHR, 2) fwd_kernel(Args a) {
    extern __shared__ __attribute__((aligned(16))) unsigned char lds_raw[];
    float* lds = (float*)lds_raw;
    const int tid = threadIdx.x, lane = tid & 63, wave = __builtin_amdgcn_readfirstlane(tid >> 6);
    const int gw = blockIdx.x * NWAVE + wave, ngw = gridDim.x * NWAVE;
    unsigned char* ws = a.ws;
    float* ADA = (float*)(ws + WS_ADA); float* SQB = (float*)(ws + WS_SQB); float* FL = (float*)(ws + WS_FL); float* GQ = (float*)(ws + WS_GQ); float* SSQ = (float*)(ws + WS_SSQ);
    bf16_t* WIN = (bf16_t*)(ws + WS_WIN); bf16_t* WOUT = (bf16_t*)(ws + WS_WOUT); bf16_t* WQ = (bf16_t*)(ws + WS_WQ); bf16_t* SUBK = (bf16_t*)(ws + WS_SUBK); bf16_t* SGWB = (bf16_t*)(ws + WS_SGW);
    bf16_t* GX = (bf16_t*)(ws + WS_GX); bf16_t* EU = (bf16_t*)(ws + WS_EU); bf16_t* EV = (bf16_t*)(ws + WS_EV); bf16_t* HB = (bf16_t*)(ws + WS_HB);
    bf16_t* ZU = (bf16_t*)(ws + WS_ZU); bf16_t* ZV = (bf16_t*)(ws + WS_ZV); bf16_t* Q = (bf16_t*)(ws + WS_Q); bf16_t* K = (bf16_t*)(ws + WS_K); bf16_t* V = (bf16_t*)(ws + WS_V);
    bf16_t* XG = (bf16_t*)(ws + WS_XG); bf16_t* QV = (bf16_t*)(ws + WS_QV); int* IDX = (int*)(ws + WS_IDX); float* GATE = (float*)(ws + WS_GATE);
    for (int u = tid; u < (LDS_BYTES - LDSCTL_OFF) / 4; u += NTHR) ((LAS unsigned*)((LAS unsigned char*)lds_raw + LDSCTL_OFF))[u] = 0u;
    __syncthreads();
    XcdBarrier bar = xcd_barrier_post((unsigned*)(ws + WS_CTL), (volatile LAS unsigned*)((LAS unsigned char*)lds_raw + MISC_OFF) + 8);
#define GRID_BAR() xcd_barrier(bar)

    {
        if (blockIdx.x < 96) {
            for (int i = tid; i < NB * DM; i += NTHR) { const float cv = a.c[i]; lds[i] = cv / (1.f + expf(-cv)); }
            __syncthreads();
            gemv8_task(lds, a.w_ada, 6 * DM, blockIdx.x * 64, a.b_ada, ADA, 6 * DM, tid);
        }
        float* scr = lds + 12288 + wave * 2112;
        constexpr int I_IN = 16 * 80, I_OUT = 16 * 32, I_Q = 16 * 64;
        for (int it = gw; it < I_IN + I_OUT + I_Q; it += ngw) {
            int r = it;
            if (r < I_IN) { transpose_item(a.w_in, DM, INC, 80, WIN, scr, r, lane); continue; } r -= I_IN;
            if (r < I_OUT) { transpose_item(a.w_out, DM, DM, 32, WOUT, scr, r, lane); continue; } r -= I_OUT;
            transpose_item(a.w_query, DM, NQ, 64, WQ, scr, r, lane);
        }
        for (int it = gw; it < 512; it += ngw) cvt512(a.sub_keys + (size_t)it * 512, SUBK + (size_t)it * 512, lane);
        for (int it = gw; it < 256; it += ngw) {
            const int e0 = it * 512 + 8 * lane, t = (e0 >> 7) & 127, s0 = e0 & 127;
            const float4 p = *(const float4*)(a.sg_w + e0), q = *(const float4*)(a.sg_w + e0 + 4);
            const float v[8] = {p.x, p.y, p.z, p.w, q.x, q.y, q.z, q.w}; float m[8];
#pragma unroll
            for (int i = 0; i < 8; ++i) m[i] = (s0 + i <= t) ? v[i] : 0.f;
            uint4 o; o.x = pk2(m[0], m[1]); o.y = pk2(m[2], m[3]); o.z = pk2(m[4], m[5]); o.w = pk2(m[6], m[7]);
            *(uint4*)(SGWB + e0) = o;
        }
        for (int it = gw; it < 2 * 32768; it += ngw) {
            if (it < 32768) cvt512(a.expert_u + (size_t)it * 512, EU + (size_t)it * 512, lane);
            else cvt512(a.expert_v + (size_t)(it - 32768) * 512, EV + (size_t)(it - 32768) * 512, lane);
        }
    }
    GRID_BAR();
    {
        for (int i = tid; i < 8 * DM; i += NTHR) { const int k = i >> 3, j = i & 7; lds[j * DM + k] = a.w_in[(size_t)k * INC + NPROJ + j]; }
        __syncthreads();
        for (int t = gw; t < NT; t += ngw) {
            const int b = t / SEQ; const float* xr = a.x + (size_t)t * DM; const float* shift = ADA + b * 6 * DM; const float* scale = shift + DM;
            float4 v[4]; float s = 0.f;
#pragma unroll
            for (int j = 0; j < 4; ++j) { v[j] = *(const float4*)(xr + 256 * j + 4 * lane); s += v[j].x * v[j].x + v[j].y * v[j].y + v[j].z * v[j].z + v[j].w * v[j].w; }
            const float rstd = rsqrtf(wave_sum(s) * (1.f / DM) + EPS);
#pragma unroll
            for (int j = 0; j < 4; ++j) {
                const int c = 256 * j + 4 * lane;
                const float4 gg = *(const float4*)(a.norm1_g + c), sh = *(const float4*)(shift + c), sc = *(const float4*)(scale + c);
                v[j].x = v[j].x * rstd * gg.x * (1.f + sc.x) + sh.x; v[j].y = v[j].y * rstd * gg.y * (1.f + sc.y) + sh.y;
                v[j].z = v[j].z * rstd * gg.z * (1.f + sc.z) + sh.z; v[j].w = v[j].w * rstd * gg.w * (1.f + sc.w) + sh.w;
                uint2 o; o.x = pk2(v[j].x, v[j].y); o.y = pk2(v[j].z, v[j].w);
                *(uint2*)(HB + (size_t)t * DM + c) = o;
            }
            float fl = 0.f;
#pragma unroll
            for (int j8 = 0; j8 < 8; ++j8) { float d = 0.f;
#pragma unroll
                for (int j = 0; j < 4; ++j) { const float4 w = *(const float4*)(lds + j8 * DM + 256 * j + 4 * lane); d += v[j].x * w.x + v[j].y * w.y + v[j].z * w.z + v[j].w * w.w; }
                d = wave_sum(d); if (lane == j8) fl = d; }
            if (lane < 8) FL[(size_t)t * 8 + lane] = log_sigmoid(fl + a.b_f[lane]);
        }
        __syncthreads();
        if (blockIdx.x < 32) {
            for (int i = tid; i < NB * DM; i += NTHR) lds[i] = ADA[(i >> 10) * 6 * DM + 3 * DM + (i & 1023)];
            __syncthreads();
            gemv8_task(lds, a.w_query, NQ, blockIdx.x * 64, nullptr, SQB, NQ, tid);
        }
    }
    GRID_BAR();
    {
        if (gw < NB * NH) {
            const int b = gw >> 3, h = gw & 7; float v[32]; float run = 0.f;
#pragma unroll
            for (int i = 0; i < 32; ++i) { run += FL[((size_t)b * SEQ + 32 * lane + i) * 8 + h]; v[i] = run; }
            float incl = run;
#pragma unroll
            for (int o = 1; o < 64; o <<= 1) { const float n = __shfl_up(incl, o); if (lane >= o) incl += n; }
            const float excl = incl - run;
#pragma unroll
            for (int i = 0; i < 32; ++i) {
                const size_t e = ((size_t)b * SEQ + 32 * lane + i) * 8 + h; const float g = (excl + v[i]) * LOG2E; GQ[e] = g;
                const float ng = -g; const unsigned g1 = f2bf(ng); const float r1 = ng - __uint_as_float(g1 << 16); const unsigned g2 = f2bf(r1); const float r2 = r1 - __uint_as_float(g2 << 16); const unsigned g3 = f2bf(r2);
                uint4 o; o.x = g1 | (g2 << 16); o.y = g3; o.z = 0u; o.w = 0u; *(uint4*)(GX + e * 8) = o;
            }
        }
        pg8::Gemm g{HB, WIN, NT, NPROJ, DM}; pg8::StaticOrder S; S.init(NT, NPROJ, gridDim.x, (int)blockIdx.x);
        pg8::EpiProj E{ZU};
        pg8::gemm_phase<pg8::EpiProj, pg8::StaticOrder, true, true>((PG8_LAS unsigned char*)lds_raw, g, S, E);
    }
    GRID_BAR();
    {
        bf16_t* Y = HB;
        for (int task = blockIdx.x; task < NB * (SEQ / CHUNK) * NH; task += gridDim.x) {
            const int h = task % NH, bc = task / NH, t0 = bc * CHUNK;
            float* vn = lds; float* yb = lds + 8192;
            __syncthreads();
            if (tid < 128) {
                const bf16_t* zr = ZV + (size_t)(t0 + tid) * 512 + h * 64; float mu = 0.f;
                for (int d = 0; d < 64; ++d) mu += bf2f(zr[d]);
                mu *= (1.f / 64); float var = 0.f;
                for (int d = 0; d < 64; ++d) { const float dd = bf2f(zr[d]) - mu; var += dd * dd; }
                const float rs = rsqrtf(var * (1.f / 64) + EPS);
                for (int d = 0; d < 64; ++d) vn[tid * 64 + d] = (bf2f(zr[d]) - mu) * rs * a.sg_ln_g[h * 64 + d] + a.sg_ln_b[h * 64 + d];
            }
            __syncthreads();
            for (int o = tid; o < 128 * 64; o += NTHR) {
                const int t = o >> 6, d = o & 63; float s = 0.f; const float* wr = a.sg_w + ((size_t)h * 128 + t) * 128;
                for (int sidx = 0; sidx <= t; ++sidx) s = fmaf(wr[sidx], vn[sidx * 64 + d], s);
                s += a.sg_b[h * 128 + t];
                yb[o] = bf2f(ZU[(size_t)(t0 + t) * 512 + h * 64 + d]) * s;
            }
            __syncthreads();
            for (int o = tid; o < 128 * 64; o += NTHR) {
                const int t = o >> 6, d = o & 63; float ss = 0.f;
                for (int e = 0; e < 64; ++e) ss += yb[t * 64 + e] * yb[t * 64 + e];
                Y[(size_t)(t0 + t) * DM + h * 64 + d] = (bf16_t)f2bf(yb[o] * rsqrtf(ss * (1.f / 64) + EPS) * a.out_g_sg[h * 64 + d]);
            }
        }
        __syncthreads();
        float* sc = lds + wave * 2048;
        for (int task = gw; task < NB * NH * SEQ; task += ngw) {
            const int t = task % SEQ, bh = task / SEQ, h = bh % NH, b = bh / NH;
            const size_t row = (size_t)b * SEQ + t;
            const float qd = bf2f(Q[row * 512 + h * 64 + lane]);
            const float Gt = GQ[row * 8 + h];
            float mx = -INFINITY;
            for (int s0 = 0; s0 <= t; s0 += 64) {
                const int s = s0 + lane, sl = s <= t ? s : t; float dot = 0.f;
                const bf16_t* kr = K + ((size_t)b * SEQ + sl) * 512 + h * 64;
                for (int d = 0; d < 64; ++d) dot = fmaf(__shfl(qd, d), bf2f(kr[d]), dot);
                float lg = dot + Gt - GQ[((size_t)b * SEQ + sl) * 8 + h];
                if (s > t) lg = -INFINITY;
                sc[s] = lg; mx = fmaxf(mx, lg);
            }
            WAVE_LDS_FENCE();
            mx = wave_max(mx);
            float sum = 0.f;
            for (int s0 = 0; s0 <= t; s0 += 64) { const int s = s0 + lane; const float p = (s <= t) ? exp2f(sc[s] - mx) : 0.f; sc[s] = p; sum += p; }
            sum = wave_sum(sum);
            WAVE_LDS_FENCE();
            float o = 0.f;
            const int smax = ((t >> 6) + 1) << 6;
            for (int s = 0; s < smax; ++s) { const int ss = s <= t ? s : t; o = fmaf(sc[s], bf2f(V[((size_t)b * SEQ + ss) * 512 + h * 64 + lane]), o); }
            o /= sum;
            const float r = rsqrtf(wave_sum(o * o) * (1.f / 64) + EPS);
            Y[row * DM + 512 + h * 64 + lane] = (bf16_t)f2bf(o * r * a.out_g_fox[h * 64 + lane]);
            WAVE_LDS_FENCE();
        }
    }
    GRID_BAR();
    {
        pg8::Gemm g{HB, WOUT, NT, DM, DM}; pg8::StaticOrder S; S.init(NT, DM, gridDim.x, (int)blockIdx.x);
        pg8::EpiOut E{a.x, ADA, a.norm2_g, a.out, XG, SSQ};
        pg8::gemm_phase<pg8::EpiOut, pg8::StaticOrder, false, true>((PG8_LAS unsigned char*)lds_raw, g, S, E);
    }
    GRID_BAR();
    {
        pg8::Gemm g{XG, WQ, NT, NQ, DM}; pg8::StaticOrder S; S.init(NT, NQ, gridDim.x, (int)blockIdx.x);
        pg8::EpiQuery E{SSQ, SQB, QV};
        pg8::gemm_phase<pg8::EpiQuery, pg8::StaticOrder, true, true>((PG8_LAS unsigned char*)lds_raw, g, S, E);
    }
    GRID_BAR();
    {
        float* qs = lds + wave * 256;
        for (int task = gw; task < NT * PH; task += ngw) {
            const int t = task / PH, h = task % PH;
            WAVE_LDS_FENCE();
            for (int i = lane; i < 256; i += 64) qs[i] = bf2f(QV[(size_t)t * NQ + h * 256 + i]);
            WAVE_LDS_FENCE();
            float sv[2]; int si[2];
            sv[0] = sv[1] = 0.f; si[0] = si[1] = 0;
#pragma unroll
            for (int p = 0; p < 2; ++p) {
                float s0 = 0.f, s1 = 0.f;
                const float* k0 = a.sub_keys + (((size_t)h * 2 + p) * NKEYS + lane) * DHALF;
                const float* k1 = k0 + 64 * DHALF;
                for (int d = 0; d < DHALF; ++d) { const float qq = qs[p * 128 + d]; s0 = fmaf(qq, k0[d], s0); s1 = fmaf(qq, k1[d], s1); }
                for (int r = 0; r < TOPK; ++r) {
                    float bv; int bi;
                    if (s0 >= s1) { bv = s0; bi = lane; } else { bv = s1; bi = lane + 64; }
#pragma unroll
                    for (int o = 1; o < 64; o <<= 1) { const float ov = __shfl_xor(bv, o); const int oi = __shfl_xor(bi, o); if (ov > bv || (ov == bv && oi < bi)) { bv = ov; bi = oi; } }
                    if (lane == r) { sv[p] = bv; si[p] = bi; }
                    if (bi == lane) s0 = -INFINITY; if (bi == lane + 64) s1 = -INFINITY;
                }
            }
            float cv[4];
#pragma unroll
            for (int j = 0; j < 4; ++j) { const int c = lane + 64 * j; cv[j] = __shfl(sv[0], c >> 4) + __shfl(sv[1], c & 15); }
            float ts = 0.f; int tpos = 0;
            for (int r = 0; r < TOPK; ++r) {
                float bv = cv[0]; int bi = lane;
#pragma unroll
                for (int j = 1; j < 4; ++j) if (cv[j] > bv) { bv = cv[j]; bi = lane + 64 * j; }
#pragma unroll
                for (int o = 1; o < 64; o <<= 1) { const float ov = __shfl_xor(bv, o); const int oi = __shfl_xor(bi, o); if (ov > bv || (ov == bv && oi < bi)) { bv = ov; bi = oi; } }
                if (lane == r) { ts = bv; tpos = bi; }
#pragma unroll
                for (int j = 0; j < 4; ++j) if (bi == lane + 64 * j) cv[j] = -INFINITY;
            }
            const float tmax = __shfl(ts, 0);
            float e = lane < 16 ? expf(ts - tmax) : 0.f;
            const float esum = wave_sum(e);
            const int ia = __shfl(si[0], tpos >> 4), ib = __shfl(si[1], tpos & 15);
            if (lane < 16) { IDX[(size_t)t * 128 + h * 16 + lane] = ia * NKEYS + ib; GATE[(size_t)t * 128 + h * 16 + lane] = e / esum; }
        }
    }
    GRID_BAR();
    {
        for (int t = gw; t < NT; t += ngw) {
            const int b = t / SEQ;
            const float4 s4 = *(const float4*)(SSQ + (size_t)t * 4);
            const float rstd2 = rsqrtf(((s4.x + s4.y) + (s4.z + s4.w)) * (1.f / DM) + EPS);
            float4 hv[4], acc[4];
#pragma unroll
            for (int j = 0; j < 4; ++j) {
                const int c = 256 * j + 4 * lane; const uint2 xg = *(const uint2*)(XG + (size_t)t * DM + c); const float4 sh = *(const float4*)(ADA + b * 6 * DM + 3 * DM + c);
                hv[j].x = __uint_as_float(xg.x << 16) * rstd2 + sh.x; hv[j].y = __uint_as_float(xg.x & 0xffff0000u) * rstd2 + sh.y;
                hv[j].z = __uint_as_float(xg.y << 16) * rstd2 + sh.z; hv[j].w = __uint_as_float(xg.y & 0xffff0000u) * rstd2 + sh.w;
                acc[j] = make_float4(0.f, 0.f, 0.f, 0.f);
            }
            for (int e = 0; e < 128; ++e) {
                const int idx = IDX[(size_t)t * 128 + e]; const float g = GATE[(size_t)t * 128 + e];
                const bf16_t* ur = EU + (size_t)idx * DM; const bf16_t* vr = EV + (size_t)idx * DM;
                float s = 0.f;
#pragma unroll
                for (int j = 0; j < 4; ++j) { const uint2 u = *(const uint2*)(ur + 256 * j + 4 * lane);
                    s += __uint_as_float(u.x << 16) * hv[j].x + __uint_as_float(u.x & 0xffff0000u) * hv[j].y + __uint_as_float(u.y << 16) * hv[j].z + __uint_as_float(u.y & 0xffff0000u) * hv[j].w; }
                s = wave_sum(s);
                const float w = g * gelu_exact(s);
#pragma unroll
                for (int j = 0; j < 4; ++j) { const uint2 v = *(const uint2*)(vr + 256 * j + 4 * lane);
                    acc[j].x = fmaf(w, __uint_as_float(v.x << 16), acc[j].x); acc[j].y = fmaf(w, __uint_as_float(v.x & 0xffff0000u), acc[j].y);
                    acc[j].z = fmaf(w, __uint_as_float(v.y << 16), acc[j].z); acc[j].w = fmaf(w, __uint_as_float(v.y & 0xffff0000u), acc[j].w); }
            }
            float ss = 0.f; float4 x2[4];
#pragma unroll
            for (int j = 0; j < 4; ++j) {
                const int c = 256 * j + 4 * lane; const float4 x1 = *(const float4*)(a.out + (size_t)t * DM + c); const float4 g2 = *(const float4*)(ADA + b * 6 * DM + 5 * DM + c);
                x2[j].x = x1.x + g2.x * acc[j].x; x2[j].y = x1.y + g2.y * acc[j].y; x2[j].z = x1.z + g2.z * acc[j].z; x2[j].w = x1.w + g2.w * acc[j].w;
                ss += x2[j].x * x2[j].x + x2[j].y * x2[j].y + x2[j].z * x2[j].z + x2[j].w * x2[j].w;
            }
            const float rstd = rsqrtf(wave_sum(ss) * (1.f / DM) + EPS);
#pragma unroll
            for (int j = 0; j < 4; ++j) {
                const int c = 256 * j + 4 * lane; const float4 fg = *(const float4*)(a.final_g + c); float4 o;
                o.x = x2[j].x * rstd * fg.x; o.y = x2[j].y * rstd * fg.y; o.z = x2[j].z * rstd * fg.z; o.w = x2[j].w * rstd * fg.w;
                *(float4*)(a.out + (size_t)t * DM + c) = o;
            }
        }
    }
}

extern "C" void kernel_launch(void* const* d_in, const int* in_sizes, int n_in, void* d_out, int out_size, void* d_ws, size_t ws_size, hipStream_t stream) {
    if (n_in != 20 || ws_size < WS_END) { fprintf(stderr, "kernel_launch: unexpected n_in %d or ws_size %zu\n", n_in, ws_size); return; }
    Args a{};
    const float** p = (const float**)&a;
    for (int i = 0; i < 20; ++i) p[i] = (const float*)d_in[i];
    a.out = (float*)d_out; a.ws = (unsigned char*)d_ws;
    static int grid = 0;
    if (grid == 0) {
        int dev = 0, cus = 0, per_cu = 0;
        (void)hipGetDevice(&dev); (void)hipDeviceGetAttribute(&cus, hipDeviceAttributeMultiprocessorCount, dev);
        (void)hipFuncSetAttribute((const void*)fwd_kernel, hipFuncAttributeMaxDynamicSharedMemorySize, LDS_BYTES);
        (void)hipOccupancyMaxActiveBlocksPerMultiprocessor(&per_cu, (const void*)fwd_kernel, NTHR, LDS_BYTES);
        (void)hipGetLastError();
        if (per_cu < 1 || cus != 256) { fprintf(stderr, "kernel_launch: occupancy query says %d blocks/CU, %d CUs (built for one block on each of 256 CUs)\n", per_cu, cus); grid = -1; }
        else grid = cus;
    }
    if (grid < 0) return;
    (void)hipMemsetAsync((char*)d_ws + WS_CTL, 0, CTL_ZERO_BYTES, stream);
    a.ph_lo = 0; a.ph_hi = 10;
    hipLaunchKernelGGL(fwd_kernel, dim3(grid), dim3(NTHR), LDS_BYTES, stream, a);
}
```

```cpp
#include <hip/hip_runtime.h>
#include <cstdint>
#include <cstdio>
#include <cmath>

constexpr int DM = 1024, NB = 8, SEQ = 2048, NT = NB * SEQ;
constexpr int HD = 64, SGW = 512, FOXW = 512, NH = 8, CHUNK = 128;
constexpr int INC = 2 * SGW + 3 * FOXW + NH;
constexpr int NPROJ = 2560;
constexpr int PH = 8, NKEYS = 128, NEXP = NKEYS * NKEYS, TOPK = 16, DKEY = 256, DHALF = 128, NQ = PH * DKEY;
constexpr float EPS = 1e-6f;
constexpr int NTHR = 512, NWAVE = 8;
constexpr float LOG2E = 1.4426950408889634f;
constexpr float C2 = 0.125f * LOG2E;

typedef unsigned short bf16_t;

constexpr size_t MiB = 1u << 20;
constexpr size_t WS_CTL = 0, CTL_ZERO_BYTES = 64 * 1024;
constexpr size_t WS_ADA = 256 * 1024;
constexpr size_t WS_SQB = 512 * 1024;
constexpr size_t WS_FL = 1 * MiB;
constexpr size_t WS_GQ = WS_FL + MiB / 2;
constexpr size_t WS_SSQ = 2 * MiB;
constexpr size_t WS_WIN = 3 * MiB;
constexpr size_t WS_WOUT = WS_WIN + 5 * MiB;
constexpr size_t WS_WQ = WS_WOUT + 2 * MiB;
constexpr size_t WS_SUBK = WS_WQ + 4 * MiB;
constexpr size_t WS_SGW = WS_SUBK + MiB;
constexpr size_t WS_GX = WS_SGW + MiB;
constexpr size_t WS_EU = 20 * MiB;
constexpr size_t WS_EV = WS_EU + 32 * MiB;
constexpr size_t WS_HB = WS_EV + 32 * MiB;
constexpr size_t WS_ZU = WS_HB + 32 * MiB;
constexpr size_t WS_ZV = WS_ZU + 16 * MiB, WS_Q = WS_ZV + 16 * MiB, WS_K = WS_Q + 16 * MiB, WS_V = WS_K + 16 * MiB;
constexpr size_t WS_XG = WS_K;
constexpr size_t WS_QV = WS_HB;
constexpr size_t WS_IDX = WS_V + 16 * MiB;
constexpr size_t WS_GATE = WS_IDX + 8 * MiB;
constexpr size_t WS_END = WS_GATE + 8 * MiB;

struct Args {
    const float *x, *c, *w_ada, *b_ada, *norm1_g, *w_in, *b_f, *sg_ln_g, *sg_ln_b, *sg_w, *sg_b, *out_g_sg, *out_g_fox,
        *w_out, *norm2_g, *w_query, *sub_keys, *expert_u, *expert_v, *final_g;
    float* out; unsigned char* ws; int ph_lo, ph_hi;
};

#define GAS __attribute__((address_space(1)))
#define LAS __attribute__((address_space(3)))
#define WAVE_LDS_FENCE() do { __builtin_amdgcn_fence(__ATOMIC_ACQ_REL, "wavefront"); __builtin_amdgcn_wave_barrier(); } while (0)
__device__ __forceinline__ float wave_sum(float v) {
#pragma unroll
    for (int o = 1; o < 64; o <<= 1) v += __shfl_xor(v, o);
    return v;
}
__device__ __forceinline__ float wave_max(float v) {
#pragma unroll
    for (int o = 1; o < 64; o <<= 1) v = fmaxf(v, __shfl_xor(v, o));
    return v;
}
__device__ __forceinline__ float gelu_exact(float v) { return 0.5f * v * (1.0f + erff(v * 0.70710678118654752f)); }
__device__ __forceinline__ float log_sigmoid(float v) { return fminf(v, 0.f) - log1pf(expf(-fabsf(v))); }
__device__ __forceinline__ float bf2f(bf16_t v) { return __uint_as_float((unsigned)v << 16); }
__device__ __forceinline__ unsigned f2bf(float f) { unsigned u = __builtin_bit_cast(unsigned, f); return (u + 0x7fffu + ((u >> 16) & 1u)) >> 16; }
__device__ __forceinline__ unsigned pk2(float lo, float hi) { return f2bf(lo) | (f2bf(hi) << 16); }

namespace pg8 {
#define PG8_LAS __attribute__((address_space(3)))
typedef unsigned short bf16_t;
typedef short bf16x8 __attribute__((ext_vector_type(8)));
typedef float f32x4 __attribute__((ext_vector_type(4)));
typedef unsigned u32x4 __attribute__((ext_vector_type(4)));
constexpr int BM = 256, BK = 64, HALF = 128, HTB = HALF * BK * 2  , STAGE_BYTES = 8 * HTB, NXCD = 8, WGM = 8;

__host__ __device__ __forceinline__ int lds_byte(int r, int c) { const int st = (r >> 4) * 2 + (c >> 5), rr = r & 15, cc = c & 31, ob = rr * 64 + cc * 2; return st * 1024 + (ob ^ (((ob >> 9) & 1) << 5)); }
__host__ __device__ __forceinline__ void stage_rc(int b, int& R, int& C) { const int st = b / 1024, sb = b % 1024, swz = sb ^ (((sb >> 9) & 1) << 5); R = (st >> 1) * 16 + swz / 64; C = (st & 1) * 32 + (swz % 64) / 2; }
__host__ __device__ __forceinline__ int perm32(int rho) { const int n = rho >> 4, i = rho & 15; return 8 * (i >> 2) + 4 * n + (i & 3); }

struct Unit { int pm, pn; };
struct Gemm { const bf16_t* A; const bf16_t* Bt; int M, N, K; };

struct StaticOrder {
    int nM, nN, nwg, G, c;
    __host__ __device__ void init(int M, int N, int G_, int c_) { nM = M / BM; nN = N / BM; nwg = nM * nN; G = G_; c = c_; }
    __host__ __device__ bool next(int i, Unit& u) const {
        const long L = (long)i * G + c; if (L >= nwg) return false;
        int wgid = (int)L; { const int q = nwg / NXCD, r = nwg % NXCD, xcd = wgid % NXCD, off = wgid / NXCD; wgid = (xcd < r ? xcd * (q + 1) : r * (q + 1) + (xcd - r) * q) + off; }
        const int nig = WGM * nN, gid = wgid / nig, fm = gid * WGM, gsz = (nM - fm) < WGM ? (nM - fm) : WGM;
        u.pm = fm + ((wgid % nig) % gsz); u.pn = (wgid % nig) / gsz; return true;
    }
    __device__ __forceinline__ void a_ready(const Unit&) const {}
    __device__ __forceinline__ void done(const Unit&) const {}
};


__device__ __forceinline__ unsigned cvt_pk_bf16(float lo, float hi) { unsigned r; asm volatile("v_cvt_pk_bf16_f32 %0, %1, %2" : "=v"(r) : "v"(lo), "v"(hi)); return r; }
typedef float f32x2 __attribute__((ext_vector_type(2)));
__device__ __forceinline__ f32x2 gelu_pk(f32x2 v) {
    const f32x2 av = __builtin_elementwise_abs(v), d = av * 0.2316418882f + 1.0f;
    f32x2 t; t.x = __builtin_amdgcn_rcpf(d.x); t.y = __builtin_amdgcn_rcpf(d.y);
    f32x2 q = t * 0.5307027145f + (-0.7265760135f); q = q * t + 0.7107068705f; q = q * t + (-0.142248368f); q = q * t + 0.127414796f; q = q * t;
    const f32x2 s = (v * v) * (-0.72134752044f);
    f32x2 e; e.x = __builtin_amdgcn_exp2f(s.x); e.y = __builtin_amdgcn_exp2f(s.y);
    const f32x2 m = v * (q * e), r = v - m;
    f32x2 o; o.x = v.x < 0.f ? m.x : r.x; o.y = v.y < 0.f ? m.y : r.y; return o;
}


typedef unsigned u32x4 __attribute__((ext_vector_type(4)));
struct EpiProj {
    static constexpr bool PERM = true, AFTER_DRAIN = false;
    bf16_t* base;
    __device__ __forceinline__ void operator()(const f32x4 (&acc)[2][2][4][2], const Unit& u, int wr, int wc, int fr, int fq) const {
        const int t = u.pn >> 1;
        bf16_t* O = base + (size_t)t * NT * 512;
        const bool act = t < 2; const float sc = (t == 2) ? C2 : 1.f;
        const int row0 = u.pm * BM + wr * 64 + fr, col0 = (u.pn & 1) * 256 + wc * 32 + 8 * fq;
#pragma unroll
        for (int ai = 0; ai < 2; ++ai)
#pragma unroll
            for (int m = 0; m < 4; ++m) { bf16_t* rowp = O + (size_t)(row0 + ai * HALF + m * 16) * 512 + col0;
#pragma unroll
                for (int bj = 0; bj < 2; ++bj) { f32x4 v0 = acc[ai][bj][m][0], v1 = acc[ai][bj][m][1];
                    if (act) { f32x2 a = gelu_pk((f32x2){v0[0], v0[1]}), b = gelu_pk((f32x2){v0[2], v0[3]}), c = gelu_pk((f32x2){v1[0], v1[1]}), d = gelu_pk((f32x2){v1[2], v1[3]});
                        v0 = (f32x4){a.x, a.y, b.x, b.y}; v1 = (f32x4){c.x, c.y, d.x, d.y}; }
                    v0 = v0 * sc; v1 = v1 * sc; u32x4 w; w.x = cvt_pk_bf16(v0[0], v0[1]); w.y = cvt_pk_bf16(v0[2], v0[3]); w.z = cvt_pk_bf16(v1[0], v1[1]); w.w = cvt_pk_bf16(v1[2], v1[3]);
                    *(u32x4*)(rowp + bj * HALF) = w; } }
    }
};
struct EpiOut {
    static constexpr bool PERM = true, AFTER_DRAIN = true;
    const float* x; const float* ada; const float* norm2_g; float* x1out; bf16_t* xg; float* ssq4;
    __device__ __forceinline__ void fused(f32x4 (&acc)[2][2][4][2], const Unit& u, int wr, int wc, int fr, int fq, PG8_LAS unsigned char* lds, int wid, int lane) const {
        const int b = (u.pm * BM) / SEQ;
        const float* gate1 = ada + b * 6 * DM + 2 * DM; const float* scale2 = ada + b * 6 * DM + 4 * DM;
        const int col0 = u.pn * BM + wc * 32 + 8 * fq;
        PG8_LAS float* P = (PG8_LAS float*)lds;
        f32x4 gt[2][2], g2[2][2];
#pragma unroll
        for (int bj = 0; bj < 2; ++bj)
#pragma unroll
            for (int n = 0; n < 2; ++n) { const int c = col0 + bj * HALF + 4 * n; gt[bj][n] = *(const f32x4*)(gate1 + c); g2[bj][n] = *(const f32x4*)(norm2_g + c) * (*(const f32x4*)(scale2 + c) + 1.0f); }
#pragma unroll
        for (int ai = 0; ai < 2; ++ai)
#pragma unroll
            for (int m = 0; m < 4; ++m) { const int rl = ai * HALF + wr * 64 + m * 16 + fr; const size_t off = (size_t)(u.pm * BM + rl) * DM + col0; float ss = 0.f;
#pragma unroll
                for (int bj = 0; bj < 2; ++bj) {
                    const f32x4 x0 = *(const f32x4*)(x + off + bj * HALF), x1 = *(const f32x4*)(x + off + bj * HALF + 4);
                    const f32x4 v0 = x0 + gt[bj][0] * acc[ai][bj][m][0], v1 = x1 + gt[bj][1] * acc[ai][bj][m][1];
                    *(f32x4*)(x1out + off + bj * HALF) = v0; *(f32x4*)(x1out + off + bj * HALF + 4) = v1;
                    ss += (v0[0] * v0[0] + v0[1] * v0[1]) + (v0[2] * v0[2] + v0[3] * v0[3]) + (v1[0] * v1[0] + v1[1] * v1[1]) + (v1[2] * v1[2] + v1[3] * v1[3]);
                    const f32x4 w0 = v0 * g2[bj][0], w1 = v1 * g2[bj][1];
                    u32x4 w; w.x = cvt_pk_bf16(w0[0], w0[1]); w.y = cvt_pk_bf16(w0[2], w0[3]); w.z = cvt_pk_bf16(w1[0], w1[1]); w.w = cvt_pk_bf16(w1[2], w1[3]);
                    *(u32x4*)(xg + off + bj * HALF) = w; }
                ss += __shfl_xor(ss, 16); ss += __shfl_xor(ss, 32);
                if (fq == 0) P[rl * 4 + wc] = ss; }
        asm volatile("s_waitcnt lgkmcnt(0)" ::: "memory"); __builtin_amdgcn_s_barrier(); asm volatile("" ::: "memory");
        const int tid = wid * 64 + lane;
        if (tid < 256) ssq4[(size_t)(u.pm * BM + tid) * 4 + u.pn] = (P[tid * 4 + 0] + P[tid * 4 + 1]) + (P[tid * 4 + 2] + P[tid * 4 + 3]);
        asm volatile("s_waitcnt lgkmcnt(0)" ::: "memory"); __builtin_amdgcn_s_barrier(); asm volatile("" ::: "memory");
    }
};
struct EpiQuery {
    static constexpr bool PERM = true, AFTER_DRAIN = false;
    const float* ssq4; const float* sqb; bf16_t* qv;
    __device__ __forceinline__ void operator()(const f32x4 (&acc)[2][2][4][2], const Unit& u, int wr, int wc, int fr, int fq) const {
        const int b = (u.pm * BM) / SEQ;
        const int row0 = u.pm * BM + wr * 64 + fr, col0 = u.pn * BM + wc * 32 + 8 * fq;
        f32x4 bv[2][2];
#pragma unroll
        for (int bj = 0; bj < 2; ++bj)
#pragma unroll
            for (int n = 0; n < 2; ++n) bv[bj][n] = *(const f32x4*)(sqb + b * NQ + col0 + bj * HALF + 4 * n);
#pragma unroll
        for (int ai = 0; ai < 2; ++ai)
#pragma unroll
            for (int m = 0; m < 4; ++m) { const int row = row0 + ai * HALF + m * 16; const f32x4 s4 = *(const f32x4*)(ssq4 + (size_t)row * 4);
                const float rstd = rsqrtf(((s4[0] + s4[1]) + (s4[2] + s4[3])) * (1.f / DM) + EPS);
                bf16_t* rowp = qv + (size_t)row * NQ + col0;
#pragma unroll
                for (int bj = 0; bj < 2; ++bj) { const f32x4 v0 = acc[ai][bj][m][0] * rstd + bv[bj][0], v1 = acc[ai][bj][m][1] * rstd + bv[bj][1];
                    u32x4 w; w.x = cvt_pk_bf16(v0[0], v0[1]); w.y = cvt_pk_bf16(v0[2], v0[3]); w.z = cvt_pk_bf16(v1[0], v1[1]); w.w = cvt_pk_bf16(v1[2], v1[3]);
                    *(u32x4*)(rowp + bj * HALF) = w; } }
    }
};

template <class Epi, class Sched, bool ALIGN_EPI = false, bool SP2 = false>
__device__ __forceinline__ void gemm_phase(PG8_LAS unsigned char* lds, const Gemm g, const Sched& S, const Epi& E) {
    const int tid = threadIdx.x, wid = __builtin_amdgcn_readfirstlane(tid >> 6), lane = tid & 63, wr = wid >> 2, wc = wid & 3, fr = lane & 15, fq = lane >> 4;
    const int K = g.K, nt = K / BK;
    unsigned voffA[2], voffB[2];
#pragma unroll
    for (int i = 0; i < 2; ++i) { int R, C; stage_rc(tid * 16 + i * 8192, R, C); const int Rb = Epi::PERM ? ((R & ~31) + perm32(R & 31)) : R;
        voffA[i] = (unsigned)(R * K + C) * 2u; voffB[i] = (unsigned)(Rb * K + C) * 2u; }
    const size_t kstep = (size_t)(BK * 2);
    const size_t hstep = (size_t)HALF * K * 2;
    const size_t tstep = 2 * hstep;
    const unsigned ldsw = (unsigned)wid * 1024u;
    const int aoff = lds_byte(wr * 64 + fr, fq * 8), boff = lds_byte(wc * 32 + fr, fq * 8);
#define PG8_SA(b, h) (((b) * 2 + (h)) * HTB)
#define PG8_SB(b, h) ((4 + (b) * 2 + (h)) * HTB)
#define PG8_STAGE(bufoff, gbase, voff) do { _Pragma("unroll") for (int _i = 0; _i < 2; ++_i) \
        __builtin_amdgcn_global_load_lds((const unsigned*)((const char*)(gbase) + (voff)[_i]), (PG8_LAS unsigned*)(lds + (bufoff) + ldsw + _i * 8192), 16, 0, 0); } while (0)
#define PG8_LDA(dst, b, h) do { _Pragma("unroll") for (int m = 0; m < 4; ++m) _Pragma("unroll") for (int k = 0; k < 2; ++k) dst[m][k] = *(const PG8_LAS bf16x8*)(lds + PG8_SA(b, h) + aoff + m * 2048 + k * 1024); } while (0)
#define PG8_LDB(dst, b, h) do { _Pragma("unroll") for (int n = 0; n < 2; ++n) _Pragma("unroll") for (int k = 0; k < 2; ++k) dst[n][k] = *(const PG8_LAS bf16x8*)(lds + PG8_SB(b, h) + boff + n * 2048 + k * 1024); } while (0)
#define PG8_MMA(ai, bj, At, Bt) do { __builtin_amdgcn_s_setprio(1); _Pragma("unroll") for (int m = 0; m < 4; ++m) _Pragma("unroll") for (int n = 0; n < 2; ++n) _Pragma("unroll") for (int k = 0; k < 2; ++k) \
        acc[ai][bj][m][n] = __builtin_amdgcn_mfma_f32_16x16x32_bf16(Bt[n][k], At[m][k], acc[ai][bj][m][n], 0, 0, 0); __builtin_amdgcn_s_setprio(0); } while (0)
#define PG8_WAIT_V(n) asm volatile("s_waitcnt vmcnt(" #n ")" ::: "memory")
#define PG8_WAIT_L(n) asm volatile("s_waitcnt lgkmcnt(" #n ")" ::: "memory")
#define PG8_BAR __builtin_amdgcn_s_barrier()
#define PG8_SCHED __builtin_amdgcn_sched_barrier(0)
    Unit cur, nxt; int ui = 0;
    if (!S.next(0, cur)) return;
    f32x4 acc[2][2][4][2];
#pragma unroll
    for (int a = 0; a < 2; ++a)
#pragma unroll
        for (int b = 0; b < 2; ++b)
#pragma unroll
            for (int m = 0; m < 4; ++m)
#pragma unroll
                for (int n = 0; n < 2; ++n) acc[a][b][m][n] = (f32x4){0.f, 0.f, 0.f, 0.f};
    bf16x8 At[4][2], B0[2][2], B1[2][2];
    const char* cA = (const char*)g.A + (size_t)cur.pm * tstep; const char* cB = (const char*)g.Bt + (size_t)cur.pn * tstep;
    S.a_ready(cur);
    if constexpr (SP2) {
        PG8_STAGE(PG8_SB(0, 0), cB, voffB); PG8_STAGE(PG8_SB(0, 1), cB + hstep, voffB); PG8_STAGE(PG8_SA(0, 0), cA, voffA); PG8_STAGE(PG8_SA(0, 1), cA + hstep, voffA);
        if (wr == 1) PG8_BAR;
        PG8_WAIT_V(2); PG8_BAR;
        PG8_STAGE(PG8_SB(1, 0), cB + kstep, voffB); PG8_STAGE(PG8_SA(1, 0), cA + kstep, voffA); PG8_STAGE(PG8_SB(1, 1), cB + hstep + kstep, voffB);
        PG8_WAIT_V(6); PG8_BAR;
    } else {
        PG8_STAGE(PG8_SB(0, 0), cB, voffB); PG8_STAGE(PG8_SA(0, 0), cA, voffA); PG8_STAGE(PG8_SB(0, 1), cB + hstep, voffB); PG8_STAGE(PG8_SA(0, 1), cA + hstep, voffA);
        if (wr == 1) PG8_BAR;
        PG8_WAIT_V(4); PG8_BAR;
        PG8_STAGE(PG8_SB(1, 0), cB + kstep, voffB); PG8_STAGE(PG8_SA(1, 0), cA + kstep, voffA); PG8_STAGE(PG8_SB(1, 1), cB + hstep + kstep, voffB);
        PG8_WAIT_V(6); PG8_BAR;
    }
    for (;;) {
        const bool has_next = S.next(ui + 1, nxt);
        const char* nA = has_next ? (const char*)g.A + (size_t)nxt.pm * tstep : cA; const char* nB = has_next ? (const char*)g.Bt + (size_t)nxt.pn * tstep : cB;
        for (int t = 0; t < nt; t += 2) {
            const bool last = (t == nt - 2);
            const char* a1 = cA + (size_t)(t + 1) * kstep;
            const char* a2 = last ? nA : cA + (size_t)(t + 2) * kstep; const char* b2 = last ? nB : cB + (size_t)(t + 2) * kstep;
            const char* a3 = a2 + kstep; const char* b3 = b2 + kstep;
            if (last && has_next) S.a_ready(nxt);
            if constexpr (SP2) {
            PG8_LDB(B0, 0, 0); PG8_LDB(B1, 0, 1); PG8_SCHED; PG8_LDA(At, 0, 0); PG8_STAGE(PG8_SA(1, 1), a1 + hstep, voffA);
            PG8_WAIT_V(8); PG8_WAIT_L(0); PG8_BAR; PG8_MMA(0, 0, At, B0); PG8_MMA(0, 1, At, B1); PG8_BAR; PG8_SCHED;
            PG8_LDA(At, 0, 1); PG8_STAGE(PG8_SB(0, 0), b2, voffB); PG8_STAGE(PG8_SB(0, 1), b2 + hstep, voffB); PG8_STAGE(PG8_SA(0, 0), a2, voffA);
            PG8_WAIT_V(8); PG8_WAIT_L(0); PG8_BAR; PG8_MMA(1, 0, At, B0); PG8_MMA(1, 1, At, B1); PG8_BAR; PG8_SCHED;
            PG8_LDB(B0, 1, 0); PG8_LDB(B1, 1, 1); PG8_SCHED; PG8_LDA(At, 1, 0); PG8_STAGE(PG8_SA(0, 1), a2 + hstep, voffA);
            PG8_WAIT_V(8); PG8_WAIT_L(0); PG8_BAR; PG8_MMA(0, 0, At, B0); PG8_MMA(0, 1, At, B1); PG8_BAR; PG8_SCHED;
            PG8_LDA(At, 1, 1); PG8_STAGE(PG8_SB(1, 0), b3, voffB); PG8_STAGE(PG8_SB(1, 1), b3 + hstep, voffB); PG8_STAGE(PG8_SA(1, 0), a3, voffA);
            PG8_WAIT_V(8); PG8_WAIT_L(0); PG8_BAR; PG8_MMA(1, 0, At, B0); PG8_MMA(1, 1, At, B1); PG8_BAR; PG8_SCHED;
            } else {
            PG8_LDB(B0, 0, 0); PG8_SCHED; PG8_LDA(At, 0, 0); PG8_STAGE(PG8_SA(1, 1), a1 + hstep, voffA);
            PG8_WAIT_L(8); PG8_BAR; PG8_WAIT_L(0); PG8_MMA(0, 0, At, B0); PG8_BAR; PG8_SCHED;
            PG8_LDB(B1, 0, 1); PG8_STAGE(PG8_SB(0, 0), b2, voffB);
            PG8_BAR; PG8_WAIT_L(0); PG8_MMA(0, 1, At, B1); PG8_BAR;
            PG8_LDA(At, 0, 1); PG8_STAGE(PG8_SA(0, 0), a2, voffA);
            PG8_BAR; PG8_WAIT_L(0); PG8_MMA(1, 0, At, B0); PG8_BAR; PG8_SCHED;
            PG8_STAGE(PG8_SB(0, 1), b2 + hstep, voffB);
            PG8_WAIT_V(6); PG8_BAR; PG8_MMA(1, 1, At, B1); PG8_BAR;
            PG8_LDB(B0, 1, 0); PG8_SCHED; PG8_LDA(At, 1, 0); PG8_STAGE(PG8_SA(0, 1), a2 + hstep, voffA);
            PG8_WAIT_L(8); PG8_BAR; PG8_WAIT_L(0); PG8_MMA(0, 0, At, B0); PG8_BAR; PG8_SCHED;
            PG8_LDB(B1, 1, 1); PG8_STAGE(PG8_SB(1, 0), b3, voffB);
            PG8_BAR; PG8_WAIT_L(0); PG8_MMA(0, 1, At, B1); PG8_BAR;
            PG8_LDA(At, 1, 1); PG8_STAGE(PG8_SA(1, 0), a3, voffA);
            PG8_BAR; PG8_WAIT_L(0); PG8_MMA(1, 0, At, B0); PG8_BAR; PG8_SCHED;
            PG8_STAGE(PG8_SB(1, 1), b3 + hstep, voffB);
            PG8_WAIT_V(6); PG8_BAR; PG8_MMA(1, 1, At, B1); PG8_BAR;
            }
        }
        if constexpr (ALIGN_EPI) { if (wr == 0) PG8_BAR; }
        if constexpr (!Epi::AFTER_DRAIN) { E(acc, cur, wr, wc, fr, fq); S.done(cur); }
        if (!has_next) break;
#pragma unroll
        for (int a = 0; a < 2; ++a)
#pragma unroll
            for (int b = 0; b < 2; ++b)
#pragma unroll
                for (int m = 0; m < 4; ++m)
#pragma unroll
                    for (int n = 0; n < 2; ++n) acc[a][b][m][n] = (f32x4){0.f, 0.f, 0.f, 0.f};
        cur = nxt; cA = nA; cB = nB; ++ui;
        if constexpr (ALIGN_EPI) { if (wr == 1) PG8_BAR; }
    }
    PG8_WAIT_V(0);
    if constexpr (!ALIGN_EPI) { if (wr == 0) PG8_BAR; }
    PG8_BAR;
    if constexpr (Epi::AFTER_DRAIN) { E.fused(acc, cur, wr, wc, fr, fq, lds, wid, lane); S.done(cur); }
#undef PG8_SA
#undef PG8_SB
#undef PG8_STAGE
#undef PG8_LDA
#undef PG8_LDB
#undef PG8_MMA
#undef PG8_WAIT_V
#undef PG8_WAIT_L
#undef PG8_BAR
#undef PG8_SCHED
}
}

namespace mixer {
typedef short bf16x8 __attribute__((ext_vector_type(8)));
typedef short s16x4 __attribute__((ext_vector_type(4)));
typedef float f32x16 __attribute__((ext_vector_type(16)));
typedef unsigned u32x4 __attribute__((ext_vector_type(4)));
typedef float f32x2_t __attribute__((ext_vector_type(2))); typedef __bf16 bf16x2_t __attribute__((ext_vector_type(2)));
__device__ __forceinline__ int crow(int r, int hi) { return (r & 3) + 8 * (r >> 2) + 4 * hi; }
__device__ __forceinline__ unsigned cvtpk(float lo, float hi) { f32x2_t v = {lo, hi}; bf16x2_t b = __builtin_convertvector(v, bf16x2_t); return __builtin_bit_cast(unsigned, b); }
#define MX_SBAR() __builtin_amdgcn_sched_barrier(0)

constexpr int A_K = 0, A_V = 8192, A_G = 16384, A_WS = 16640, A_OST = 18688, A_BYTES = A_OST + 8 * 8192;
__device__ __forceinline__ void pv(f32x16* o, int vb, bf16x8 pa0, bf16x8 pa1, bf16x8 pa2, bf16x8 pa3) {
#pragma unroll
    for (int d0 = 0; d0 < 2; ++d0) { s16x4 lo[4], hi[4];
#pragma unroll
        for (int ks = 0; ks < 4; ++ks) {
            asm volatile("ds_read_b64_tr_b16 %0,%1 offset:%c2" : "=&v"(lo[ks]) : "v"(vb), "i"(d0 * 4096 + ks * 1024) : "memory");
            asm volatile("ds_read_b64_tr_b16 %0,%1 offset:%c2" : "=&v"(hi[ks]) : "v"(vb), "i"(d0 * 4096 + ks * 1024 + 512) : "memory"); }
        asm volatile("s_waitcnt lgkmcnt(0)" ::: "memory"); MX_SBAR();
#define MX_PK(k) (bf16x8){lo[k][0], lo[k][1], lo[k][2], lo[k][3], hi[k][0], hi[k][1], hi[k][2], hi[k][3]}
        o[d0] = __builtin_amdgcn_mfma_f32_32x32x16_bf16(pa0, MX_PK(0), o[d0], 0, 0, 0);
        o[d0] = __builtin_amdgcn_mfma_f32_32x32x16_bf16(pa1, MX_PK(1), o[d0], 0, 0, 0);
        o[d0] = __builtin_amdgcn_mfma_f32_32x32x16_bf16(pa2, MX_PK(2), o[d0], 0, 0, 0);
        o[d0] = __builtin_amdgcn_mfma_f32_32x32x16_bf16(pa3, MX_PK(3), o[d0], 0, 0, 0);
#undef MX_PK
    }
}
__device__ __forceinline__ void attn_unit(int b, int h, int qb, const bf16_t* Q, const bf16_t* K, const bf16_t* V, const float* GQ, const float* out_g, bf16_t* Y, char* shm) {
    const int tid = threadIdx.x, lane = tid & 63, r32 = lane & 31, hi = lane >> 5; const int wid = __builtin_amdgcn_readfirstlane(tid >> 6);
    const size_t rowbase = (size_t)b * SEQ; const int q0 = qb * 256;
    const bf16_t* Qw = Q + (rowbase + q0 + wid * 32) * 512 + h * 64;
    const bf16_t* Kh = K + rowbase * 512 + h * 64; const bf16_t* Vh = V + rowbase * 512 + h * 64;
    const unsigned lds0 = (unsigned)(uintptr_t)shm;
    float* wsf = (float*)(shm + A_WS) + wid * 64;
    const float* gbl = (const float*)(shm + A_G);
    const bf16_t* ksrc = Kh + (size_t)lane * 512 + wid * 8;
    const bf16_t* vsrc = Vh + (size_t)(16 * (wid & 3) + (lane >> 2)) * 512 + (wid >> 2) * 32 + (lane & 3) * 8;
    uint4* kdst = (uint4*)(shm + A_K + wid * 1024 + lane * 16); uint4* vdst = (uint4*)(shm + A_V + wid * 1024 + lane * 16);
    const int vb0 = (int)(lds0 + A_V) + ((lane >> 4) & 1) * 32 + (lane & 3) * 8 + (4 * hi + ((lane & 15) >> 2)) * 64;
    const char* kb = shm + A_K + hi * 1024 + r32 * 16;
    const int NTL = (q0 + 256) / 64;
    bf16x8 qr[4];
#pragma unroll
    for (int d0 = 0; d0 < 4; ++d0) qr[d0] = *reinterpret_cast<const bf16x8*>(&Qw[(size_t)r32 * 512 + d0 * 16 + hi * 8]);
    const int qrow = q0 + wid * 32 + r32;
    const float Gq = GQ[(rowbase + qrow) * 8 + h];
    float m_run = -INFINITY, l_run = 0.f; f32x16 o[2]; o[0] = f32x16{}; o[1] = f32x16{};
    uint4 kreg = *(const uint4*)ksrc, vreg = *(const uint4*)vsrc; float greg = (tid < 64) ? GQ[(rowbase + tid) * 8 + h] : 0.f;
    for (int t = 0; t < NTL; ++t) {
        __syncthreads();
        *kdst = kreg; *vdst = vreg; if (tid < 64) ((float*)(shm + A_G))[tid] = greg;
        __syncthreads();
        if (t + 1 < NTL) { kreg = *(const uint4*)(ksrc + (size_t)(t + 1) * 64 * 512); vreg = *(const uint4*)(vsrc + (size_t)(t + 1) * 64 * 512); if (tid < 64) greg = GQ[(rowbase + (t + 1) * 64 + tid) * 8 + h]; }
        f32x16 p0 = f32x16{}, p1 = f32x16{};
#pragma unroll
        for (int d0 = 0; d0 < 4; ++d0) {
            const bf16x8 b0 = *reinterpret_cast<const bf16x8*>(kb + d0 * 2048), b1 = *reinterpret_cast<const bf16x8*>(kb + d0 * 2048 + 512);
            p0 = __builtin_amdgcn_mfma_f32_32x32x16_bf16(b0, qr[d0], p0, 0, 0, 0); p1 = __builtin_amdgcn_mfma_f32_32x32x16_bf16(b1, qr[d0], p1, 0, 0, 0); }
        const int kbase = t * 64 + 4 * hi;
#pragma unroll
        for (int g = 0; g < 4; ++g) {
            const float4 ga = *(const float4*)(gbl + 8 * g + 4 * hi), gc = *(const float4*)(gbl + 32 + 8 * g + 4 * hi);
            p0[4 * g + 0] += Gq - ga.x; p0[4 * g + 1] += Gq - ga.y; p0[4 * g + 2] += Gq - ga.z; p0[4 * g + 3] += Gq - ga.w;
            p1[4 * g + 0] += Gq - gc.x; p1[4 * g + 1] += Gq - gc.y; p1[4 * g + 2] += Gq - gc.z; p1[4 * g + 3] += Gq - gc.w; }
        if (t >= NTL - 4) {
#pragma unroll
            for (int r = 0; r < 16; ++r) { const int kv = kbase + (r & 3) + 8 * (r >> 2); if (kv > qrow) p0[r] = -INFINITY; if (kv + 32 > qrow) p1[r] = -INFINITY; } }
        float rm = fmaxf(p0[0], p1[0]);
#pragma unroll
        for (int r = 1; r < 16; ++r) rm = fmaxf(rm, fmaxf(p0[r], p1[r]));
        rm = fmaxf(rm, __shfl_xor(rm, 32));
        const float m_new = fmaxf(m_run, rm), alpha = __builtin_amdgcn_exp2f(m_run - m_new); m_run = m_new;
        float ps = 0.f;
#pragma unroll
        for (int r = 0; r < 16; ++r) { p0[r] = __builtin_amdgcn_exp2f(p0[r] - m_new); p1[r] = __builtin_amdgcn_exp2f(p1[r] - m_new); ps += p0[r] + p1[r]; }
        l_run = l_run * alpha + ps;
        if (hi == 0) wsf[r32] = alpha;
        WAVE_LDS_FENCE();
#pragma unroll
        for (int g = 0; g < 4; ++g) { const float4 al = *(const float4*)(wsf + 8 * g + 4 * hi);
#pragma unroll
            for (int d = 0; d < 2; ++d) { o[d][4 * g + 0] *= al.x; o[d][4 * g + 1] *= al.y; o[d][4 * g + 2] *= al.z; o[d][4 * g + 3] *= al.w; } }
        WAVE_LDS_FENCE();
        u32x4 pw0, pw1, pw2, pw3;
        pw0 = (u32x4){cvtpk(p0[0], p0[1]), cvtpk(p0[2], p0[3]), cvtpk(p0[4], p0[5]), cvtpk(p0[6], p0[7])};
        pw1 = (u32x4){cvtpk(p0[8], p0[9]), cvtpk(p0[10], p0[11]), cvtpk(p0[12], p0[13]), cvtpk(p0[14], p0[15])};
        pw2 = (u32x4){cvtpk(p1[0], p1[1]), cvtpk(p1[2], p1[3]), cvtpk(p1[4], p1[5]), cvtpk(p1[6], p1[7])};
        pw3 = (u32x4){cvtpk(p1[8], p1[9]), cvtpk(p1[10], p1[11]), cvtpk(p1[12], p1[13]), cvtpk(p1[14], p1[15])};
        MX_SBAR();
        pv(o, vb0, __builtin_bit_cast(bf16x8, pw0), __builtin_bit_cast(bf16x8, pw1), __builtin_bit_cast(bf16x8, pw2), __builtin_bit_cast(bf16x8, pw3));
    }
    l_run += __shfl_xor(l_run, 32);
    if (hi == 0) wsf[r32] = 1.0f / l_run;
    WAVE_LDS_FENCE();
    float* stg = (float*)(shm + A_OST) + wid * 2048;
#pragma unroll
    for (int r = 0; r < 16; ++r) { const int orow = crow(r, hi); const float rl = wsf[orow];
#pragma unroll
        for (int d0 = 0; d0 < 2; ++d0) stg[orow * 64 + d0 * 32 + r32] = o[d0][r] * rl; }
    WAVE_LDS_FENCE();
    bf16_t* Yw = Y + (rowbase + q0 + wid * 32) * DM + 512 + h * 64;
#pragma unroll
    for (int i = 0; i < 4; ++i) { const int row = i * 8 + (lane >> 3), ch = lane & 7;
        const float4 a = *(const float4*)(stg + row * 64 + ch * 8), c = *(const float4*)(stg + row * 64 + ch * 8 + 4);
        float ss = (a.x * a.x + a.y * a.y) + (a.z * a.z + a.w * a.w) + (c.x * c.x + c.y * c.y) + (c.z * c.z + c.w * c.w);
        ss += __shfl_xor(ss, 1); ss += __shfl_xor(ss, 2); ss += __shfl_xor(ss, 4);
        const float rs = rsqrtf(ss * (1.f / 64) + EPS);
        const float4 g0 = *(const float4*)(out_g + h * 64 + ch * 8), g1 = *(const float4*)(out_g + h * 64 + ch * 8 + 4);
        u32x4 w; w.x = cvtpk(a.x * rs * g0.x, a.y * rs * g0.y); w.y = cvtpk(a.z * rs * g0.z, a.w * rs * g0.w); w.z = cvtpk(c.x * rs * g1.x, c.y * rs * g1.y); w.w = cvtpk(c.z * rs * g1.z, c.w * rs * g1.w);
        *(u32x4*)(Yw + (size_t)row * DM + ch * 8) = w; }
    WAVE_LDS_FENCE();
}

constexpr int SG_PITCH = 136, SG_SLOT = 64 * SG_PITCH * 2;
__device__ __forceinline__ void sgu_pair(int task0, const bf16_t* ZU, const bf16_t* ZV, const bf16_t* SGWB, const float* ln_g, const float* ln_b, const float* sg_b, const float* out_g, bf16_t* Y, char* shm) {
    const int tid = threadIdx.x, lane = tid & 63, r32 = lane & 31, hi = lane >> 5; const int wid = __builtin_amdgcn_readfirstlane(tid >> 6);
    const int slot = wid >> 2, j = wid & 3, task = task0 + slot;
    const int h = task % NH, bc = task / NH, t0 = bc * CHUNK;
    bf16_t* vnT = (bf16_t*)(shm + slot * SG_SLOT);
    __syncthreads();
    {
        const int tl = tid & 255, s = tl >> 1, half = tl & 1;
        const bf16_t* zr = ZV + (size_t)(t0 + s) * 512 + h * 64 + half * 32;
        uint4 raw[4]; float v[32]; float sum = 0.f;
#pragma unroll
        for (int i = 0; i < 4; ++i) raw[i] = *(const uint4*)(zr + 8 * i);
#pragma unroll
        for (int i = 0; i < 4; ++i) { const unsigned w[4] = {raw[i].x, raw[i].y, raw[i].z, raw[i].w};
#pragma unroll
            for (int k = 0; k < 4; ++k) { v[8 * i + 2 * k] = __uint_as_float(w[k] << 16); v[8 * i + 2 * k + 1] = __uint_as_float(w[k] & 0xffff0000u); } }
#pragma unroll
        for (int i = 0; i < 32; ++i) sum += v[i];
        sum += __shfl_xor(sum, 1);
        const float mu = sum * (1.f / 64); float var = 0.f;
#pragma unroll
        for (int i = 0; i < 32; ++i) { v[i] -= mu; var += v[i] * v[i]; }
        var += __shfl_xor(var, 1);
        const float rs = rsqrtf(var * (1.f / 64) + EPS);
#pragma unroll
        for (int i = 0; i < 32; ++i) { const int d = half * 32 + i; vnT[d * SG_PITCH + s] = (bf16_t)f2bf(v[i] * rs * ln_g[h * 64 + d] + ln_b[h * 64 + d]); }
    }
    __syncthreads();
    f32x16 acc[2]; acc[0] = f32x16{}; acc[1] = f32x16{};
    const bf16_t* wrow = SGWB + ((size_t)h * 128 + 32 * j + r32) * 128 + 8 * hi;
    const int nks = 2 * (j + 1);
    for (int ks = 0; ks < nks; ++ks) {
        const bf16x8 bw = *reinterpret_cast<const bf16x8*>(wrow + 16 * ks);
        const bf16x8 a0 = *reinterpret_cast<const bf16x8*>(vnT + (size_t)r32 * SG_PITCH + 16 * ks + 8 * hi);
        const bf16x8 a1 = *reinterpret_cast<const bf16x8*>(vnT + (size_t)(32 + r32) * SG_PITCH + 16 * ks + 8 * hi);
        acc[0] = __builtin_amdgcn_mfma_f32_32x32x16_bf16(a0, bw, acc[0], 0, 0, 0);
        acc[1] = __builtin_amdgcn_mfma_f32_32x32x16_bf16(a1, bw, acc[1], 0, 0, 0);
    }
    const int tl = 32 * j + r32; const size_t row = (size_t)t0 + tl;
    const float bs = sg_b[h * 128 + tl];
    float ss = 0.f;
#pragma unroll
    for (int mb = 0; mb < 2; ++mb)
#pragma unroll
        for (int g = 0; g < 4; ++g) { const int d = 32 * mb + 8 * g + 4 * hi;
            const uint2 z = *(const uint2*)(ZU + row * 512 + h * 64 + d);
            const float z0 = __uint_as_float(z.x << 16), z1 = __uint_as_float(z.x & 0xffff0000u), z2 = __uint_as_float(z.y << 16), z3 = __uint_as_float(z.y & 0xffff0000u);
            acc[mb][4 * g + 0] = z0 * (acc[mb][4 * g + 0] + bs); acc[mb][4 * g + 1] = z1 * (acc[mb][4 * g + 1] + bs);
            acc[mb][4 * g + 2] = z2 * (acc[mb][4 * g + 2] + bs); acc[mb][4 * g + 3] = z3 * (acc[mb][4 * g + 3] + bs);
            ss += (acc[mb][4 * g + 0] * acc[mb][4 * g + 0] + acc[mb][4 * g + 1] * acc[mb][4 * g + 1]) + (acc[mb][4 * g + 2] * acc[mb][4 * g + 2] + acc[mb][4 * g + 3] * acc[mb][4 * g + 3]); }
    ss += __shfl_xor(ss, 32);
    const float rs = rsqrtf(ss * (1.f / 64) + EPS);
#pragma unroll
    for (int mb = 0; mb < 2; ++mb)
#pragma unroll
        for (int g = 0; g < 4; ++g) { const int d = 32 * mb + 8 * g + 4 * hi;
            const float4 og = *(const float4*)(out_g + h * 64 + d);
            uint2 w; w.x = cvtpk(acc[mb][4 * g + 0] * rs * og.x, acc[mb][4 * g + 1] * rs * og.y); w.y = cvtpk(acc[mb][4 * g + 2] * rs * og.z, acc[mb][4 * g + 3] * rs * og.w);
            *(uint2*)(Y + row * DM + h * 64 + d) = w; }
}
#undef MX_SBAR
}

namespace peer {
typedef short bf16x8 __attribute__((ext_vector_type(8)));
typedef float f32x16 __attribute__((ext_vector_type(16)));
__device__ __forceinline__ unsigned umax(unsigned a, unsigned b) { return a > b ? a : b; }
__device__ __forceinline__ unsigned umin(unsigned a, unsigned b) { return a < b ? a : b; }
__device__ __forceinline__ unsigned f2ord(float f) { const unsigned u = __float_as_uint(f); return u ^ ((u >> 31) ? 0xffffffffu : 0x80000000u); }
__device__ __forceinline__ float ord2f(unsigned k) { const unsigned u = k ^ ((k >> 31) ? 0x80000000u : 0xffffffffu); return __uint_as_float(u); }
__device__ __forceinline__ void sort16(unsigned* a) {
#pragma unroll
    for (int k = 2; k <= 16; k <<= 1)
#pragma unroll
        for (int j = k >> 1; j > 0; j >>= 1)
#pragma unroll
            for (int i = 0; i < 16; ++i) { const int l = i ^ j; if (l > i) { const unsigned hi_ = umax(a[i], a[l]), lo_ = umin(a[i], a[l]); if ((i & k) == 0) { a[i] = hi_; a[l] = lo_; } else { a[i] = lo_; a[l] = hi_; } } }
}
__device__ __forceinline__ void merge16(unsigned* a) {
#pragma unroll
    for (int j = 8; j > 0; j >>= 1)
#pragma unroll
        for (int i = 0; i < 16; ++i) { const int l = i ^ j; if (l > i) { const unsigned hi_ = umax(a[i], a[l]), lo_ = umin(a[i], a[l]); a[i] = hi_; a[l] = lo_; } }
}
__device__ __forceinline__ void top16_of_two(unsigned* a, const unsigned* b) {
#pragma unroll
    for (int i = 0; i < 16; ++i) a[i] = umax(a[i], b[15 - i]);
    merge16(a);
}
__device__ __forceinline__ void top16_of_64(unsigned* k) {
    sort16(k); sort16(k + 16); sort16(k + 32); sort16(k + 48);
    top16_of_two(k, k + 16); top16_of_two(k + 32, k + 48); top16_of_two(k, k + 32);
}

constexpr int P_IDX = 0, P_GATE = 16384, P_SI = 32768, P_BYTES = P_SI + 8 * 8192;
__device__ __forceinline__ void topk_head(int t0, int h, const bf16_t* QV, const bf16_t* SUBK, char* shm) {
    const int lane = threadIdx.x & 63, r32 = lane & 31, hi = lane >> 5; const int wid = __builtin_amdgcn_readfirstlane(threadIdx.x >> 6);
    int* lsi = (int*)(shm + P_SI) + wid * 2048;
    unsigned top[2][16];
#pragma unroll
    for (int p = 0; p < 2; ++p) {
        f32x16 acc[4]; acc[0] = f32x16{}; acc[1] = f32x16{}; acc[2] = f32x16{}; acc[3] = f32x16{};
        const bf16_t* qp = QV + (size_t)(t0 + r32) * NQ + h * 256 + p * 128 + 8 * hi;
        const bf16_t* kp = SUBK + (((size_t)h * 2 + p) * NKEYS + r32) * DHALF + 8 * hi;
#pragma unroll 2
        for (int ks = 0; ks < 8; ++ks) {
            const bf16x8 bq = *reinterpret_cast<const bf16x8*>(qp + 16 * ks);
#pragma unroll
            for (int nb = 0; nb < 4; ++nb) { const bf16x8 ak = *reinterpret_cast<const bf16x8*>(kp + (size_t)nb * 32 * DHALF + 16 * ks);
                acc[nb] = __builtin_amdgcn_mfma_f32_32x32x16_bf16(ak, bq, acc[nb], 0, 0, 0); }
        }
        unsigned key[64];
#pragma unroll
        for (int nb = 0; nb < 4; ++nb)
#pragma unroll
            for (int r = 0; r < 16; ++r) { const int n = 32 * nb + (r & 3) + 8 * (r >> 2) + 4 * hi; key[16 * nb + r] = (f2ord(acc[nb][r]) & ~127u) | (unsigned)(127 - n); }
        top16_of_64(key);
        unsigned part[16];
#pragma unroll
        for (int i = 0; i < 16; ++i) part[i] = (unsigned)__shfl_xor((int)key[i], 32);
        top16_of_two(key, part);
#pragma unroll
        for (int i = 0; i < 16; ++i) { top[p][i] = key[i]; lsi[(p * 16 + i) * 64 + lane] = 127 - (int)(key[i] & 127u); }
    }
    float s0[16], s1[16];
#pragma unroll
    for (int i = 0; i < 16; ++i) { s0[i] = ord2f(top[0][i] & ~127u); s1[i] = ord2f(top[1][i] & ~127u); }
    unsigned ck[64];
    {
        int n = 0;
#pragma unroll
        for (int a = 0; a < 16; ++a)
#pragma unroll
            for (int b = 0; b < 16; ++b) if ((a + 1) * (b + 1) <= 16) { ck[n] = (f2ord(s0[a] + s1[b]) & ~255u) | (unsigned)(255 - (a * 16 + b)); ++n; }
#pragma unroll
        for (int i = 50; i < 64; ++i) ck[i] = 0u;
    }
    top16_of_64(ck);
    float sc[16]; float mx = -INFINITY, sum = 0.f;
#pragma unroll
    for (int i = 0; i < 16; ++i) { sc[i] = ord2f(ck[i] & ~255u); }
    mx = sc[0];
#pragma unroll
    for (int i = 0; i < 16; ++i) { sc[i] = __expf(sc[i] - mx); sum += sc[i]; }
    const float inv = 1.0f / sum;
    WAVE_LDS_FENCE();
    int* lidx = (int*)(shm + P_IDX) + r32 * 128 + h * 16; float* lgate = (float*)(shm + P_GATE) + r32 * 128 + h * 16;
#pragma unroll
    for (int i = 0; i < 16; ++i) if ((i >> 3) == hi) {
        const int pos = 255 - (int)(ck[i] & 255u), ia = lsi[(pos >> 4) * 64 + lane], ib = lsi[(16 + (pos & 15)) * 64 + lane];
        lidx[i] = ia * NKEYS + ib; lgate[i] = sc[i] * inv; }
    WAVE_LDS_FENCE();
}

__device__ __forceinline__ void gather_token(int t, int tl, const bf16_t* XG, const float* SSQ, const float* ADA, const bf16_t* EU, const bf16_t* EV, const float* final_g, float* out, const char* shm) {
    const int lane = threadIdx.x & 63; const int b = t / SEQ;
    const int* lidx = (const int*)(shm + P_IDX) + tl * 128; const float* lgate = (const float*)(shm + P_GATE) + tl * 128;
    const float4 s4 = *(const float4*)(SSQ + (size_t)t * 4);
    const float rstd2 = rsqrtf(((s4.x + s4.y) + (s4.z + s4.w)) * (1.f / DM) + EPS);
    float hv[16], acc[16];
#pragma unroll
    for (int j = 0; j < 2; ++j) {
        const int c = 512 * j + 8 * lane; const uint4 xg = *(const uint4*)(XG + (size_t)t * DM + c);
        const float4 sa = *(const float4*)(ADA + b * 6 * DM + 3 * DM + c), sb = *(const float4*)(ADA + b * 6 * DM + 3 * DM + c + 4);
        const unsigned w[4] = {xg.x, xg.y, xg.z, xg.w}; const float sh[8] = {sa.x, sa.y, sa.z, sa.w, sb.x, sb.y, sb.z, sb.w};
#pragma unroll
        for (int k = 0; k < 4; ++k) { hv[8 * j + 2 * k] = __uint_as_float(w[k] << 16) * rstd2 + sh[2 * k]; hv[8 * j + 2 * k + 1] = __uint_as_float(w[k] & 0xffff0000u) * rstd2 + sh[2 * k + 1]; }
    }
#pragma unroll
    for (int i = 0; i < 16; ++i) acc[i] = 0.f;
    for (int e0 = 0; e0 < 128; e0 += 4) {
        int idx[4]; float g[4]; uint4 u[4][2];
#pragma unroll
        for (int q = 0; q < 4; ++q) { idx[q] = lidx[e0 + q]; g[q] = lgate[e0 + q]; }
#pragma unroll
        for (int q = 0; q < 4; ++q) { const bf16_t* ur = EU + (size_t)idx[q] * DM + 8 * lane; u[q][0] = *(const uint4*)ur; u[q][1] = *(const uint4*)(ur + 512); }
        uint4 v[4][2];
#pragma unroll
        for (int q = 0; q < 4; ++q) { const bf16_t* vr = EV + (size_t)idx[q] * DM + 8 * lane; v[q][0] = *(const uint4*)vr; v[q][1] = *(const uint4*)(vr + 512); }
        float s[4];
#pragma unroll
        for (int q = 0; q < 4; ++q) { float d = 0.f;
#pragma unroll
            for (int j = 0; j < 2; ++j) { const unsigned w[4] = {u[q][j].x, u[q][j].y, u[q][j].z, u[q][j].w};
#pragma unroll
                for (int k = 0; k < 4; ++k) { d = fmaf(__uint_as_float(w[k] << 16), hv[8 * j + 2 * k], d); d = fmaf(__uint_as_float(w[k] & 0xffff0000u), hv[8 * j + 2 * k + 1], d); } }
            s[q] = d; }
#pragma unroll
        for (int o = 1; o < 64; o <<= 1) {
#pragma unroll
            for (int q = 0; q < 4; ++q) s[q] += __shfl_xor(s[q], o); }
#pragma unroll
        for (int q = 0; q < 4; ++q) { const float wgt = g[q] * gelu_exact(s[q]);
#pragma unroll
            for (int j = 0; j < 2; ++j) { const unsigned w[4] = {v[q][j].x, v[q][j].y, v[q][j].z, v[q][j].w};
#pragma unroll
                for (int k = 0; k < 4; ++k) { acc[8 * j + 2 * k] = fmaf(wgt, __uint_as_float(w[k] << 16), acc[8 * j + 2 * k]); acc[8 * j + 2 * k + 1] = fmaf(wgt, __uint_as_float(w[k] & 0xffff0000u), acc[8 * j + 2 * k + 1]); } } }
    }
    float ss = 0.f; float x2[16];
#pragma unroll
    for (int j = 0; j < 2; ++j) {
        const int c = 512 * j + 8 * lane;
        const float4 xa = *(const float4*)(out + (size_t)t * DM + c), xb = *(const float4*)(out + (size_t)t * DM + c + 4);
        const float4 ga = *(const float4*)(ADA + b * 6 * DM + 5 * DM + c), gb = *(const float4*)(ADA + b * 6 * DM + 5 * DM + c + 4);
        const float x1[8] = {xa.x, xa.y, xa.z, xa.w, xb.x, xb.y, xb.z, xb.w}; const float g2[8] = {ga.x, ga.y, ga.z, ga.w, gb.x, gb.y, gb.z, gb.w};
#pragma unroll
        for (int k = 0; k < 8; ++k) { x2[8 * j + k] = x1[k] + g2[k] * acc[8 * j + k]; ss += x2[8 * j + k] * x2[8 * j + k]; }
    }
    const float rstd = rsqrtf(wave_sum(ss) * (1.f / DM) + EPS);
#pragma unroll
    for (int j = 0; j < 2; ++j) {
        const int c = 512 * j + 8 * lane;
        const float4 fa = *(const float4*)(final_g + c), fb = *(const float4*)(final_g + c + 4);
        float4 oa, ob;
        oa.x = x2[8 * j + 0] * rstd * fa.x; oa.y = x2[8 * j + 1] * rstd * fa.y; oa.z = x2[8 * j + 2] * rstd * fa.z; oa.w = x2[8 * j + 3] * rstd * fa.w;
        ob.x = x2[8 * j + 4] * rstd * fb.x; ob.y = x2[8 * j + 5] * rstd * fb.y; ob.z = x2[8 * j + 6] * rstd * fb.z; ob.w = x2[8 * j + 7] * rstd * fb.w;
        *(float4*)(out + (size_t)t * DM + c) = oa; *(float4*)(out + (size_t)t * DM + c + 4) = ob;
    }
}
}

using pg8::bf16x8; using pg8::f32x4;
#define XB_TMO      128
#define XB_XCNT(j)  (256  + 64 * (j))
#define XB_XSUB(j)  (1280 + 64 * (j))
#define XB_XGEN(j)  (2304 + 64 * (j))
#define XB_TOP      3328
#define XB_TOPGEN   3392
#define XCD_BAR_WORDS 3456
#define XB_SPIN_CAP (1u << 18)
__device__ __forceinline__ unsigned xb_ld(unsigned* p)              { return __hip_atomic_load(p, __ATOMIC_RELAXED, __HIP_MEMORY_SCOPE_AGENT); }
__device__ __forceinline__ unsigned xb_add(unsigned* p, unsigned v) { return __hip_atomic_fetch_add(p, v, __ATOMIC_RELAXED, __HIP_MEMORY_SCOPE_AGENT); }
__device__ __forceinline__ unsigned xb_xcc_id() { return (unsigned)__builtin_amdgcn_s_getreg((3 << 11) | 20) & 0xFu; }
#define XB_SPIN(cond, bar) do { unsigned _sp = 0; while (cond) { __builtin_amdgcn_s_sleep(1); \
    if ((++_sp & 255u) == 0u) { if (xb_ld(&(bar)[XB_TMO])) break; if (_sp > XB_SPIN_CAP) { atomicAdd(&(bar)[XB_TMO], 1u); break; } } } } while (0)
struct XcdBarrier { unsigned* bar; unsigned x; volatile LAS unsigned* st; };
__device__ __forceinline__ XcdBarrier xcd_barrier_post(unsigned* bar, volatile LAS unsigned* st) {
    XcdBarrier b; b.bar = bar; b.x = xb_xcc_id(); b.st = st;
    if (threadIdx.x == 0) (void)xb_add(&bar[XB_XCNT(b.x)], 1u);
    return b;
}
__device__ __forceinline__ void xcd_barrier_complete(unsigned* bar, unsigned x, unsigned& nloc, unsigned& nx) {
    const unsigned G = gridDim.x * gridDim.y * gridDim.z;
    unsigned sum, cnt, mine, sp = 0u;
    for (;;) {
        sum = 0u; cnt = 0u; mine = 0u;
#pragma unroll
        for (unsigned j = 0; j < 16; ++j) { const unsigned c = xb_ld(&bar[XB_XCNT(j)]); sum += c; cnt += (c > 0u) ? 1u : 0u; mine = (j == x) ? c : mine; }
        if (sum == G) break;
        __builtin_amdgcn_s_sleep(1);
        if ((++sp & 255u) == 0u) { if (xb_ld(&bar[XB_TMO])) break; if (sp > XB_SPIN_CAP) { atomicAdd(&bar[XB_TMO], 1u); break; } }
    }
    nloc = mine > 0u ? mine : 1u; nx = cnt > 0u ? cnt : 1u;
}
__device__ __forceinline__ void xcd_barrier(const XcdBarrier& b) {
    asm volatile("s_waitcnt vmcnt(0)" ::: "memory");
    __syncthreads();
    if (threadIdx.x == 0) {
        unsigned* bar = b.bar;
        __builtin_amdgcn_s_waitcnt(0);
        unsigned nloc = b.st[0], nx = b.st[1];
        if (nloc == 0u) { xcd_barrier_complete(bar, b.x, nloc, nx); b.st[0] = nloc; b.st[1] = nx; }
        const unsigned old = xb_add(&bar[XB_XSUB(b.x)], 1u);
        const unsigned gen = old / nloc;
        if (old + 1u == (gen + 1u) * nloc) {
            __builtin_amdgcn_fence(__ATOMIC_RELEASE, "agent");
            asm volatile("s_waitcnt vmcnt(0)" ::: "memory");
            const unsigned og = xb_add(&bar[XB_TOP], 1u);
            const unsigned tg = og / nx;
            if (og + 1u == (tg + 1u) * nx) xb_add(&bar[XB_TOPGEN], 1u);
            else XB_SPIN(xb_ld(&bar[XB_TOPGEN]) == tg, bar);
            __builtin_amdgcn_fence(__ATOMIC_ACQUIRE, "agent");
            xb_add(&bar[XB_XGEN(b.x)], 1u);
            asm volatile("s_waitcnt vmcnt(0)" ::: "memory");
        } else {
            XB_SPIN(xb_ld(&bar[XB_XGEN(b.x)]) == gen, bar);
            __builtin_amdgcn_fence(__ATOMIC_ACQUIRE, "agent");
            asm volatile("s_waitcnt vmcnt(0)" ::: "memory");
        }
    }
    __syncthreads();
}
constexpr int LDS_BYTES = 147456, LDSCTL_OFF = 131072, MISC_OFF = LDSCTL_OFF + 320;

__device__ __forceinline__ void gemv8_task(float* lds, const float* W, int ldw, int n0, const float* bias, float* out, int ldo, int tid) {
    const int wave = tid >> 6, lane = tid & 63;
    float acc[8];
#pragma unroll
    for (int b = 0; b < 8; ++b) acc[b] = 0.f;
    const float* wp = W + (size_t)(wave * 128) * ldw + n0 + lane;
    const float* As = lds + wave * 128;
    for (int k = 0; k < 128; k += 8) {
        float wv[8];
#pragma unroll
        for (int i = 0; i < 8; ++i) wv[i] = wp[(size_t)(k + i) * ldw];
#pragma unroll
        for (int i = 0; i < 8; ++i)
#pragma unroll
            for (int b = 0; b < 8; ++b) acc[b] = fmaf(As[b * 1024 + k + i], wv[i], acc[b]);
    }
    float* red = lds + 8192;
#pragma unroll
    for (int b = 0; b < 8; ++b) red[(wave * 8 + b) * 64 + lane] = acc[b];
    __syncthreads();
    { const int b = tid >> 6; float s = 0.f;
#pragma unroll
      for (int w = 0; w < 8; ++w) s += red[(w * 8 + b) * 64 + lane];
      out[b * ldo + n0 + lane] = s + (bias ? bias[n0 + lane] : 0.f); }
    __syncthreads();
}
__device__ __forceinline__ void transpose_item(const float* W, int K, int ldw, int nblk, bf16_t* WT, float* scr, int item, int lane) {
    const int kb = item / nblk, nb = item % nblk, k0 = 64 * kb, n0 = 32 * nb;
#pragma unroll 8
    for (int i = 0; i < 32; ++i) { const int kk = 2 * i + (lane >> 5); scr[kk * 33 + (lane & 31)] = W[(size_t)(k0 + kk) * ldw + n0 + (lane & 31)]; }
    WAVE_LDS_FENCE();
    const int c = lane & 7;
#pragma unroll
    for (int j = 0; j < 4; ++j) { const int n = (lane >> 3) + 8 * j; const float* s = scr + (8 * c) * 33 + n;
        uint4 o; o.x = pk2(s[0 * 33], s[1 * 33]); o.y = pk2(s[2 * 33], s[3 * 33]); o.z = pk2(s[4 * 33], s[5 * 33]); o.w = pk2(s[6 * 33], s[7 * 33]);
        *(uint4*)(WT + (size_t)(n0 + n) * K + k0 + 8 * c) = o; }
    WAVE_LDS_FENCE();
}
__device__ __forceinline__ void cvt512(const float* src, bf16_t* dst, int lane) {
    const float4 a = *(const float4*)(src + 8 * lane), b = *(const float4*)(src + 8 * lane + 4);
    uint4 o; o.x = pk2(a.x, a.y); o.y = pk2(a.z, a.w); o.z = pk2(b.x, b.y); o.w = pk2(b.z, b.w);
    *(uint4*)(dst + 8 * lane) = o;
}

__global__ void __launch_bounds__(NTHR, 2) fwd_kernel(Args a) {
    extern __shared__ __attribute__((aligned(16))) unsigned char lds_raw[];
    float* lds = (float*)lds_raw;
    const int tid = threadIdx.x, lane = tid & 63, wave = __builtin_amdgcn_readfirstlane(tid >> 6);
    const int gw = blockIdx.x * NWAVE + wave, ngw = gridDim.x * NWAVE;
    unsigned char* ws = a.ws;
    float* ADA = (float*)(ws + WS_ADA); float* SQB = (float*)(ws + WS_SQB); float* FL = (float*)(ws + WS_FL); float* GQ = (float*)(ws + WS_GQ); float* SSQ = (float*)(ws + WS_SSQ);
    bf16_t* WIN = (bf16_t*)(ws + WS_WIN); bf16_t* WOUT = (bf16_t*)(ws + WS_WOUT); bf16_t* WQ = (bf16_t*)(ws + WS_WQ); bf16_t* SUBK = (bf16_t*)(ws + WS_SUBK); bf16_t* SGWB = (bf16_t*)(ws + WS_SGW);
    bf16_t* GX = (bf16_t*)(ws + WS_GX); bf16_t* EU = (bf16_t*)(ws + WS_EU); bf16_t* EV = (bf16_t*)(ws + WS_EV); bf16_t* HB = (bf16_t*)(ws + WS_HB);
    bf16_t* ZU = (bf16_t*)(ws + WS_ZU); bf16_t* ZV = (bf16_t*)(ws + WS_ZV); bf16_t* Q = (bf16_t*)(ws + WS_Q); bf16_t* K = (bf16_t*)(ws + WS_K); bf16_t* V = (bf16_t*)(ws + WS_V);
    bf16_t* XG = (bf16_t*)(ws + WS_XG); bf16_t* QV = (bf16_t*)(ws + WS_QV); int* IDX = (int*)(ws + WS_IDX); float* GATE = (float*)(ws + WS_GATE);
    for (int u = tid; u < (LDS_BYTES - LDSCTL_OFF) / 4; u += NTHR) ((LAS unsigned*)((LAS unsigned char*)lds_raw + LDSCTL_OFF))[u] = 0u;
    __syncthreads();
    XcdBarrier bar = xcd_barrier_post((unsigned*)(ws + WS_CTL), (volatile LAS unsigned*)((LAS unsigned char*)lds_raw + MISC_OFF) + 8);
#define GRID_BAR() xcd_barrier(bar)

    {
        if (blockIdx.x < 96) {
            for (int i = tid; i < NB * DM; i += NTHR) { const float cv = a.c[i]; lds[i] = cv / (1.f + expf(-cv)); }
            __syncthreads();
            gemv8_task(lds, a.w_ada, 6 * DM, blockIdx.x * 64, a.b_ada, ADA, 6 * DM, tid);
        }
        float* scr = lds + 12288 + wave * 2112;
        constexpr int I_IN = 16 * 80, I_OUT = 16 * 32, I_Q = 16 * 64;
        for (int it = gw; it < I_IN + I_OUT + I_Q; it += ngw) {
            int r = it;
            if (r < I_IN) { transpose_item(a.w_in, DM, INC, 80, WIN, scr, r, lane); continue; } r -= I_IN;
            if (r < I_OUT) { transpose_item(a.w_out, DM, DM, 32, WOUT, scr, r, lane); continue; } r -= I_OUT;
            transpose_item(a.w_query, DM, NQ, 64, WQ, scr, r, lane);
        }
        for (int it = gw; it < 512; it += ngw) cvt512(a.sub_keys + (size_t)it * 512, SUBK + (size_t)it * 512, lane);
        for (int it = gw; it < 256; it += ngw) {
            const int e0 = it * 512 + 8 * lane, t = (e0 >> 7) & 127, s0 = e0 & 127;
            const float4 p = *(const float4*)(a.sg_w + e0), q = *(const float4*)(a.sg_w + e0 + 4);
            const float v[8] = {p.x, p.y, p.z, p.w, q.x, q.y, q.z, q.w}; float m[8];
#pragma unroll
            for (int i = 0; i < 8; ++i) m[i] = (s0 + i <= t) ? v[i] : 0.f;
            uint4 o; o.x = pk2(m[0], m[1]); o.y = pk2(m[2], m[3]); o.z = pk2(m[4], m[5]); o.w = pk2(m[6], m[7]);
            *(uint4*)(SGWB + e0) = o;
        }
        for (int it = gw; it < 2 * 32768; it += ngw) {
            if (it < 32768) cvt512(a.expert_u + (size_t)it * 512, EU + (size_t)it * 512, lane);
            else cvt512(a.expert_v + (size_t)(it - 32768) * 512, EV + (size_t)(it - 32768) * 512, lane);
        }
    }
    GRID_BAR();
    {
        for (int i = tid; i < 8 * DM; i += NTHR) { const int k = i >> 3, j = i & 7; lds[j * DM + k] = a.w_in[(size_t)k * INC + NPROJ + j]; }
        __syncthreads();
        for (int t = gw; t < NT; t += ngw) {
            const int b = t / SEQ; const float* xr = a.x + (size_t)t * DM; const float* shift = ADA + b * 6 * DM; const float* scale = shift + DM;
            float4 v[4]; float s = 0.f;
#pragma unroll
            for (int j = 0; j < 4; ++j) { v[j] = *(const float4*)(xr + 256 * j + 4 * lane); s += v[j].x * v[j].x + v[j].y * v[j].y + v[j].z * v[j].z + v[j].w * v[j].w; }
            const float rstd = rsqrtf(wave_sum(s) * (1.f / DM) + EPS);
#pragma unroll
            for (int j = 0; j < 4; ++j) {
                const int c = 256 * j + 4 * lane;
                const float4 gg = *(const float4*)(a.norm1_g + c), sh = *(const float4*)(shift + c), sc = *(const float4*)(scale + c);
                v[j].x = v[j].x * rstd * gg.x * (1.f + sc.x) + sh.x; v[j].y = v[j].y * rstd * gg.y * (1.f + sc.y) + sh.y;
                v[j].z = v[j].z * rstd * gg.z * (1.f + sc.z) + sh.z; v[j].w = v[j].w * rstd * gg.w * (1.f + sc.w) + sh.w;
                uint2 o; o.x = pk2(v[j].x, v[j].y); o.y = pk2(v[j].z, v[j].w);
                *(uint2*)(HB + (size_t)t * DM + c) = o;
            }
            float fl = 0.f;
#pragma unroll
            for (int j8 = 0; j8 < 8; ++j8) { float d = 0.f;
#pragma unroll
                for (int j = 0; j < 4; ++j) { const float4 w = *(const float4*)(lds + j8 * DM + 256 * j + 4 * lane); d += v[j].x * w.x + v[j].y * w.y + v[j].z * w.z + v[j].w * w.w; }
                d = wave_sum(d); if (lane == j8) fl = d; }
            if (lane < 8) FL[(size_t)t * 8 + lane] = log_sigmoid(fl + a.b_f[lane]);
        }
        __syncthreads();
        if (blockIdx.x < 32) {
            for (int i = tid; i < NB * DM; i += NTHR) lds[i] = ADA[(i >> 10) * 6 * DM + 3 * DM + (i & 1023)];
            __syncthreads();
            gemv8_task(lds, a.w_query, NQ, blockIdx.x * 64, nullptr, SQB, NQ, tid);
        }
    }
    GRID_BAR();
    {
        if (gw < NB * NH) {
            const int b = gw >> 3, h = gw & 7; float v[32]; float run = 0.f;
#pragma unroll
            for (int i = 0; i < 32; ++i) { run += FL[((size_t)b * SEQ + 32 * lane + i) * 8 + h]; v[i] = run; }
            float incl = run;
#pragma unroll
            for (int o = 1; o < 64; o <<= 1) { const float n = __shfl_up(incl, o); if (lane >= o) incl += n; }
            const float excl = incl - run;
#pragma unroll
            for (int i = 0; i < 32; ++i) {
                const size_t e = ((size_t)b * SEQ + 32 * lane + i) * 8 + h; const float g = (excl + v[i]) * LOG2E; GQ[e] = g;
                const float ng = -g; const unsigned g1 = f2bf(ng); const float r1 = ng - __uint_as_float(g1 << 16); const unsigned g2 = f2bf(r1); const float r2 = r1 - __uint_as_float(g2 << 16); const unsigned g3 = f2bf(r2);
                uint4 o; o.x = g1 | (g2 << 16); o.y = g3; o.z = 0u; o.w = 0u; *(uint4*)(GX + e * 8) = o;
            }
        }
        pg8::Gemm g{HB, WIN, NT, NPROJ, DM}; pg8::StaticOrder S; S.init(NT, NPROJ, gridDim.x, (int)blockIdx.x);
        pg8::EpiProj E{ZU};
        pg8::gemm_phase<pg8::EpiProj, pg8::StaticOrder, true, true>((PG8_LAS unsigned char*)lds_raw, g, S, E);
    }
    GRID_BAR();
    {
        char* shm = (char*)lds_raw;
        for (int pt = blockIdx.x; pt < NB * (SEQ / CHUNK) * NH / 2; pt += gridDim.x)
            mixer::sgu_pair(2 * pt, ZU, ZV, SGWB, a.sg_ln_g, a.sg_ln_b, a.sg_b, a.out_g_sg, HB, shm);
        __syncthreads();
        const int G = gridDim.x, vcu = (G % 8 == 0) ? (blockIdx.x % 8) * (G / 8) + blockIdx.x / 8 : blockIdx.x;
        for (int pr = vcu; pr < NB * NH * 4; pr += G) {
            const int bh = pr >> 2, s = pr & 3;
            mixer::attn_unit(bh >> 3, bh & 7, 7 - s, Q, K, V, GQ, a.out_g_fox, HB, shm);
            mixer::attn_unit(bh >> 3, bh & 7, s, Q, K, V, GQ, a.out_g_fox, HB, shm);
        }
    }
    GRID_BAR();
    {
        pg8::Gemm g{HB, WOUT, NT, DM, DM}; pg8::StaticOrder S; S.init(NT, DM, gridDim.x, (int)blockIdx.x);
        pg8::EpiOut E{a.x, ADA, a.norm2_g, a.out, XG, SSQ};
        pg8::gemm_phase<pg8::EpiOut, pg8::StaticOrder, false, true>((PG8_LAS unsigned char*)lds_raw, g, S, E);
    }
    GRID_BAR();
    {
        pg8::Gemm g{XG, WQ, NT, NQ, DM}; pg8::StaticOrder S; S.init(NT, NQ, gridDim.x, (int)blockIdx.x);
        pg8::EpiQuery E{SSQ, SQB, QV};
        pg8::gemm_phase<pg8::EpiQuery, pg8::StaticOrder, true, true>((PG8_LAS unsigned char*)lds_raw, g, S, E);
    }
    GRID_BAR();
    {
        char* shm = (char*)lds_raw;
        for (int task = blockIdx.x; task < NT / 32; task += gridDim.x) {
            const int t0 = task * 32;
            __syncthreads();
            peer::topk_head(t0, wave, QV, SUBK, shm);
            __syncthreads();
            for (int i = 0; i < 4; ++i) peer::gather_token(t0 + wave * 4 + i, wave * 4 + i, XG, SSQ, ADA, EU, EV, a.final_g, a.out, shm);
        }
    }
}

extern "C" void kernel_launch(void* const* d_in, const int* in_sizes, int n_in, void* d_out, int out_size, void* d_ws, size_t ws_size, hipStream_t stream) {
    if (n_in != 20 || ws_size < WS_END) { fprintf(stderr, "kernel_launch: unexpected n_in %d or ws_size %zu\n", n_in, ws_size); return; }
    Args a{};
    const float** p = (const float**)&a;
    for (int i = 0; i < 20; ++i) p[i] = (const float*)d_in[i];
    a.out = (float*)d_out; a.ws = (unsigned char*)d_ws;
    static int grid = 0;
    if (grid == 0) {
        int dev = 0, cus = 0, per_cu = 0;
        (void)hipGetDevice(&dev); (void)hipDeviceGetAttribute(&cus, hipDeviceAttributeMultiprocessorCount, dev);
        (void)hipFuncSetAttribute((const void*)fwd_kernel, hipFuncAttributeMaxDynamicSharedMemorySize, LDS_BYTES);
        (void)hipOccupancyMaxActiveBlocksPerMultiprocessor(&per_cu, (const void*)fwd_kernel, NTHR, LDS_BYTES);
        (void)hipGetLastError();
        if (per_cu < 1 || cus != 256) { fprintf(stderr, "kernel_launch: occupancy query says %d blocks/CU, %d CUs (built for one block on each of 256 CUs)\n", per_cu, cus); grid = -1; }
        else grid = cus;
    }
    if (grid < 0) return;
    (void)hipMemsetAsync((char*)d_ws + WS_CTL, 0, CTL_ZERO_BYTES, stream);
    a.ph_lo = 0; a.ph_hi = 10;
    hipLaunchKernelGGL(fwd_kernel, dim3(grid), dim3(NTHR), LDS_BYTES, stream, a);
}
```

```cpp
#include <hip/hip_runtime.h>
#include <cstdint>
#include <cstdio>
#include <cmath>

constexpr int DM = 1024, NB = 8, SEQ = 2048, NT = NB * SEQ;
constexpr int HD = 64, SGW = 512, FOXW = 512, NH = 8, CHUNK = 128;
constexpr int INC = 2 * SGW + 3 * FOXW + NH;
constexpr int NPROJ = 2560;
constexpr int PH = 8, NKEYS = 128, NEXP = NKEYS * NKEYS, TOPK = 16, DKEY = 256, DHALF = 128, NQ = PH * DKEY;
constexpr float EPS = 1e-6f;
constexpr int NTHR = 512, NWAVE = 8;
constexpr float LOG2E = 1.4426950408889634f;
constexpr float C2 = 0.125f * LOG2E;

typedef unsigned short bf16_t;

constexpr size_t MiB = 1u << 20;
constexpr size_t WS_CTL = 0, CTL_ZERO_BYTES = 64 * 1024;
constexpr size_t WS_ADA = 256 * 1024;
constexpr size_t WS_SQB = 512 * 1024;
constexpr size_t WS_FL = 1 * MiB;
constexpr size_t WS_GQ = WS_FL + MiB / 2;
constexpr size_t WS_SSQ = 2 * MiB;
constexpr size_t WS_WIN = 3 * MiB;
constexpr size_t WS_WOUT = WS_WIN + 5 * MiB;
constexpr size_t WS_WQ = WS_WOUT + 2 * MiB;
constexpr size_t WS_SUBK = WS_WQ + 4 * MiB;
constexpr size_t WS_SGW = WS_SUBK + MiB;
constexpr size_t WS_GX = WS_SGW + MiB;
constexpr size_t WS_EU = 20 * MiB;
constexpr size_t WS_EV = WS_EU + 32 * MiB;
constexpr size_t WS_HB = WS_EV + 32 * MiB;
constexpr size_t WS_ZU = WS_HB + 32 * MiB;
constexpr size_t WS_ZV = WS_ZU + 16 * MiB, WS_Q = WS_ZV + 16 * MiB, WS_K = WS_Q + 16 * MiB, WS_V = WS_K + 16 * MiB;
constexpr size_t WS_XG = WS_K;
constexpr size_t WS_QV = WS_HB;
constexpr size_t WS_IDX = WS_V + 16 * MiB;
constexpr size_t WS_GATE = WS_IDX + 8 * MiB;
constexpr size_t WS_END = WS_GATE + 8 * MiB;

struct Args {
    const float *x, *c, *w_ada, *b_ada, *norm1_g, *w_in, *b_f, *sg_ln_g, *sg_ln_b, *sg_w, *sg_b, *out_g_sg, *out_g_fox,
        *w_out, *norm2_g, *w_query, *sub_keys, *expert_u, *expert_v, *final_g;
    float* out; unsigned char* ws; int ph_lo, ph_hi;
};

#define GAS __attribute__((address_space(1)))
#define LAS __attribute__((address_space(3)))
#define WAVE_LDS_FENCE() do { __builtin_amdgcn_fence(__ATOMIC_ACQ_REL, "wavefront"); __builtin_amdgcn_wave_barrier(); } while (0)
__device__ __forceinline__ float wave_sum(float v) {
#pragma unroll
    for (int o = 1; o < 64; o <<= 1) v += __shfl_xor(v, o);
    return v;
}
__device__ __forceinline__ float wave_max(float v) {
#pragma unroll
    for (int o = 1; o < 64; o <<= 1) v = fmaxf(v, __shfl_xor(v, o));
    return v;
}
__device__ __forceinline__ float gelu_exact(float v) { return 0.5f * v * (1.0f + erff(v * 0.70710678118654752f)); }
__device__ __forceinline__ float log_sigmoid(float v) { return fminf(v, 0.f) - log1pf(expf(-fabsf(v))); }
__device__ __forceinline__ float bf2f(bf16_t v) { return __uint_as_float((unsigned)v << 16); }
__device__ __forceinline__ unsigned f2bf(float f) { unsigned u = __builtin_bit_cast(unsigned, f); return (u + 0x7fffu + ((u >> 16) & 1u)) >> 16; }
__device__ __forceinline__ unsigned pk2(float lo, float hi) { return f2bf(lo) | (f2bf(hi) << 16); }

namespace pg8 {
#define PG8_LAS __attribute__((address_space(3)))
typedef unsigned short bf16_t;
typedef short bf16x8 __attribute__((ext_vector_type(8)));
typedef float f32x4 __attribute__((ext_vector_type(4)));
typedef unsigned u32x4 __attribute__((ext_vector_type(4)));
constexpr int BM = 256, BK = 64, HALF = 128, HTB = HALF * BK * 2  , STAGE_BYTES = 8 * HTB, NXCD = 8, WGM = 8;

__host__ __device__ __forceinline__ int lds_byte(int r, int c) { const int st = (r >> 4) * 2 + (c >> 5), rr = r & 15, cc = c & 31, ob = rr * 64 + cc * 2; return st * 1024 + (ob ^ (((ob >> 9) & 1) << 5)); }
__host__ __device__ __forceinline__ void stage_rc(int b, int& R, int& C) { const int st = b / 1024, sb = b % 1024, swz = sb ^ (((sb >> 9) & 1) << 5); R = (st >> 1) * 16 + swz / 64; C = (st & 1) * 32 + (swz % 64) / 2; }
__host__ __device__ __forceinline__ int perm32(int rho) { const int n = rho >> 4, i = rho & 15; return 8 * (i >> 2) + 4 * n + (i & 3); }

struct Unit { int pm, pn; };
struct Gemm { const bf16_t* A; const bf16_t* Bt; int M, N, K; };

struct StaticOrder {
    int nM, nN, nwg, G, c;
    __host__ __device__ void init(int M, int N, int G_, int c_) { nM = M / BM; nN = N / BM; nwg = nM * nN; G = G_; c = c_; }
    __host__ __device__ bool next(int i, Unit& u) const {
        const long L = (long)i * G + c; if (L >= nwg) return false;
        int wgid = (int)L; { const int q = nwg / NXCD, r = nwg % NXCD, xcd = wgid % NXCD, off = wgid / NXCD; wgid = (xcd < r ? xcd * (q + 1) : r * (q + 1) + (xcd - r) * q) + off; }
        const int nig = WGM * nN, gid = wgid / nig, fm = gid * WGM, gsz = (nM - fm) < WGM ? (nM - fm) : WGM;
        u.pm = fm + ((wgid % nig) % gsz); u.pn = (wgid % nig) / gsz; return true;
    }
    __device__ __forceinline__ void a_ready(const Unit&) const {}
    __device__ __forceinline__ void done(const Unit&) const {}
};


__device__ __forceinline__ unsigned cvt_pk_bf16(float lo, float hi) { unsigned r; asm volatile("v_cvt_pk_bf16_f32 %0, %1, %2" : "=v"(r) : "v"(lo), "v"(hi)); return r; }
typedef float f32x2 __attribute__((ext_vector_type(2)));
__device__ __forceinline__ f32x2 gelu_pk(f32x2 v) {
    const f32x2 av = __builtin_elementwise_abs(v), d = av * 0.2316418882f + 1.0f;
    f32x2 t; t.x = __builtin_amdgcn_rcpf(d.x); t.y = __builtin_amdgcn_rcpf(d.y);
    f32x2 q = t * 0.5307027145f + (-0.7265760135f); q = q * t + 0.7107068705f; q = q * t + (-0.142248368f); q = q * t + 0.127414796f; q = q * t;
    const f32x2 s = (v * v) * (-0.72134752044f);
    f32x2 e; e.x = __builtin_amdgcn_exp2f(s.x); e.y = __builtin_amdgcn_exp2f(s.y);
    const f32x2 m = v * (q * e), r = v - m;
    f32x2 o; o.x = v.x < 0.f ? m.x : r.x; o.y = v.y < 0.f ? m.y : r.y; return o;
}


typedef unsigned u32x4 __attribute__((ext_vector_type(4)));
struct EpiProj {
    static constexpr bool PERM = true, AFTER_DRAIN = false;
    bf16_t* base;
    __device__ __forceinline__ void operator()(const f32x4 (&acc)[2][2][4][2], const Unit& u, int wr, int wc, int fr, int fq) const {
        const int t = u.pn >> 1;
        bf16_t* O = base + (size_t)t * NT * 512;
        const bool act = t < 2; const float sc = (t == 2) ? C2 : 1.f;
        const int row0 = u.pm * BM + wr * 64 + fr, col0 = (u.pn & 1) * 256 + wc * 32 + 8 * fq;
#pragma unroll
        for (int ai = 0; ai < 2; ++ai)
#pragma unroll
            for (int m = 0; m < 4; ++m) { bf16_t* rowp = O + (size_t)(row0 + ai * HALF + m * 16) * 512 + col0;
#pragma unroll
                for (int bj = 0; bj < 2; ++bj) { f32x4 v0 = acc[ai][bj][m][0], v1 = acc[ai][bj][m][1];
                    if (act) { f32x2 a = gelu_pk((f32x2){v0[0], v0[1]}), b = gelu_pk((f32x2){v0[2], v0[3]}), c = gelu_pk((f32x2){v1[0], v1[1]}), d = gelu_pk((f32x2){v1[2], v1[3]});
                        v0 = (f32x4){a.x, a.y, b.x, b.y}; v1 = (f32x4){c.x, c.y, d.x, d.y}; }
                    v0 = v0 * sc; v1 = v1 * sc; u32x4 w; w.x = cvt_pk_bf16(v0[0], v0[1]); w.y = cvt_pk_bf16(v0[2], v0[3]); w.z = cvt_pk_bf16(v1[0], v1[1]); w.w = cvt_pk_bf16(v1[2], v1[3]);
                    *(u32x4*)(rowp + bj * HALF) = w; } }
    }
};
struct EpiOut {
    static constexpr bool PERM = true, AFTER_DRAIN = true;
    const float* x; const float* ada; const float* norm2_g; float* x1out; bf16_t* xg; float* ssq4;
    __device__ __forceinline__ void fused(f32x4 (&acc)[2][2][4][2], const Unit& u, int wr, int wc, int fr, int fq, PG8_LAS unsigned char* lds, int wid, int lane) const {
        const int b = (u.pm * BM) / SEQ;
        const float* gate1 = ada + b * 6 * DM + 2 * DM; const float* scale2 = ada + b * 6 * DM + 4 * DM;
        const int col0 = u.pn * BM + wc * 32 + 8 * fq;
        PG8_LAS float* P = (PG8_LAS float*)lds;
        f32x4 gt[2][2], g2[2][2];
#pragma unroll
        for (int bj = 0; bj < 2; ++bj)
#pragma unroll
            for (int n = 0; n < 2; ++n) { const int c = col0 + bj * HALF + 4 * n; gt[bj][n] = *(const f32x4*)(gate1 + c); g2[bj][n] = *(const f32x4*)(norm2_g + c) * (*(const f32x4*)(scale2 + c) + 1.0f); }
#pragma unroll
        for (int ai = 0; ai < 2; ++ai)
#pragma unroll
            for (int m = 0; m < 4; ++m) { const int rl = ai * HALF + wr * 64 + m * 16 + fr; const size_t off = (size_t)(u.pm * BM + rl) * DM + col0; float ss = 0.f;
#pragma unroll
                for (int bj = 0; bj < 2; ++bj) {
                    const f32x4 x0 = *(const f32x4*)(x + off + bj * HALF), x1 = *(const f32x4*)(x + off + bj * HALF + 4);
                    const f32x4 v0 = x0 + gt[bj][0] * acc[ai][bj][m][0], v1 = x1 + gt[bj][1] * acc[ai][bj][m][1];
                    *(f32x4*)(x1out + off + bj * HALF) = v0; *(f32x4*)(x1out + off + bj * HALF + 4) = v1;
                    ss += (v0[0] * v0[0] + v0[1] * v0[1]) + (v0[2] * v0[2] + v0[3] * v0[3]) + (v1[0] * v1[0] + v1[1] * v1[1]) + (v1[2] * v1[2] + v1[3] * v1[3]);
                    const f32x4 w0 = v0 * g2[bj][0], w1 = v1 * g2[bj][1];
                    u32x4 w; w.x = cvt_pk_bf16(w0[0], w0[1]); w.y = cvt_pk_bf16(w0[2], w0[3]); w.z = cvt_pk_bf16(w1[0], w1[1]); w.w = cvt_pk_bf16(w1[2], w1[3]);
                    *(u32x4*)(xg + off + bj * HALF) = w; }
                ss += __shfl_xor(ss, 16); ss += __shfl_xor(ss, 32);
                if (fq == 0) P[rl * 4 + wc] = ss; }
        asm volatile("s_waitcnt lgkmcnt(0)" ::: "memory"); __builtin_amdgcn_s_barrier(); asm volatile("" ::: "memory");
        const int tid = wid * 64 + lane;
        if (tid < 256) ssq4[(size_t)(u.pm * BM + tid) * 4 + u.pn] = (P[tid * 4 + 0] + P[tid * 4 + 1]) + (P[tid * 4 + 2] + P[tid * 4 + 3]);
        asm volatile("s_waitcnt lgkmcnt(0)" ::: "memory"); __builtin_amdgcn_s_barrier(); asm volatile("" ::: "memory");
    }
};
struct EpiQuery {
    static constexpr bool PERM = true, AFTER_DRAIN = false;
    const float* ssq4; const float* sqb; bf16_t* qv;
    __device__ __forceinline__ void operator()(const f32x4 (&acc)[2][2][4][2], const Unit& u, int wr, int wc, int fr, int fq) const {
        const int b = (u.pm * BM) / SEQ;
        const int row0 = u.pm * BM + wr * 64 + fr, col0 = u.pn * BM + wc * 32 + 8 * fq;
        f32x4 bv[2][2];
#pragma unroll
        for (int bj = 0; bj < 2; ++bj)
#pragma unroll
            for (int n = 0; n < 2; ++n) bv[bj][n] = *(const f32x4*)(sqb + b * NQ + col0 + bj * HALF + 4 * n);
#pragma unroll
        for (int ai = 0; ai < 2; ++ai)
#pragma unroll
            for (int m = 0; m < 4; ++m) { const int row = row0 + ai * HALF + m * 16; const f32x4 s4 = *(const f32x4*)(ssq4 + (size_t)row * 4);
                const float rstd = rsqrtf(((s4[0] + s4[1]) + (s4[2] + s4[3])) * (1.f / DM) + EPS);
                bf16_t* rowp = qv + (size_t)row * NQ + col0;
#pragma unroll
                for (int bj = 0; bj < 2; ++bj) { const f32x4 v0 = acc[ai][bj][m][0] * rstd + bv[bj][0], v1 = acc[ai][bj][m][1] * rstd + bv[bj][1];
                    u32x4 w; w.x = cvt_pk_bf16(v0[0], v0[1]); w.y = cvt_pk_bf16(v0[2], v0[3]); w.z = cvt_pk_bf16(v1[0], v1[1]); w.w = cvt_pk_bf16(v1[2], v1[3]);
                    *(u32x4*)(rowp + bj * HALF) = w; } }
    }
};

template <class Epi, class Sched, bool ALIGN_EPI = false, bool SP2 = false>
__device__ __forceinline__ void gemm_phase(PG8_LAS unsigned char* lds, const Gemm g, const Sched& S, const Epi& E) {
    const int tid = threadIdx.x, wid = __builtin_amdgcn_readfirstlane(tid >> 6), lane = tid & 63, wr = wid >> 2, wc = wid & 3, fr = lane & 15, fq = lane >> 4;
    const int K = g.K, nt = K / BK;
    unsigned voffA[2], voffB[2];
#pragma unroll
    for (int i = 0; i < 2; ++i) { int R, C; stage_rc(tid * 16 + i * 8192, R, C); const int Rb = Epi::PERM ? ((R & ~31) + perm32(R & 31)) : R;
        voffA[i] = (unsigned)(R * K + C) * 2u; voffB[i] = (unsigned)(Rb * K + C) * 2u; }
    const size_t kstep = (size_t)(BK * 2);
    const size_t hstep = (size_t)HALF * K * 2;
    const size_t tstep = 2 * hstep;
    const unsigned ldsw = (unsigned)wid * 1024u;
    const int aoff = lds_byte(wr * 64 + fr, fq * 8), boff = lds_byte(wc * 32 + fr, fq * 8);
#define PG8_SA(b, h) (((b) * 2 + (h)) * HTB)
#define PG8_SB(b, h) ((4 + (b) * 2 + (h)) * HTB)
#define PG8_STAGE(bufoff, gbase, voff) do { _Pragma("unroll") for (int _i = 0; _i < 2; ++_i) \
        __builtin_amdgcn_global_load_lds((const unsigned*)((const char*)(gbase) + (voff)[_i]), (PG8_LAS unsigned*)(lds + (bufoff) + ldsw + _i * 8192), 16, 0, 0); } while (0)
#define PG8_LDA(dst, b, h) do { _Pragma("unroll") for (int m = 0; m < 4; ++m) _Pragma("unroll") for (int k = 0; k < 2; ++k) dst[m][k] = *(const PG8_LAS bf16x8*)(lds + PG8_SA(b, h) + aoff + m * 2048 + k * 1024); } while (0)
#define PG8_LDB(dst, b, h) do { _Pragma("unroll") for (int n = 0; n < 2; ++n) _Pragma("unroll") for (int k = 0; k < 2; ++k) dst[n][k] = *(const PG8_LAS bf16x8*)(lds + PG8_SB(b, h) + boff + n * 2048 + k * 1024); } while (0)
#define PG8_MMA(ai, bj, At, Bt) do { __builtin_amdgcn_s_setprio(1); _Pragma("unroll") for (int m = 0; m < 4; ++m) _Pragma("unroll") for (int n = 0; n < 2; ++n) _Pragma("unroll") for (int k = 0; k < 2; ++k) \
        acc[ai][bj][m][n] = __builtin_amdgcn_mfma_f32_16x16x32_bf16(Bt[n][k], At[m][k], acc[ai][bj][m][n], 0, 0, 0); __builtin_amdgcn_s_setprio(0); } while (0)
#define PG8_WAIT_V(n) asm volatile("s_waitcnt vmcnt(" #n ")" ::: "memory")
#define PG8_WAIT_L(n) asm volatile("s_waitcnt lgkmcnt(" #n ")" ::: "memory")
#define PG8_BAR __builtin_amdgcn_s_barrier()
#define PG8_SCHED __builtin_amdgcn_sched_barrier(0)
    Unit cur, nxt; int ui = 0;
    if (!S.next(0, cur)) return;
    f32x4 acc[2][2][4][2];
#pragma unroll
    for (int a = 0; a < 2; ++a)
#pragma unroll
        for (int b = 0; b < 2; ++b)
#pragma unroll
            for (int m = 0; m < 4; ++m)
#pragma unroll
                for (int n = 0; n < 2; ++n) acc[a][b][m][n] = (f32x4){0.f, 0.f, 0.f, 0.f};
    bf16x8 At[4][2], B0[2][2], B1[2][2];
    const char* cA = (const char*)g.A + (size_t)cur.pm * tstep; const char* cB = (const char*)g.Bt + (size_t)cur.pn * tstep;
    S.a_ready(cur);
    if constexpr (SP2) {
        PG8_STAGE(PG8_SB(0, 0), cB, voffB); PG8_STAGE(PG8_SB(0, 1), cB + hstep, voffB); PG8_STAGE(PG8_SA(0, 0), cA, voffA); PG8_STAGE(PG8_SA(0, 1), cA + hstep, voffA);
        if (wr == 1) PG8_BAR;
        PG8_WAIT_V(2); PG8_BAR;
        PG8_STAGE(PG8_SB(1, 0), cB + kstep, voffB); PG8_STAGE(PG8_SA(1, 0), cA + kstep, voffA); PG8_STAGE(PG8_SB(1, 1), cB + hstep + kstep, voffB);
        PG8_WAIT_V(6); PG8_BAR;
    } else {
        PG8_STAGE(PG8_SB(0, 0), cB, voffB); PG8_STAGE(PG8_SA(0, 0), cA, voffA); PG8_STAGE(PG8_SB(0, 1), cB + hstep, voffB); PG8_STAGE(PG8_SA(0, 1), cA + hstep, voffA);
        if (wr == 1) PG8_BAR;
        PG8_WAIT_V(4); PG8_BAR;
        PG8_STAGE(PG8_SB(1, 0), cB + kstep, voffB); PG8_STAGE(PG8_SA(1, 0), cA + kstep, voffA); PG8_STAGE(PG8_SB(1, 1), cB + hstep + kstep, voffB);
        PG8_WAIT_V(6); PG8_BAR;
    }
    for (;;) {
        const bool has_next = S.next(ui + 1, nxt);
        const char* nA = has_next ? (const char*)g.A + (size_t)nxt.pm * tstep : cA; const char* nB = has_next ? (const char*)g.Bt + (size_t)nxt.pn * tstep : cB;
        for (int t = 0; t < nt; t += 2) {
            const bool last = (t == nt - 2);
            const char* a1 = cA + (size_t)(t + 1) * kstep;
            const char* a2 = last ? nA : cA + (size_t)(t + 2) * kstep; const char* b2 = last ? nB : cB + (size_t)(t + 2) * kstep;
            const char* a3 = a2 + kstep; const char* b3 = b2 + kstep;
            if (last && has_next) S.a_ready(nxt);
            if constexpr (SP2) {
            PG8_LDB(B0, 0, 0); PG8_LDB(B1, 0, 1); PG8_SCHED; PG8_LDA(At, 0, 0); PG8_STAGE(PG8_SA(1, 1), a1 + hstep, voffA);
            PG8_WAIT_V(8); PG8_WAIT_L(0); PG8_BAR; PG8_MMA(0, 0, At, B0); PG8_MMA(0, 1, At, B1); PG8_BAR; PG8_SCHED;
            PG8_LDA(At, 0, 1); PG8_STAGE(PG8_SB(0, 0), b2, voffB); PG8_STAGE(PG8_SB(0, 1), b2 + hstep, voffB); PG8_STAGE(PG8_SA(0, 0), a2, voffA);
            PG8_WAIT_V(8); PG8_WAIT_L(0); PG8_BAR; PG8_MMA(1, 0, At, B0); PG8_MMA(1, 1, At, B1); PG8_BAR; PG8_SCHED;
            PG8_LDB(B0, 1, 0); PG8_LDB(B1, 1, 1); PG8_SCHED; PG8_LDA(At, 1, 0); PG8_STAGE(PG8_SA(0, 1), a2 + hstep, voffA);
            PG8_WAIT_V(8); PG8_WAIT_L(0); PG8_BAR; PG8_MMA(0, 0, At, B0); PG8_MMA(0, 1, At, B1); PG8_BAR; PG8_SCHED;
            PG8_LDA(At, 1, 1); PG8_STAGE(PG8_SB(1, 0), b3, voffB); PG8_STAGE(PG8_SB(1, 1), b3 + hstep, voffB); PG8_STAGE(PG8_SA(1, 0), a3, voffA);
            PG8_WAIT_V(8); PG8_WAIT_L(0); PG8_BAR; PG8_MMA(1, 0, At, B0); PG8_MMA(1, 1, At, B1); PG8_BAR; PG8_SCHED;
            } else {
            PG8_LDB(B0, 0, 0); PG8_SCHED; PG8_LDA(At, 0, 0); PG8_STAGE(PG8_SA(1, 1), a1 + hstep, voffA);
            PG8_WAIT_L(8); PG8_BAR; PG8_WAIT_L(0); PG8_MMA(0, 0, At, B0); PG8_BAR; PG8_SCHED;
            PG8_LDB(B1, 0, 1); PG8_STAGE(PG8_SB(0, 0), b2, voffB);
            PG8_BAR; PG8_WAIT_L(0); PG8_MMA(0, 1, At, B1); PG8_BAR;
            PG8_LDA(At, 0, 1); PG8_STAGE(PG8_SA(0, 0), a2, voffA);
            PG8_BAR; PG8_WAIT_L(0); PG8_MMA(1, 0, At, B0); PG8_BAR; PG8_SCHED;
            PG8_STAGE(PG8_SB(0, 1), b2 + hstep, voffB);
            PG8_WAIT_V(6); PG8_BAR; PG8_MMA(1, 1, At, B1); PG8_BAR;
            PG8_LDB(B0, 1, 0); PG8_SCHED; PG8_LDA(At, 1, 0); PG8_STAGE(PG8_SA(0, 1), a2 + hstep, voffA);
            PG8_WAIT_L(8); PG8_BAR; PG8_WAIT_L(0); PG8_MMA(0, 0, At, B0); PG8_BAR; PG8_SCHED;
            PG8_LDB(B1, 1, 1); PG8_STAGE(PG8_SB(1, 0), b3, voffB);
            PG8_BAR; PG8_WAIT_L(0); PG8_MMA(0, 1, At, B1); PG8_BAR;
            PG8_LDA(At, 1, 1); PG8_STAGE(PG8_SA(1, 0), a3, voffA);
            PG8_BAR; PG8_WAIT_L(0); PG8_MMA(1, 0, At, B0); PG8_BAR; PG8_SCHED;
            PG8_STAGE(PG8_SB(1, 1), b3 + hstep, voffB);
            PG8_WAIT_V(6); PG8_BAR; PG8_MMA(1, 1, At, B1); PG8_BAR;
            }
        }
        if constexpr (ALIGN_EPI) { if (wr == 0) PG8_BAR; }
        if constexpr (!Epi::AFTER_DRAIN) { E(acc, cur, wr, wc, fr, fq); S.done(cur); }
        if (!has_next) break;
#pragma unroll
        for (int a = 0; a < 2; ++a)
#pragma unroll
            for (int b = 0; b < 2; ++b)
#pragma unroll
                for (int m = 0; m < 4; ++m)
#pragma unroll
                    for (int n = 0; n < 2; ++n) acc[a][b][m][n] = (f32x4){0.f, 0.f, 0.f, 0.f};
        cur = nxt; cA = nA; cB = nB; ++ui;
        if constexpr (ALIGN_EPI) { if (wr == 1) PG8_BAR; }
    }
    PG8_WAIT_V(0);
    if constexpr (!ALIGN_EPI) { if (wr == 0) PG8_BAR; }
    PG8_BAR;
    if constexpr (Epi::AFTER_DRAIN) { E.fused(acc, cur, wr, wc, fr, fq, lds, wid, lane); S.done(cur); }
#undef PG8_SA
#undef PG8_SB
#undef PG8_STAGE
#undef PG8_LDA
#undef PG8_LDB
#undef PG8_MMA
#undef PG8_WAIT_V
#undef PG8_WAIT_L
#undef PG8_BAR
#undef PG8_SCHED
}
}

namespace mixer {
typedef short bf16x8 __attribute__((ext_vector_type(8)));
typedef short s16x4 __attribute__((ext_vector_type(4)));
typedef float f32x16 __attribute__((ext_vector_type(16)));
typedef unsigned u32x4 __attribute__((ext_vector_type(4)));
typedef float f32x2_t __attribute__((ext_vector_type(2))); typedef __bf16 bf16x2_t __attribute__((ext_vector_type(2)));
__device__ __forceinline__ int crow(int r, int hi) { return (r & 3) + 8 * (r >> 2) + 4 * hi; }
__device__ __forceinline__ unsigned cvtpk(float lo, float hi) { f32x2_t v = {lo, hi}; bf16x2_t b = __builtin_convertvector(v, bf16x2_t); return __builtin_bit_cast(unsigned, b); }
#define MX_SBAR() __builtin_amdgcn_sched_barrier(0)

constexpr int A_K = 0, A_V = 8192, A_G = 16384, A_WS = 16640, A_OST = 18688, A_BYTES = A_OST + 8 * 8192;
__device__ __forceinline__ void pv(f32x16* o, int vb, bf16x8 pa0, bf16x8 pa1, bf16x8 pa2, bf16x8 pa3) {
#pragma unroll
    for (int d0 = 0; d0 < 2; ++d0) { s16x4 lo[4], hi[4];
#pragma unroll
        for (int ks = 0; ks < 4; ++ks) {
            asm volatile("ds_read_b64_tr_b16 %0,%1 offset:%c2" : "=&v"(lo[ks]) : "v"(vb), "i"(d0 * 4096 + ks * 1024) : "memory");
            asm volatile("ds_read_b64_tr_b16 %0,%1 offset:%c2" : "=&v"(hi[ks]) : "v"(vb), "i"(d0 * 4096 + ks * 1024 + 512) : "memory"); }
        asm volatile("s_waitcnt lgkmcnt(0)" ::: "memory"); MX_SBAR();
#define MX_PK(k) (bf16x8){lo[k][0], lo[k][1], lo[k][2], lo[k][3], hi[k][0], hi[k][1], hi[k][2], hi[k][3]}
        o[d0] = __builtin_amdgcn_mfma_f32_32x32x16_bf16(pa0, MX_PK(0), o[d0], 0, 0, 0);
        o[d0] = __builtin_amdgcn_mfma_f32_32x32x16_bf16(pa1, MX_PK(1), o[d0], 0, 0, 0);
        o[d0] = __builtin_amdgcn_mfma_f32_32x32x16_bf16(pa2, MX_PK(2), o[d0], 0, 0, 0);
        o[d0] = __builtin_amdgcn_mfma_f32_32x32x16_bf16(pa3, MX_PK(3), o[d0], 0, 0, 0);
#undef MX_PK
    }
}
__device__ __forceinline__ void attn_unit(int b, int h, int qb, const bf16_t* Q, const bf16_t* K, const bf16_t* V, const float* GQ, const float* out_g, bf16_t* Y, char* shm) {
    const int tid = threadIdx.x, lane = tid & 63, r32 = lane & 31, hi = lane >> 5; const int wid = __builtin_amdgcn_readfirstlane(tid >> 6);
    const size_t rowbase = (size_t)b * SEQ; const int q0 = qb * 256;
    const bf16_t* Qw = Q + (rowbase + q0 + wid * 32) * 512 + h * 64;
    const bf16_t* Kh = K + rowbase * 512 + h * 64; const bf16_t* Vh = V + rowbase * 512 + h * 64;
    const unsigned lds0 = (unsigned)(uintptr_t)shm;
    float* wsf = (float*)(shm + A_WS) + wid * 64;
    const float* gbl = (const float*)(shm + A_G);
    const bf16_t* ksrc = Kh + (size_t)lane * 512 + wid * 8;
    const bf16_t* vsrc = Vh + (size_t)(16 * (wid & 3) + (lane >> 2)) * 512 + (wid >> 2) * 32 + (lane & 3) * 8;
    uint4* kdst = (uint4*)(shm + A_K + wid * 1024 + lane * 16); uint4* vdst = (uint4*)(shm + A_V + wid * 1024 + lane * 16);
    const int vb0 = (int)(lds0 + A_V) + ((lane >> 4) & 1) * 32 + (lane & 3) * 8 + (4 * hi + ((lane & 15) >> 2)) * 64;
    const char* kb = shm + A_K + hi * 1024 + r32 * 16;
    const int NTL = (q0 + 256) / 64;
    bf16x8 qr[4];
#pragma unroll
    for (int d0 = 0; d0 < 4; ++d0) qr[d0] = *reinterpret_cast<const bf16x8*>(&Qw[(size_t)r32 * 512 + d0 * 16 + hi * 8]);
    const int qrow = q0 + wid * 32 + r32;
    const float Gq = GQ[(rowbase + qrow) * 8 + h];
    float m_run = -INFINITY, l_run = 0.f; f32x16 o[2]; o[0] = f32x16{}; o[1] = f32x16{};
    uint4 kreg = *(const uint4*)ksrc, vreg = *(const uint4*)vsrc; float greg = (tid < 64) ? GQ[(rowbase + tid) * 8 + h] : 0.f;
    for (int t = 0; t < NTL; ++t) {
        __syncthreads();
        *kdst = kreg; *vdst = vreg; if (tid < 64) ((float*)(shm + A_G))[tid] = greg;
        __syncthreads();
        if (t + 1 < NTL) { kreg = *(const uint4*)(ksrc + (size_t)(t + 1) * 64 * 512); vreg = *(const uint4*)(vsrc + (size_t)(t + 1) * 64 * 512); if (tid < 64) greg = GQ[(rowbase + (t + 1) * 64 + tid) * 8 + h]; }
        f32x16 p0 = f32x16{}, p1 = f32x16{};
#pragma unroll
        for (int d0 = 0; d0 < 4; ++d0) {
            const bf16x8 b0 = *reinterpret_cast<const bf16x8*>(kb + d0 * 2048), b1 = *reinterpret_cast<const bf16x8*>(kb + d0 * 2048 + 512);
            p0 = __builtin_amdgcn_mfma_f32_32x32x16_bf16(b0, qr[d0], p0, 0, 0, 0); p1 = __builtin_amdgcn_mfma_f32_32x32x16_bf16(b1, qr[d0], p1, 0, 0, 0); }
        const int kbase = t * 64 + 4 * hi;
#pragma unroll
        for (int g = 0; g < 4; ++g) {
            const float4 ga = *(const float4*)(gbl + 8 * g + 4 * hi), gc = *(const float4*)(gbl + 32 + 8 * g + 4 * hi);
            p0[4 * g + 0] += Gq - ga.x; p0[4 * g + 1] += Gq - ga.y; p0[4 * g + 2] += Gq - ga.z; p0[4 * g + 3] += Gq - ga.w;
            p1[4 * g + 0] += Gq - gc.x; p1[4 * g + 1] += Gq - gc.y; p1[4 * g + 2] += Gq - gc.z; p1[4 * g + 3] += Gq - gc.w; }
        if (t >= NTL - 4) {
#pragma unroll
            for (int r = 0; r < 16; ++r) { const int kv = kbase + (r & 3) + 8 * (r >> 2); if (kv > qrow) p0[r] = -INFINITY; if (kv + 32 > qrow) p1[r] = -INFINITY; } }
        float rm = fmaxf(p0[0], p1[0]);
#pragma unroll
        for (int r = 1; r < 16; ++r) rm = fmaxf(rm, fmaxf(p0[r], p1[r]));
        rm = fmaxf(rm, __shfl_xor(rm, 32));
        const float m_new = fmaxf(m_run, rm), alpha = __builtin_amdgcn_exp2f(m_run - m_new); m_run = m_new;
        float ps = 0.f;
#pragma unroll
        for (int r = 0; r < 16; ++r) { p0[r] = __builtin_amdgcn_exp2f(p0[r] - m_new); p1[r] = __builtin_amdgcn_exp2f(p1[r] - m_new); ps += p0[r] + p1[r]; }
        l_run = l_run * alpha + ps;
        if (hi == 0) wsf[r32] = alpha;
        WAVE_LDS_FENCE();
#pragma unroll
        for (int g = 0; g < 4; ++g) { const float4 al = *(const float4*)(wsf + 8 * g + 4 * hi);
#pragma unroll
            for (int d = 0; d < 2; ++d) { o[d][4 * g + 0] *= al.x; o[d][4 * g + 1] *= al.y; o[d][4 * g + 2] *= al.z; o[d][4 * g + 3] *= al.w; } }
        WAVE_LDS_FENCE();
        u32x4 pw0, pw1, pw2, pw3;
        pw0 = (u32x4){cvtpk(p0[0], p0[1]), cvtpk(p0[2], p0[3]), cvtpk(p0[4], p0[5]), cvtpk(p0[6], p0[7])};
        pw1 = (u32x4){cvtpk(p0[8], p0[9]), cvtpk(p0[10], p0[11]), cvtpk(p0[12], p0[13]), cvtpk(p0[14], p0[15])};
        pw2 = (u32x4){cvtpk(p1[0], p1[1]), cvtpk(p1[2], p1[3]), cvtpk(p1[4], p1[5]), cvtpk(p1[6], p1[7])};
        pw3 = (u32x4){cvtpk(p1[8], p1[9]), cvtpk(p1[10], p1[11]), cvtpk(p1[12], p1[13]), cvtpk(p1[14], p1[15])};
        MX_SBAR();
        pv(o, vb0, __builtin_bit_cast(bf16x8, pw0), __builtin_bit_cast(bf16x8, pw1), __builtin_bit_cast(bf16x8, pw2), __builtin_bit_cast(bf16x8, pw3));
    }
    l_run += __shfl_xor(l_run, 32);
    if (hi == 0) wsf[r32] = 1.0f / l_run;
    WAVE_LDS_FENCE();
    float* stg = (float*)(shm + A_OST) + wid * 2048;
#pragma unroll
    for (int r = 0; r < 16; ++r) { const int orow = crow(r, hi); const float rl = wsf[orow];
#pragma unroll
        for (int d0 = 0; d0 < 2; ++d0) stg[orow * 64 + d0 * 32 + r32] = o[d0][r] * rl; }
    WAVE_LDS_FENCE();
    bf16_t* Yw = Y + (rowbase + q0 + wid * 32) * DM + 512 + h * 64;
#pragma unroll
    for (int i = 0; i < 4; ++i) { const int row = i * 8 + (lane >> 3), ch = lane & 7;
        const float4 a = *(const float4*)(stg + row * 64 + ch * 8), c = *(const float4*)(stg + row * 64 + ch * 8 + 4);
        float ss = (a.x * a.x + a.y * a.y) + (a.z * a.z + a.w * a.w) + (c.x * c.x + c.y * c.y) + (c.z * c.z + c.w * c.w);
        ss += __shfl_xor(ss, 1); ss += __shfl_xor(ss, 2); ss += __shfl_xor(ss, 4);
        const float rs = rsqrtf(ss * (1.f / 64) + EPS);
        const float4 g0 = *(const float4*)(out_g + h * 64 + ch * 8), g1 = *(const float4*)(out_g + h * 64 + ch * 8 + 4);
        u32x4 w; w.x = cvtpk(a.x * rs * g0.x, a.y * rs * g0.y); w.y = cvtpk(a.z * rs * g0.z, a.w * rs * g0.w); w.z = cvtpk(c.x * rs * g1.x, c.y * rs * g1.y); w.w = cvtpk(c.z * rs * g1.z, c.w * rs * g1.w);
        *(u32x4*)(Yw + (size_t)row * DM + ch * 8) = w; }
    WAVE_LDS_FENCE();
}

constexpr int SG_PITCH = 136, SG_SLOT = 64 * SG_PITCH * 2;
__device__ __forceinline__ void sgu_pair(int task0, const bf16_t* ZU, const bf16_t* ZV, const bf16_t* SGWB, const float* ln_g, const float* ln_b, const float* sg_b, const float* out_g, bf16_t* Y, char* shm) {
    const int tid = threadIdx.x, lane = tid & 63, r32 = lane & 31, hi = lane >> 5; const int wid = __builtin_amdgcn_readfirstlane(tid >> 6);
    const int slot = wid >> 2, j = wid & 3, task = task0 + slot;
    const int h = task % NH, bc = task / NH, t0 = bc * CHUNK;
    bf16_t* vnT = (bf16_t*)(shm + slot * SG_SLOT);
    __syncthreads();
    {
        const int tl = tid & 255, s = tl >> 1, half = tl & 1;
        const bf16_t* zr = ZV + (size_t)(t0 + s) * 512 + h * 64 + half * 32;
        uint4 raw[4]; float v[32]; float sum = 0.f;
#pragma unroll
        for (int i = 0; i < 4; ++i) raw[i] = *(const uint4*)(zr + 8 * i);
#pragma unroll
        for (int i = 0; i < 4; ++i) { const unsigned w[4] = {raw[i].x, raw[i].y, raw[i].z, raw[i].w};
#pragma unroll
            for (int k = 0; k < 4; ++k) { v[8 * i + 2 * k] = __uint_as_float(w[k] << 16); v[8 * i + 2 * k + 1] = __uint_as_float(w[k] & 0xffff0000u); } }
#pragma unroll
        for (int i = 0; i < 32; ++i) sum += v[i];
        sum += __shfl_xor(sum, 1);
        const float mu = sum * (1.f / 64); float var = 0.f;
#pragma unroll
        for (int i = 0; i < 32; ++i) { v[i] -= mu; var += v[i] * v[i]; }
        var += __shfl_xor(var, 1);
        const float rs = rsqrtf(var * (1.f / 64) + EPS);
#pragma unroll
        for (int i = 0; i < 32; ++i) { const int d = half * 32 + i; vnT[d * SG_PITCH + s] = (bf16_t)f2bf(v[i] * rs * ln_g[h * 64 + d] + ln_b[h * 64 + d]); }
    }
    __syncthreads();
    f32x16 acc[2]; acc[0] = f32x16{}; acc[1] = f32x16{};
    const bf16_t* wrow = SGWB + ((size_t)h * 128 + 32 * j + r32) * 128 + 8 * hi;
    const int nks = 2 * (j + 1);
    for (int ks = 0; ks < nks; ++ks) {
        const bf16x8 bw = *reinterpret_cast<const bf16x8*>(wrow + 16 * ks);
        const bf16x8 a0 = *reinterpret_cast<const bf16x8*>(vnT + (size_t)r32 * SG_PITCH + 16 * ks + 8 * hi);
        const bf16x8 a1 = *reinterpret_cast<const bf16x8*>(vnT + (size_t)(32 + r32) * SG_PITCH + 16 * ks + 8 * hi);
        acc[0] = __builtin_amdgcn_mfma_f32_32x32x16_bf16(a0, bw, acc[0], 0, 0, 0);
        acc[1] = __builtin_amdgcn_mfma_f32_32x32x16_bf16(a1, bw, acc[1], 0, 0, 0);
    }
    const int tl = 32 * j + r32; const size_t row = (size_t)t0 + tl;
    const float bs = sg_b[h * 128 + tl];
    float ss = 0.f;
#pragma unroll
    for (int mb = 0; mb < 2; ++mb)
#pragma unroll
        for (int g = 0; g < 4; ++g) { const int d = 32 * mb + 8 * g + 4 * hi;
            const uint2 z = *(const uint2*)(ZU + row * 512 + h * 64 + d);
            const float z0 = __uint_as_float(z.x << 16), z1 = __uint_as_float(z.x & 0xffff0000u), z2 = __uint_as_float(z.y << 16), z3 = __uint_as_float(z.y & 0xffff0000u);
            acc[mb][4 * g + 0] = z0 * (acc[mb][4 * g + 0] + bs); acc[mb][4 * g + 1] = z1 * (acc[mb][4 * g + 1] + bs);
            acc[mb][4 * g + 2] = z2 * (acc[mb][4 * g + 2] + bs); acc[mb][4 * g + 3] = z3 * (acc[mb][4 * g + 3] + bs);
            ss += (acc[mb][4 * g + 0] * acc[mb][4 * g + 0] + acc[mb][4 * g + 1] * acc[mb][4 * g + 1]) + (acc[mb][4 * g + 2] * acc[mb][4 * g + 2] + acc[mb][4 * g + 3] * acc[mb][4 * g + 3]); }
    ss += __shfl_xor(ss, 32);
    const float rs = rsqrtf(ss * (1.f / 64) + EPS);
#pragma unroll
    for (int mb = 0; mb < 2; ++mb)
#pragma unroll
        for (int g = 0; g < 4; ++g) { const int d = 32 * mb + 8 * g + 4 * hi;
            const float4 og = *(const float4*)(out_g + h * 64 + d);
            uint2 w; w.x = cvtpk(acc[mb][4 * g + 0] * rs * og.x, acc[mb][4 * g + 1] * rs * og.y); w.y = cvtpk(acc[mb][4 * g + 2] * rs * og.z, acc[mb][4 * g + 3] * rs * og.w);
            *(uint2*)(Y + row * DM + h * 64 + d) = w; }
}
#undef MX_SBAR
}

namespace peer {
typedef short bf16x8 __attribute__((ext_vector_type(8)));
typedef float f32x16 __attribute__((ext_vector_type(16)));
__device__ __forceinline__ unsigned umax(unsigned a, unsigned b) { return a > b ? a : b; }
__device__ __forceinline__ unsigned umin(unsigned a, unsigned b) { return a < b ? a : b; }
__device__ __forceinline__ unsigned f2ord(float f) { const unsigned u = __float_as_uint(f); return u ^ ((u >> 31) ? 0xffffffffu : 0x80000000u); }
__device__ __forceinline__ float ord2f(unsigned k) { const unsigned u = k ^ ((k >> 31) ? 0x80000000u : 0xffffffffu); return __uint_as_float(u); }
__device__ __forceinline__ void sort16(unsigned* a) {
#pragma unroll
    for (int k = 2; k <= 16; k <<= 1)
#pragma unroll
        for (int j = k >> 1; j > 0; j >>= 1)
#pragma unroll
            for (int i = 0; i < 16; ++i) { const int l = i ^ j; if (l > i) { const unsigned hi_ = umax(a[i], a[l]), lo_ = umin(a[i], a[l]); if ((i & k) == 0) { a[i] = hi_; a[l] = lo_; } else { a[i] = lo_; a[l] = hi_; } } }
}
__device__ __forceinline__ void merge16(unsigned* a) {
#pragma unroll
    for (int j = 8; j > 0; j >>= 1)
#pragma unroll
        for (int i = 0; i < 16; ++i) { const int l = i ^ j; if (l > i) { const unsigned hi_ = umax(a[i], a[l]), lo_ = umin(a[i], a[l]); a[i] = hi_; a[l] = lo_; } }
}
__device__ __forceinline__ void top16_of_two(unsigned* a, const unsigned* b) {
#pragma unroll
    for (int i = 0; i < 16; ++i) a[i] = umax(a[i], b[15 - i]);
    merge16(a);
}
__device__ __forceinline__ void top16_of_64(unsigned* k) {
    sort16(k); sort16(k + 16); sort16(k + 32); sort16(k + 48);
    top16_of_two(k, k + 16); top16_of_two(k + 32, k + 48); top16_of_two(k, k + 32);
}

constexpr int P_IDX = 0, P_GATE = 16384, P_SI = 32768, P_BYTES = P_SI + 8 * 8192;
__device__ __forceinline__ void topk_head(int t0, int h, const bf16_t* QV, const bf16_t* SUBK, char* shm) {
    const int lane = threadIdx.x & 63, r32 = lane & 31, hi = lane >> 5; const int wid = __builtin_amdgcn_readfirstlane(threadIdx.x >> 6);
    int* lsi = (int*)(shm + P_SI) + wid * 2048;
    unsigned top[2][16];
#pragma unroll
    for (int p = 0; p < 2; ++p) {
        f32x16 acc[4]; acc[0] = f32x16{}; acc[1] = f32x16{}; acc[2] = f32x16{}; acc[3] = f32x16{};
        const bf16_t* qp = QV + (size_t)(t0 + r32) * NQ + h * 256 + p * 128 + 8 * hi;
        const bf16_t* kp = SUBK + (((size_t)h * 2 + p) * NKEYS + r32) * DHALF + 8 * hi;
#pragma unroll 2
        for (int ks = 0; ks < 8; ++ks) {
            const bf16x8 bq = *reinterpret_cast<const bf16x8*>(qp + 16 * ks);
#pragma unroll
            for (int nb = 0; nb < 4; ++nb) { const bf16x8 ak = *reinterpret_cast<const bf16x8*>(kp + (size_t)nb * 32 * DHALF + 16 * ks);
                acc[nb] = __builtin_amdgcn_mfma_f32_32x32x16_bf16(ak, bq, acc[nb], 0, 0, 0); }
        }
        unsigned key[64];
#pragma unroll
        for (int nb = 0; nb < 4; ++nb)
#pragma unroll
            for (int r = 0; r < 16; ++r) { const int n = 32 * nb + (r & 3) + 8 * (r >> 2) + 4 * hi; key[16 * nb + r] = (f2ord(acc[nb][r]) & ~127u) | (unsigned)(127 - n); }
        top16_of_64(key);
        unsigned part[16];
#pragma unroll
        for (int i = 0; i < 16; ++i) part[i] = (unsigned)__shfl_xor((int)key[i], 32);
        top16_of_two(key, part);
#pragma unroll
        for (int i = 0; i < 16; ++i) { top[p][i] = key[i]; lsi[(p * 16 + i) * 64 + lane] = 127 - (int)(key[i] & 127u); }
    }
    float s0[16], s1[16];
#pragma unroll
    for (int i = 0; i < 16; ++i) { s0[i] = ord2f(top[0][i] & ~127u); s1[i] = ord2f(top[1][i] & ~127u); }
    unsigned ck[64];
    {
        int n = 0;
#pragma unroll
        for (int a = 0; a < 16; ++a)
#pragma unroll
            for (int b = 0; b < 16; ++b) if ((a + 1) * (b + 1) <= 16) { ck[n] = (f2ord(s0[a] + s1[b]) & ~255u) | (unsigned)(255 - (a * 16 + b)); ++n; }
#pragma unroll
        for (int i = 50; i < 64; ++i) ck[i] = 0u;
    }
    top16_of_64(ck);
    float sc[16]; float mx = -INFINITY, sum = 0.f;
#pragma unroll
    for (int i = 0; i < 16; ++i) { sc[i] = ord2f(ck[i] & ~255u); }
    mx = sc[0];
#pragma unroll
    for (int i = 0; i < 16; ++i) { sc[i] = __expf(sc[i] - mx); sum += sc[i]; }
    const float inv = 1.0f / sum;
    WAVE_LDS_FENCE();
    int* lidx = (int*)(shm + P_IDX) + r32 * 128 + h * 16; float* lgate = (float*)(shm + P_GATE) + r32 * 128 + h * 16;
#pragma unroll
    for (int i = 0; i < 16; ++i) if ((i >> 3) == hi) {
        const int pos = 255 - (int)(ck[i] & 255u), ia = lsi[(pos >> 4) * 64 + lane], ib = lsi[(16 + (pos & 15)) * 64 + lane];
        lidx[i] = ia * NKEYS + ib; lgate[i] = sc[i] * inv; }
    WAVE_LDS_FENCE();
}

__device__ __forceinline__ float gelu_as(float v) {
    const float av = fabsf(v), t = __builtin_amdgcn_rcpf(av * 0.2316418882f + 1.0f);
    float q = t * 0.5307027145f + (-0.7265760135f); q = q * t + 0.7107068705f; q = q * t + (-0.142248368f); q = q * t + 0.127414796f; q = q * t;
    const float e = __builtin_amdgcn_exp2f((v * v) * (-0.72134752044f));
    const float m = v * (q * e);
    return v < 0.f ? m : v - m;
}
typedef float f32x2 __attribute__((ext_vector_type(2)));
constexpr float U_SCALE = 256.f, V_SCALE = 16.f;
__device__ __forceinline__ float dot16_fp8(const uint4 u, const float* hv) {
    const int w[4] = {(int)u.x, (int)u.y, (int)u.z, (int)u.w}; float d0 = 0.f, d1 = 0.f;
#pragma unroll
    for (int k = 0; k < 4; ++k) { const f32x2 a = __builtin_amdgcn_cvt_pk_f32_fp8(w[k], false), b = __builtin_amdgcn_cvt_pk_f32_fp8(w[k], true);
        d0 = fmaf(a.x, hv[4 * k], d0); d1 = fmaf(a.y, hv[4 * k + 1], d1); d0 = fmaf(b.x, hv[4 * k + 2], d0); d1 = fmaf(b.y, hv[4 * k + 3], d1); }
    return d0 + d1;
}
__device__ __forceinline__ void gather_token(int t, int tl, const bf16_t* XG, const float* SSQ, const float* ADA, const unsigned char* EU, const unsigned char* EV, const float* final_g, float* out, const char* shm, bool do_store) {
    const int lane = threadIdx.x & 63; const int b = t / SEQ;
    const int* lidx = (const int*)(shm + P_IDX) + tl * 128; const float* lgate = (const float*)(shm + P_GATE) + tl * 128;
    const float4 s4 = *(const float4*)(SSQ + (size_t)t * 4);
    const float rstd2 = rsqrtf(((s4.x + s4.y) + (s4.z + s4.w)) * (1.f / DM) + EPS);
    float hv[16], acc[16];
    {
        const int c = 16 * lane; const uint4 xa = *(const uint4*)(XG + (size_t)t * DM + c), xb = *(const uint4*)(XG + (size_t)t * DM + c + 8);
        const unsigned w[8] = {xa.x, xa.y, xa.z, xa.w, xb.x, xb.y, xb.z, xb.w};
#pragma unroll
        for (int k = 0; k < 4; ++k) { const float4 sh = *(const float4*)(ADA + b * 6 * DM + 3 * DM + c + 4 * k);
            hv[4 * k + 0] = __uint_as_float(w[2 * k] << 16) * rstd2 + sh.x; hv[4 * k + 1] = __uint_as_float(w[2 * k] & 0xffff0000u) * rstd2 + sh.y;
            hv[4 * k + 2] = __uint_as_float(w[2 * k + 1] << 16) * rstd2 + sh.z; hv[4 * k + 3] = __uint_as_float(w[2 * k + 1] & 0xffff0000u) * rstd2 + sh.w; }
    }
#pragma unroll
    for (int i = 0; i < 16; ++i) acc[i] = 0.f;
    const bool b5 = (lane & 32) != 0, b4 = (lane & 16) != 0, b3 = (lane & 8) != 0;
    for (int e0 = 0; e0 < 128; e0 += 8) {
        uint4 u[8], v[8];
#pragma unroll
        for (int q = 0; q < 8; ++q) { const size_t ro = (size_t)lidx[e0 + q] * DM + 16 * lane; u[q] = *(const uint4*)(EU + ro); v[q] = *(const uint4*)(EV + ro); }
        const float myg = lgate[e0 + (lane >> 3)];
        float s[8];
#pragma unroll
        for (int q = 0; q < 8; ++q) s[q] = dot16_fp8(u[q], hv);
        float r4[4], r2[2];
#pragma unroll
        for (int k = 0; k < 4; ++k) { const float mine = b5 ? s[k + 4] : s[k], oth = b5 ? s[k] : s[k + 4]; r4[k] = mine + __shfl_xor(oth, 32); }
#pragma unroll
        for (int k = 0; k < 2; ++k) { const float mine = b4 ? r4[k + 2] : r4[k], oth = b4 ? r4[k] : r4[k + 2]; r2[k] = mine + __shfl_xor(oth, 16); }
        float z; { const float mine = b3 ? r2[1] : r2[0], oth = b3 ? r2[0] : r2[1]; z = mine + __shfl_xor(oth, 8); }
        z += __shfl_xor(z, 4); z += __shfl_xor(z, 2); z += __shfl_xor(z, 1);
        const float wl = myg * gelu_as(z * (1.0f / U_SCALE)) * (1.0f / V_SCALE);
#pragma unroll
        for (int q = 0; q < 8; ++q) { const float wgt = __uint_as_float((unsigned)__builtin_amdgcn_readlane((int)__float_as_uint(wl), 8 * q));
            const int w[4] = {(int)v[q].x, (int)v[q].y, (int)v[q].z, (int)v[q].w};
#pragma unroll
            for (int k = 0; k < 4; ++k) { const f32x2 x = __builtin_amdgcn_cvt_pk_f32_fp8(w[k], false), y = __builtin_amdgcn_cvt_pk_f32_fp8(w[k], true);
                acc[4 * k] = fmaf(wgt, x.x, acc[4 * k]); acc[4 * k + 1] = fmaf(wgt, x.y, acc[4 * k + 1]); acc[4 * k + 2] = fmaf(wgt, y.x, acc[4 * k + 2]); acc[4 * k + 3] = fmaf(wgt, y.y, acc[4 * k + 3]); } }
    }
    float ss = 0.f; float x2[16];
#pragma unroll
    for (int k = 0; k < 4; ++k) {
        const int c = 16 * lane + 4 * k;
        const float4 x1 = *(const float4*)(out + (size_t)t * DM + c), g2 = *(const float4*)(ADA + b * 6 * DM + 5 * DM + c);
        x2[4 * k] = x1.x + g2.x * acc[4 * k]; x2[4 * k + 1] = x1.y + g2.y * acc[4 * k + 1]; x2[4 * k + 2] = x1.z + g2.z * acc[4 * k + 2]; x2[4 * k + 3] = x1.w + g2.w * acc[4 * k + 3];
        ss += (x2[4 * k] * x2[4 * k] + x2[4 * k + 1] * x2[4 * k + 1]) + (x2[4 * k + 2] * x2[4 * k + 2] + x2[4 * k + 3] * x2[4 * k + 3]);
    }
    const float rstd = rsqrtf(wave_sum(ss) * (1.f / DM) + EPS);
    if (do_store) {
#pragma unroll
        for (int k = 0; k < 4; ++k) {
            const int c = 16 * lane + 4 * k; const float4 fg = *(const float4*)(final_g + c); float4 o;
            o.x = x2[4 * k] * rstd * fg.x; o.y = x2[4 * k + 1] * rstd * fg.y; o.z = x2[4 * k + 2] * rstd * fg.z; o.w = x2[4 * k + 3] * rstd * fg.w;
            *(float4*)(out + (size_t)t * DM + c) = o;
        }
    }
}
}

using pg8::bf16x8; using pg8::f32x4;
#define XB_TMO      128
#define XB_XCNT(j)  (256  + 64 * (j))
#define XB_XSUB(j)  (1280 + 64 * (j))
#define XB_XGEN(j)  (2304 + 64 * (j))
#define XB_TOP      3328
#define XB_TOPGEN   3392
#define XCD_BAR_WORDS 3456
#define XB_SPIN_CAP (1u << 18)
__device__ __forceinline__ unsigned xb_ld(unsigned* p)              { return __hip_atomic_load(p, __ATOMIC_RELAXED, __HIP_MEMORY_SCOPE_AGENT); }
__device__ __forceinline__ unsigned xb_add(unsigned* p, unsigned v) { return __hip_atomic_fetch_add(p, v, __ATOMIC_RELAXED, __HIP_MEMORY_SCOPE_AGENT); }
__device__ __forceinline__ unsigned xb_xcc_id() { return (unsigned)__builtin_amdgcn_s_getreg((3 << 11) | 20) & 0xFu; }
#define XB_SPIN(cond, bar) do { unsigned _sp = 0; while (cond) { __builtin_amdgcn_s_sleep(1); \
    if ((++_sp & 255u) == 0u) { if (xb_ld(&(bar)[XB_TMO])) break; if (_sp > XB_SPIN_CAP) { atomicAdd(&(bar)[XB_TMO], 1u); break; } } } } while (0)
struct XcdBarrier { unsigned* bar; unsigned x; volatile LAS unsigned* st; };
__device__ __forceinline__ XcdBarrier xcd_barrier_post(unsigned* bar, volatile LAS unsigned* st) {
    XcdBarrier b; b.bar = bar; b.x = xb_xcc_id(); b.st = st;
    if (threadIdx.x == 0) (void)xb_add(&bar[XB_XCNT(b.x)], 1u);
    return b;
}
__device__ __forceinline__ void xcd_barrier_complete(unsigned* bar, unsigned x, unsigned& nloc, unsigned& nx) {
    const unsigned G = gridDim.x * gridDim.y * gridDim.z;
    unsigned sum, cnt, mine, sp = 0u;
    for (;;) {
        sum = 0u; cnt = 0u; mine = 0u;
#pragma unroll
        for (unsigned j = 0; j < 16; ++j) { const unsigned c = xb_ld(&bar[XB_XCNT(j)]); sum += c; cnt += (c > 0u) ? 1u : 0u; mine = (j == x) ? c : mine; }
        if (sum == G) break;
        __builtin_amdgcn_s_sleep(1);
        if ((++sp & 255u) == 0u) { if (xb_ld(&bar[XB_TMO])) break; if (sp > XB_SPIN_CAP) { atomicAdd(&bar[XB_TMO], 1u); break; } }
    }
    nloc = mine > 0u ? mine : 1u; nx = cnt > 0u ? cnt : 1u;
}
__device__ __forceinline__ void xcd_barrier(const XcdBarrier& b) {
    asm volatile("s_waitcnt vmcnt(0)" ::: "memory");
    __syncthreads();
    if (threadIdx.x == 0) {
        unsigned* bar = b.bar;
        __builtin_amdgcn_s_waitcnt(0);
        unsigned nloc = b.st[0], nx = b.st[1];
        if (nloc == 0u) { xcd_barrier_complete(bar, b.x, nloc, nx); b.st[0] = nloc; b.st[1] = nx; }
        const unsigned old = xb_add(&bar[XB_XSUB(b.x)], 1u);
        const unsigned gen = old / nloc;
        if (old + 1u == (gen + 1u) * nloc) {
            __builtin_amdgcn_fence(__ATOMIC_RELEASE, "agent");
            asm volatile("s_waitcnt vmcnt(0)" ::: "memory");
            const unsigned og = xb_add(&bar[XB_TOP], 1u);
            const unsigned tg = og / nx;
            if (og + 1u == (tg + 1u) * nx) xb_add(&bar[XB_TOPGEN], 1u);
            else XB_SPIN(xb_ld(&bar[XB_TOPGEN]) == tg, bar);
            __builtin_amdgcn_fence(__ATOMIC_ACQUIRE, "agent");
            xb_add(&bar[XB_XGEN(b.x)], 1u);
            asm volatile("s_waitcnt vmcnt(0)" ::: "memory");
        } else {
            XB_SPIN(xb_ld(&bar[XB_XGEN(b.x)]) == gen, bar);
            __builtin_amdgcn_fence(__ATOMIC_ACQUIRE, "agent");
            asm volatile("s_waitcnt vmcnt(0)" ::: "memory");
        }
    }
    __syncthreads();
}
constexpr int LDS_BYTES = 147456, LDSCTL_OFF = 131072, MISC_OFF = LDSCTL_OFF + 320;

__device__ __forceinline__ void gemv8_task(float* lds, const float* W, int ldw, int n0, const float* bias, float* out, int ldo, int tid) {
    const int wave = tid >> 6, lane = tid & 63;
    float acc[8];
#pragma unroll
    for (int b = 0; b < 8; ++b) acc[b] = 0.f;
    const float* wp = W + (size_t)(wave * 128) * ldw + n0 + lane;
    const float* As = lds + wave * 128;
    for (int k = 0; k < 128; k += 8) {
        float wv[8];
#pragma unroll
        for (int i = 0; i < 8; ++i) wv[i] = wp[(size_t)(k + i) * ldw];
#pragma unroll
        for (int i = 0; i < 8; ++i)
#pragma unroll
            for (int b = 0; b < 8; ++b) acc[b] = fmaf(As[b * 1024 + k + i], wv[i], acc[b]);
    }
    float* red = lds + 8192;
#pragma unroll
    for (int b = 0; b < 8; ++b) red[(wave * 8 + b) * 64 + lane] = acc[b];
    __syncthreads();
    { const int b = tid >> 6; float s = 0.f;
#pragma unroll
      for (int w = 0; w < 8; ++w) s += red[(w * 8 + b) * 64 + lane];
      out[b * ldo + n0 + lane] = s + (bias ? bias[n0 + lane] : 0.f); }
    __syncthreads();
}
__device__ __forceinline__ void transpose_item(const float* W, int K, int ldw, int nblk, bf16_t* WT, float* scr, int item, int lane) {
    const int kb = item / nblk, nb = item % nblk, k0 = 64 * kb, n0 = 32 * nb;
#pragma unroll 8
    for (int i = 0; i < 32; ++i) { const int kk = 2 * i + (lane >> 5); scr[kk * 33 + (lane & 31)] = W[(size_t)(k0 + kk) * ldw + n0 + (lane & 31)]; }
    WAVE_LDS_FENCE();
    const int c = lane & 7;
#pragma unroll
    for (int j = 0; j < 4; ++j) { const int n = (lane >> 3) + 8 * j; const float* s = scr + (8 * c) * 33 + n;
        uint4 o; o.x = pk2(s[0 * 33], s[1 * 33]); o.y = pk2(s[2 * 33], s[3 * 33]); o.z = pk2(s[4 * 33], s[5 * 33]); o.w = pk2(s[6 * 33], s[7 * 33]);
        *(uint4*)(WT + (size_t)(n0 + n) * K + k0 + 8 * c) = o; }
    WAVE_LDS_FENCE();
}
__device__ __forceinline__ void cvt512(const float* src, bf16_t* dst, int lane) {
    const float4 a = *(const float4*)(src + 8 * lane), b = *(const float4*)(src + 8 * lane + 4);
    uint4 o; o.x = pk2(a.x, a.y); o.y = pk2(a.z, a.w); o.z = pk2(b.x, b.y); o.w = pk2(b.z, b.w);
    *(uint4*)(dst + 8 * lane) = o;
}

#ifndef PROBE_REP
#define PROBE_REP -1
#endif
#define REP(k) for (int rep_ = 0; rep_ < ((PROBE_REP) == (k) ? 2 : 1); ++rep_)
__global__ void __launch_bounds__(NTHR, 2) fwd_kernel(Args a) {
    extern __shared__ __attribute__((aligned(16))) unsigned char lds_raw[];
    float* lds = (float*)lds_raw;
    const int tid = threadIdx.x, lane = tid & 63, wave = __builtin_amdgcn_readfirstlane(tid >> 6);
    const int gw = blockIdx.x * NWAVE + wave, ngw = gridDim.x * NWAVE;
    unsigned char* ws = a.ws;
    float* ADA = (float*)(ws + WS_ADA); float* SQB = (float*)(ws + WS_SQB); float* FL = (float*)(ws + WS_FL); float* GQ = (float*)(ws + WS_GQ); float* SSQ = (float*)(ws + WS_SSQ);
    bf16_t* WIN = (bf16_t*)(ws + WS_WIN); bf16_t* WOUT = (bf16_t*)(ws + WS_WOUT); bf16_t* WQ = (bf16_t*)(ws + WS_WQ); bf16_t* SUBK = (bf16_t*)(ws + WS_SUBK); bf16_t* SGWB = (bf16_t*)(ws + WS_SGW);
    bf16_t* GX = (bf16_t*)(ws + WS_GX); unsigned char* EU = ws + WS_EU; unsigned char* EV = ws + WS_EV; bf16_t* HB = (bf16_t*)(ws + WS_HB);
    bf16_t* ZU = (bf16_t*)(ws + WS_ZU); bf16_t* ZV = (bf16_t*)(ws + WS_ZV); bf16_t* Q = (bf16_t*)(ws + WS_Q); bf16_t* K = (bf16_t*)(ws + WS_K); bf16_t* V = (bf16_t*)(ws + WS_V);
    bf16_t* XG = (bf16_t*)(ws + WS_XG); bf16_t* QV = (bf16_t*)(ws + WS_QV); int* IDX = (int*)(ws + WS_IDX); float* GATE = (float*)(ws + WS_GATE);
    for (int u = tid; u < (LDS_BYTES - LDSCTL_OFF) / 4; u += NTHR) ((LAS unsigned*)((LAS unsigned char*)lds_raw + LDSCTL_OFF))[u] = 0u;
    __syncthreads();
    XcdBarrier bar = xcd_barrier_post((unsigned*)(ws + WS_CTL), (volatile LAS unsigned*)((LAS unsigned char*)lds_raw + MISC_OFF) + 8);
#define GRID_BAR() xcd_barrier(bar)

    REP(0) {
        if (blockIdx.x < 96) {
            for (int i = tid; i < NB * DM; i += NTHR) { const float cv = a.c[i]; lds[i] = cv / (1.f + expf(-cv)); }
            __syncthreads();
            gemv8_task(lds, a.w_ada, 6 * DM, blockIdx.x * 64, a.b_ada, ADA, 6 * DM, tid);
        }
        float* scr = lds + 12288 + wave * 2112;
        constexpr int I_IN = 16 * 80, I_OUT = 16 * 32, I_Q = 16 * 64;
        for (int it = gw; it < I_IN + I_OUT + I_Q; it += ngw) {
            int r = it;
            if (r < I_IN) { transpose_item(a.w_in, DM, INC, 80, WIN, scr, r, lane); continue; } r -= I_IN;
            if (r < I_OUT) { transpose_item(a.w_out, DM, DM, 32, WOUT, scr, r, lane); continue; } r -= I_OUT;
            transpose_item(a.w_query, DM, NQ, 64, WQ, scr, r, lane);
        }
        for (int it = gw; it < 512; it += ngw) cvt512(a.sub_keys + (size_t)it * 512, SUBK + (size_t)it * 512, lane);
        for (int it = gw; it < 256; it += ngw) {
            const int e0 = it * 512 + 8 * lane, t = (e0 >> 7) & 127, s0 = e0 & 127;
            const float4 p = *(const float4*)(a.sg_w + e0), q = *(const float4*)(a.sg_w + e0 + 4);
            const float v[8] = {p.x, p.y, p.z, p.w, q.x, q.y, q.z, q.w}; float m[8];
#pragma unroll
            for (int i = 0; i < 8; ++i) m[i] = (s0 + i <= t) ? v[i] : 0.f;
            uint4 o; o.x = pk2(m[0], m[1]); o.y = pk2(m[2], m[3]); o.z = pk2(m[4], m[5]); o.w = pk2(m[6], m[7]);
            *(uint4*)(SGWB + e0) = o;
        }
        for (int it = gw; it < 2 * 16384; it += ngw) {
            const bool isv = it >= 16384; const int r = isv ? it - 16384 : it; const float sc = isv ? peer::V_SCALE : peer::U_SCALE;
            const float* src = (isv ? a.expert_v : a.expert_u) + (size_t)r * DM + 16 * lane; unsigned char* dst = (isv ? EV : EU) + (size_t)r * DM + 16 * lane;
            uint4 o; unsigned* ow = (unsigned*)&o;
#pragma unroll
            for (int k = 0; k < 4; ++k) { const float4 f = *(const float4*)(src + 4 * k); int w = __builtin_amdgcn_cvt_pk_fp8_f32(f.x * sc, f.y * sc, 0, false); w = __builtin_amdgcn_cvt_pk_fp8_f32(f.z * sc, f.w * sc, w, true); ow[k] = (unsigned)w; }
            *(uint4*)dst = o;
        }
    }
    GRID_BAR();
    REP(1) {
        for (int i = tid; i < 8 * DM; i += NTHR) { const int k = i >> 3, j = i & 7; lds[j * DM + k] = a.w_in[(size_t)k * INC + NPROJ + j]; }
        __syncthreads();
        for (int t = gw; t < NT; t += ngw) {
            const int b = t / SEQ; const float* xr = a.x + (size_t)t * DM; const float* shift = ADA + b * 6 * DM; const float* scale = shift + DM;
            float4 v[4]; float s = 0.f;
#pragma unroll
            for (int j = 0; j < 4; ++j) { v[j] = *(const float4*)(xr + 256 * j + 4 * lane); s += v[j].x * v[j].x + v[j].y * v[j].y + v[j].z * v[j].z + v[j].w * v[j].w; }
            const float rstd = rsqrtf(wave_sum(s) * (1.f / DM) + EPS);
#pragma unroll
            for (int j = 0; j < 4; ++j) {
                const int c = 256 * j + 4 * lane;
                const float4 gg = *(const float4*)(a.norm1_g + c), sh = *(const float4*)(shift + c), sc = *(const float4*)(scale + c);
                v[j].x = v[j].x * rstd * gg.x * (1.f + sc.x) + sh.x; v[j].y = v[j].y * rstd * gg.y * (1.f + sc.y) + sh.y;
                v[j].z = v[j].z * rstd * gg.z * (1.f + sc.z) + sh.z; v[j].w = v[j].w * rstd * gg.w * (1.f + sc.w) + sh.w;
                uint2 o; o.x = pk2(v[j].x, v[j].y); o.y = pk2(v[j].z, v[j].w);
                *(uint2*)(HB + (size_t)t * DM + c) = o;
            }
            float fl = 0.f;
#pragma unroll
            for (int j8 = 0; j8 < 8; ++j8) { float d = 0.f;
#pragma unroll
                for (int j = 0; j < 4; ++j) { const float4 w = *(const float4*)(lds + j8 * DM + 256 * j + 4 * lane); d += v[j].x * w.x + v[j].y * w.y + v[j].z * w.z + v[j].w * w.w; }
                d = wave_sum(d); if (lane == j8) fl = d; }
            if (lane < 8) FL[(size_t)t * 8 + lane] = log_sigmoid(fl + a.b_f[lane]);
        }
        __syncthreads();
        if (blockIdx.x < 32) {
            for (int i = tid; i < NB * DM; i += NTHR) lds[i] = ADA[(i >> 10) * 6 * DM + 3 * DM + (i & 1023)];
            __syncthreads();
            gemv8_task(lds, a.w_query, NQ, blockIdx.x * 64, nullptr, SQB, NQ, tid);
        }
    }
    GRID_BAR();
    REP(2) {
        if (gw < NB * NH) {
            const int b = gw >> 3, h = gw & 7; float v[32]; float run = 0.f;
#pragma unroll
            for (int i = 0; i < 32; ++i) { run += FL[((size_t)b * SEQ + 32 * lane + i) * 8 + h]; v[i] = run; }
            float incl = run;
#pragma unroll
            for (int o = 1; o < 64; o <<= 1) { const float n = __shfl_up(incl, o); if (lane >= o) incl += n; }
            const float excl = incl - run;
#pragma unroll
            for (int i = 0; i < 32; ++i) {
                const size_t e = ((size_t)b * SEQ + 32 * lane + i) * 8 + h; const float g = (excl + v[i]) * LOG2E; GQ[e] = g;
                const float ng = -g; const unsigned g1 = f2bf(ng); const float r1 = ng - __uint_as_float(g1 << 16); const unsigned g2 = f2bf(r1); const float r2 = r1 - __uint_as_float(g2 << 16); const unsigned g3 = f2bf(r2);
                uint4 o; o.x = g1 | (g2 << 16); o.y = g3; o.z = 0u; o.w = 0u; *(uint4*)(GX + e * 8) = o;
            }
        }
        pg8::Gemm g{HB, WIN, NT, NPROJ, DM}; pg8::StaticOrder S; S.init(NT, NPROJ, gridDim.x, (int)blockIdx.x);
        pg8::EpiProj E{ZU};
        pg8::gemm_phase<pg8::EpiProj, pg8::StaticOrder, true, true>((PG8_LAS unsigned char*)lds_raw, g, S, E);
    }
    GRID_BAR();
    REP(3) {
        char* shm = (char*)lds_raw;
        for (int pt = blockIdx.x; pt < NB * (SEQ / CHUNK) * NH / 2; pt += gridDim.x)
            mixer::sgu_pair(2 * pt, ZU, ZV, SGWB, a.sg_ln_g, a.sg_ln_b, a.sg_b, a.out_g_sg, HB, shm);
        __syncthreads();
        const int G = gridDim.x, vcu = (G % 8 == 0) ? (blockIdx.x % 8) * (G / 8) + blockIdx.x / 8 : blockIdx.x;
        for (int pr = vcu; pr < NB * NH * 4; pr += G) {
            const int bh = pr >> 2, s = pr & 3;
            mixer::attn_unit(bh >> 3, bh & 7, 7 - s, Q, K, V, GQ, a.out_g_fox, HB, shm);
            mixer::attn_unit(bh >> 3, bh & 7, s, Q, K, V, GQ, a.out_g_fox, HB, shm);
        }
    }
    GRID_BAR();
    REP(4) {
        pg8::Gemm g{HB, WOUT, NT, DM, DM}; pg8::StaticOrder S; S.init(NT, DM, gridDim.x, (int)blockIdx.x);
        pg8::EpiOut E{a.x, ADA, a.norm2_g, a.out, XG, SSQ};
        pg8::gemm_phase<pg8::EpiOut, pg8::StaticOrder, false, true>((PG8_LAS unsigned char*)lds_raw, g, S, E);
    }
    GRID_BAR();
    REP(5) {
        pg8::Gemm g{XG, WQ, NT, NQ, DM}; pg8::StaticOrder S; S.init(NT, NQ, gridDim.x, (int)blockIdx.x);
        pg8::EpiQuery E{SSQ, SQB, QV};
        pg8::gemm_phase<pg8::EpiQuery, pg8::StaticOrder, true, true>((PG8_LAS unsigned char*)lds_raw, g, S, E);
    }
    GRID_BAR();
    REP(6) {
        char* shm = (char*)lds_raw;
        for (int task = blockIdx.x; task < NT / 32; task += gridDim.x) {
            const int t0 = task * 32;
            __syncthreads();
            peer::topk_head(t0, wave, QV, SUBK, shm);
            __syncthreads();
            for (int i = 0; i < 4; ++i) peer::gather_token(t0 + wave * 4 + i, wave * 4 + i, XG, SSQ, ADA, EU, EV, a.final_g, a.out, shm, (rep_ == ((PROBE_REP) == 6 ? 1 : 0)) || a.ph_hi == 12345);
        }
    }
}

extern "C" void kernel_launch(void* const* d_in, const int* in_sizes, int n_in, void* d_out, int out_size, void* d_ws, size_t ws_size, hipStream_t stream) {
    if (n_in != 20 || ws_size < WS_END) { fprintf(stderr, "kernel_launch: unexpected n_in %d or ws_size %zu\n", n_in, ws_size); return; }
    Args a{};
    const float** p = (const float**)&a;
    for (int i = 0; i < 20; ++i) p[i] = (const float*)d_in[i];
    a.out = (float*)d_out; a.ws = (unsigned char*)d_ws;
    static int grid = 0;
    if (grid == 0) {
        int dev = 0, cus = 0, per_cu = 0;
        (void)hipGetDevice(&dev); (void)hipDeviceGetAttribute(&cus, hipDeviceAttributeMultiprocessorCount, dev);
        (void)hipFuncSetAttribute((const void*)fwd_kernel, hipFuncAttributeMaxDynamicSharedMemorySize, LDS_BYTES);
        (void)hipOccupancyMaxActiveBlocksPerMultiprocessor(&per_cu, (const void*)fwd_kernel, NTHR, LDS_BYTES);
        (void)hipGetLastError();
        if (per_cu < 1 || cus != 256) { fprintf(stderr, "kernel_launch: occupancy query says %d blocks/CU, %d CUs (built for one block on each of 256 CUs)\n", per_cu, cus); grid = -1; }
        else grid = cus;
    }
    if (grid < 0) return;
    (void)hipMemsetAsync((char*)d_ws + WS_CTL, 0, CTL_ZERO_BYTES, stream);
    a.ph_lo = 0; a.ph_hi = 10;
    hipLaunchKernelGGL(fwd_kernel, dim3(grid), dim3(NTHR), LDS_BYTES, stream, a);
}
```

```cpp
#include <hip/hip_runtime.h>
#include <cstdint>
#include <cstdio>
#include <cmath>

constexpr int DM = 1024, NB = 8, SEQ = 2048, NT = NB * SEQ;
constexpr int HD = 64, SGW = 512, FOXW = 512, NH = 8, CHUNK = 128;
constexpr int INC = 2 * SGW + 3 * FOXW + NH;
constexpr int NPROJ = 2560;
constexpr int PH = 8, NKEYS = 128, NEXP = NKEYS * NKEYS, TOPK = 16, DKEY = 256, DHALF = 128, NQ = PH * DKEY;
constexpr float EPS = 1e-6f;
constexpr int NTHR = 512, NWAVE = 8;
constexpr float LOG2E = 1.4426950408889634f;
constexpr float C2 = 0.125f * LOG2E;

typedef unsigned short bf16_t;

constexpr size_t MiB = 1u << 20;
constexpr size_t WS_CTL = 0, CTL_ZERO_BYTES = 64 * 1024;
constexpr size_t WS_ADA = 256 * 1024;
constexpr size_t WS_SQB = 512 * 1024;
constexpr size_t WS_FL = 1 * MiB;
constexpr size_t WS_GQ = WS_FL + MiB / 2;
constexpr size_t WS_SSQ = 2 * MiB;
constexpr size_t WS_WIN = 3 * MiB;
constexpr size_t WS_WOUT = WS_WIN + 5 * MiB;
constexpr size_t WS_WQ = WS_WOUT + 2 * MiB;
constexpr size_t WS_SUBK = WS_WQ + 4 * MiB;
constexpr size_t WS_SGW = WS_SUBK + MiB;
constexpr size_t WS_GX = WS_SGW + MiB;
constexpr size_t WS_EU = 20 * MiB;
constexpr size_t WS_EV = WS_EU + 32 * MiB;
constexpr size_t WS_HB = WS_EV + 32 * MiB;
constexpr size_t WS_ZU = WS_HB + 32 * MiB;
constexpr size_t WS_ZV = WS_ZU + 16 * MiB, WS_Q = WS_ZV + 16 * MiB, WS_K = WS_Q + 16 * MiB, WS_V = WS_K + 16 * MiB;
constexpr size_t WS_XG = WS_K;
constexpr size_t WS_QV = WS_HB;
constexpr size_t WS_IDX = WS_V + 16 * MiB;
constexpr size_t WS_GATE = WS_IDX + 8 * MiB;
constexpr size_t WS_END = WS_GATE + 8 * MiB;

struct Args {
    const float *x, *c, *w_ada, *b_ada, *norm1_g, *w_in, *b_f, *sg_ln_g, *sg_ln_b, *sg_w, *sg_b, *out_g_sg, *out_g_fox,
        *w_out, *norm2_g, *w_query, *sub_keys, *expert_u, *expert_v, *final_g;
    float* out; unsigned char* ws; int ph_lo, ph_hi;
};

#define GAS __attribute__((address_space(1)))
#define LAS __attribute__((address_space(3)))
#define WAVE_LDS_FENCE() do { __builtin_amdgcn_fence(__ATOMIC_ACQ_REL, "wavefront"); __builtin_amdgcn_wave_barrier(); } while (0)
constexpr int WTAB_OFF = 131072 + 1024;
__device__ __forceinline__ int lane_id() { return (int)__builtin_amdgcn_mbcnt_hi(~0u, __builtin_amdgcn_mbcnt_lo(~0u, 0u)); }
__device__ __forceinline__ int hw_slot() { return (int)(__builtin_amdgcn_s_getreg((5 << 11) | 4) & 63u); }
__device__ __forceinline__ int wave_id() { return __builtin_amdgcn_readfirstlane(*(const LAS int*)(unsigned)(WTAB_OFF + 4 * hw_slot())); }
#define TIDX (wave_id() * 64 + lane_id())
__device__ __forceinline__ float wave_sum(float v) {
#pragma unroll
    for (int o = 1; o < 64; o <<= 1) v += __shfl_xor(v, o);
    return v;
}
__device__ __forceinline__ float wave_max(float v) {
#pragma unroll
    for (int o = 1; o < 64; o <<= 1) v = fmaxf(v, __shfl_xor(v, o));
    return v;
}
__device__ __forceinline__ float gelu_exact(float v) { return 0.5f * v * (1.0f + erff(v * 0.70710678118654752f)); }
__device__ __forceinline__ float log_sigmoid(float v) { return fminf(v, 0.f) - log1pf(expf(-fabsf(v))); }
__device__ __forceinline__ float bf2f(bf16_t v) { return __uint_as_float((unsigned)v << 16); }
__device__ __forceinline__ unsigned f2bf(float f) { unsigned u = __builtin_bit_cast(unsigned, f); return (u + 0x7fffu + ((u >> 16) & 1u)) >> 16; }
__device__ __forceinline__ unsigned pk2(float lo, float hi) { return f2bf(lo) | (f2bf(hi) << 16); }

namespace pg8 {
#define PG8_LAS __attribute__((address_space(3)))
typedef unsigned short bf16_t;
typedef short bf16x8 __attribute__((ext_vector_type(8)));
typedef float f32x4 __attribute__((ext_vector_type(4)));
typedef unsigned u32x4 __attribute__((ext_vector_type(4)));
constexpr int BM = 256, BK = 64, HALF = 128, HTB = HALF * BK * 2  , STAGE_BYTES = 8 * HTB, NXCD = 8, WGM = 8;

__host__ __device__ __forceinline__ int lds_byte(int r, int c) { const int st = (r >> 4) * 2 + (c >> 5), rr = r & 15, cc = c & 31, ob = rr * 64 + cc * 2; return st * 1024 + (ob ^ (((ob >> 9) & 1) << 5)); }
__host__ __device__ __forceinline__ void stage_rc(int b, int& R, int& C) { const int st = b / 1024, sb = b % 1024, swz = sb ^ (((sb >> 9) & 1) << 5); R = (st >> 1) * 16 + swz / 64; C = (st & 1) * 32 + (swz % 64) / 2; }
__host__ __device__ __forceinline__ int perm32(int rho) { const int n = rho >> 4, i = rho & 15; return 8 * (i >> 2) + 4 * n + (i & 3); }

struct Unit { int pm, pn; };
struct Gemm { const bf16_t* A; const bf16_t* Bt; int M, N, K; };

struct StaticOrder {
    int nM, nN, nwg, G, c;
    __host__ __device__ void init(int M, int N, int G_, int c_) { nM = M / BM; nN = N / BM; nwg = nM * nN; G = G_; c = c_; }
    __host__ __device__ bool next(int i, Unit& u) const {
        const long L = (long)i * G + c; if (L >= nwg) return false;
        int wgid = (int)L; { const int q = nwg / NXCD, r = nwg % NXCD, xcd = wgid % NXCD, off = wgid / NXCD; wgid = (xcd < r ? xcd * (q + 1) : r * (q + 1) + (xcd - r) * q) + off; }
        const int nig = WGM * nN, gid = wgid / nig, fm = gid * WGM, gsz = (nM - fm) < WGM ? (nM - fm) : WGM;
        u.pm = fm + ((wgid % nig) % gsz); u.pn = (wgid % nig) / gsz; return true;
    }
    __device__ __forceinline__ void a_ready(const Unit&) const {}
    __device__ __forceinline__ void done(const Unit&) const {}
};


__device__ __forceinline__ unsigned cvt_pk_bf16(float lo, float hi) { unsigned r; asm volatile("v_cvt_pk_bf16_f32 %0, %1, %2" : "=v"(r) : "v"(lo), "v"(hi)); return r; }
typedef float f32x2 __attribute__((ext_vector_type(2)));
__device__ __forceinline__ f32x2 gelu_pk(f32x2 v) {
    const f32x2 av = __builtin_elementwise_abs(v), d = av * 0.2316418882f + 1.0f;
    f32x2 t; t.x = __builtin_amdgcn_rcpf(d.x); t.y = __builtin_amdgcn_rcpf(d.y);
    f32x2 q = t * 0.5307027145f + (-0.7265760135f); q = q * t + 0.7107068705f; q = q * t + (-0.142248368f); q = q * t + 0.127414796f; q = q * t;
    const f32x2 s = (v * v) * (-0.72134752044f);
    f32x2 e; e.x = __builtin_amdgcn_exp2f(s.x); e.y = __builtin_amdgcn_exp2f(s.y);
    const f32x2 m = v * (q * e), r = v - m;
    f32x2 o; o.x = v.x < 0.f ? m.x : r.x; o.y = v.y < 0.f ? m.y : r.y; return o;
}


typedef unsigned u32x4 __attribute__((ext_vector_type(4)));
struct EpiProj {
    static constexpr bool PERM = true, AFTER_DRAIN = false;
    bf16_t* base;
    __device__ __forceinline__ void operator()(const f32x4 (&acc)[2][2][4][2], const Unit& u, int wr, int wc, int fr, int fq) const {
        const int t = u.pn >> 1;
        bf16_t* O = base + (size_t)t * NT * 512;
        const bool act = t < 2; const float sc = (t == 2) ? C2 : 1.f;
        const int row0 = u.pm * BM + wr * 64 + fr, col0 = (u.pn & 1) * 256 + wc * 32 + 8 * fq;
#pragma unroll
        for (int ai = 0; ai < 2; ++ai)
#pragma unroll
            for (int m = 0; m < 4; ++m) { bf16_t* rowp = O + (size_t)(row0 + ai * HALF + m * 16) * 512 + col0;
#pragma unroll
                for (int bj = 0; bj < 2; ++bj) { f32x4 v0 = acc[ai][bj][m][0], v1 = acc[ai][bj][m][1];
                    if (act) { f32x2 a = gelu_pk((f32x2){v0[0], v0[1]}), b = gelu_pk((f32x2){v0[2], v0[3]}), c = gelu_pk((f32x2){v1[0], v1[1]}), d = gelu_pk((f32x2){v1[2], v1[3]});
                        v0 = (f32x4){a.x, a.y, b.x, b.y}; v1 = (f32x4){c.x, c.y, d.x, d.y}; }
                    v0 = v0 * sc; v1 = v1 * sc; u32x4 w; w.x = cvt_pk_bf16(v0[0], v0[1]); w.y = cvt_pk_bf16(v0[2], v0[3]); w.z = cvt_pk_bf16(v1[0], v1[1]); w.w = cvt_pk_bf16(v1[2], v1[3]);
                    *(u32x4*)(rowp + bj * HALF) = w; } }
    }
};
struct EpiOut {
    static constexpr bool PERM = true, AFTER_DRAIN = true;
    const float* x; const float* ada; const float* norm2_g; float* x1out; bf16_t* xg; float* ssq4;
    __device__ __forceinline__ void fused(f32x4 (&acc)[2][2][4][2], const Unit& u, int wr, int wc, int fr, int fq, PG8_LAS unsigned char* lds, int wid, int lane) const {
        const int b = (u.pm * BM) / SEQ;
        const float* gate1 = ada + b * 6 * DM + 2 * DM; const float* scale2 = ada + b * 6 * DM + 4 * DM;
        const int col0 = u.pn * BM + wc * 32 + 8 * fq;
        PG8_LAS float* P = (PG8_LAS float*)lds;
        f32x4 gt[2][2], g2[2][2];
#pragma unroll
        for (int bj = 0; bj < 2; ++bj)
#pragma unroll
            for (int n = 0; n < 2; ++n) { const int c = col0 + bj * HALF + 4 * n; gt[bj][n] = *(const f32x4*)(gate1 + c); g2[bj][n] = *(const f32x4*)(norm2_g + c) * (*(const f32x4*)(scale2 + c) + 1.0f); }
#pragma unroll
        for (int ai = 0; ai < 2; ++ai)
#pragma unroll
            for (int m = 0; m < 4; ++m) { const int rl = ai * HALF + wr * 64 + m * 16 + fr; const size_t off = (size_t)(u.pm * BM + rl) * DM + col0; float ss = 0.f;
#pragma unroll
                for (int bj = 0; bj < 2; ++bj) {
                    const f32x4 x0 = *(const f32x4*)(x + off + bj * HALF), x1 = *(const f32x4*)(x + off + bj * HALF + 4);
                    const f32x4 v0 = x0 + gt[bj][0] * acc[ai][bj][m][0], v1 = x1 + gt[bj][1] * acc[ai][bj][m][1];
                    *(f32x4*)(x1out + off + bj * HALF) = v0; *(f32x4*)(x1out + off + bj * HALF + 4) = v1;
                    ss += (v0[0] * v0[0] + v0[1] * v0[1]) + (v0[2] * v0[2] + v0[3] * v0[3]) + (v1[0] * v1[0] + v1[1] * v1[1]) + (v1[2] * v1[2] + v1[3] * v1[3]);
                    const f32x4 w0 = v0 * g2[bj][0], w1 = v1 * g2[bj][1];
                    u32x4 w; w.x = cvt_pk_bf16(w0[0], w0[1]); w.y = cvt_pk_bf16(w0[2], w0[3]); w.z = cvt_pk_bf16(w1[0], w1[1]); w.w = cvt_pk_bf16(w1[2], w1[3]);
                    *(u32x4*)(xg + off + bj * HALF) = w; }
                ss += __shfl_xor(ss, 16); ss += __shfl_xor(ss, 32);
                if (fq == 0) P[rl * 4 + wc] = ss; }
        asm volatile("s_waitcnt lgkmcnt(0)" ::: "memory"); __builtin_amdgcn_s_barrier(); asm volatile("" ::: "memory");
        const int tid = wid * 64 + lane;
        if (tid < 256) ssq4[(size_t)(u.pm * BM + tid) * 4 + u.pn] = (P[tid * 4 + 0] + P[tid * 4 + 1]) + (P[tid * 4 + 2] + P[tid * 4 + 3]);
        asm volatile("s_waitcnt lgkmcnt(0)" ::: "memory"); __builtin_amdgcn_s_barrier(); asm volatile("" ::: "memory");
    }
};
struct EpiQuery {
    static constexpr bool PERM = true, AFTER_DRAIN = false;
    const float* ssq4; const float* sqb; bf16_t* qv;
    __device__ __forceinline__ void operator()(const f32x4 (&acc)[2][2][4][2], const Unit& u, int wr, int wc, int fr, int fq) const {
        const int b = (u.pm * BM) / SEQ;
        const int row0 = u.pm * BM + wr * 64 + fr, col0 = u.pn * BM + wc * 32 + 8 * fq;
        f32x4 bv[2][2];
#pragma unroll
        for (int bj = 0; bj < 2; ++bj)
#pragma unroll
            for (int n = 0; n < 2; ++n) bv[bj][n] = *(const f32x4*)(sqb + b * NQ + col0 + bj * HALF + 4 * n);
#pragma unroll
        for (int ai = 0; ai < 2; ++ai)
#pragma unroll
            for (int m = 0; m < 4; ++m) { const int row = row0 + ai * HALF + m * 16; const f32x4 s4 = *(const f32x4*)(ssq4 + (size_t)row * 4);
                const float rstd = rsqrtf(((s4[0] + s4[1]) + (s4[2] + s4[3])) * (1.f / DM) + EPS);
                bf16_t* rowp = qv + (size_t)row * NQ + col0;
#pragma unroll
                for (int bj = 0; bj < 2; ++bj) { const f32x4 v0 = acc[ai][bj][m][0] * rstd + bv[bj][0], v1 = acc[ai][bj][m][1] * rstd + bv[bj][1];
                    u32x4 w; w.x = cvt_pk_bf16(v0[0], v0[1]); w.y = cvt_pk_bf16(v0[2], v0[3]); w.z = cvt_pk_bf16(v1[0], v1[1]); w.w = cvt_pk_bf16(v1[2], v1[3]);
                    *(u32x4*)(rowp + bj * HALF) = w; } }
    }
};

template <class Epi, class Sched, bool ALIGN_EPI = false, bool SP2 = false>
__device__ __forceinline__ void gemm_phase(PG8_LAS unsigned char* lds, const Gemm g, const Sched& S, const Epi& E) {
    const int tid = TIDX, wid = __builtin_amdgcn_readfirstlane(tid >> 6), lane = tid & 63, wr = wid >> 2, wc = wid & 3, fr = lane & 15, fq = lane >> 4;
    const int K = g.K, nt = K / BK;
    unsigned voffA[2], voffB[2];
#pragma unroll
    for (int i = 0; i < 2; ++i) { int R, C; stage_rc(tid * 16 + i * 8192, R, C); const int Rb = Epi::PERM ? ((R & ~31) + perm32(R & 31)) : R;
        voffA[i] = (unsigned)(R * K + C) * 2u; voffB[i] = (unsigned)(Rb * K + C) * 2u; }
    const size_t kstep = (size_t)(BK * 2);
    const size_t hstep = (size_t)HALF * K * 2;
    const size_t tstep = 2 * hstep;
    const unsigned ldsw = (unsigned)wid * 1024u;
    const int aoff = lds_byte(wr * 64 + fr, fq * 8), boff = lds_byte(wc * 32 + fr, fq * 8);
#define PG8_SA(b, h) (((b) * 2 + (h)) * HTB)
#define PG8_SB(b, h) ((4 + (b) * 2 + (h)) * HTB)
#define PG8_STAGE(bufoff, gbase, voff) do { _Pragma("unroll") for (int _i = 0; _i < 2; ++_i) \
        __builtin_amdgcn_global_load_lds((const unsigned*)((const char*)(gbase) + (voff)[_i]), (PG8_LAS unsigned*)(lds + (bufoff) + ldsw + _i * 8192), 16, 0, 0); } while (0)
#define PG8_LDA(dst, b, h) do { _Pragma("unroll") for (int m = 0; m < 4; ++m) _Pragma("unroll") for (int k = 0; k < 2; ++k) dst[m][k] = *(const PG8_LAS bf16x8*)(lds + PG8_SA(b, h) + aoff + m * 2048 + k * 1024); } while (0)
#define PG8_LDB(dst, b, h) do { _Pragma("unroll") for (int n = 0; n < 2; ++n) _Pragma("unroll") for (int k = 0; k < 2; ++k) dst[n][k] = *(const PG8_LAS bf16x8*)(lds + PG8_SB(b, h) + boff + n * 2048 + k * 1024); } while (0)
#define PG8_MMA(ai, bj, At, Bt) do { __builtin_amdgcn_s_setprio(1); _Pragma("unroll") for (int m = 0; m < 4; ++m) _Pragma("unroll") for (int n = 0; n < 2; ++n) _Pragma("unroll") for (int k = 0; k < 2; ++k) \
        acc[ai][bj][m][n] = __builtin_amdgcn_mfma_f32_16x16x32_bf16(Bt[n][k], At[m][k], acc[ai][bj][m][n], 0, 0, 0); __builtin_amdgcn_s_setprio(0); } while (0)
#define PG8_WAIT_V(n) asm volatile("s_waitcnt vmcnt(" #n ")" ::: "memory")
#define PG8_WAIT_L(n) asm volatile("s_waitcnt lgkmcnt(" #n ")" ::: "memory")
#define PG8_BAR __builtin_amdgcn_s_barrier()
#define PG8_SCHED __builtin_amdgcn_sched_barrier(0)
    Unit cur, nxt; int ui = 0;
    if (!S.next(0, cur)) return;
    f32x4 acc[2][2][4][2];
#pragma unroll
    for (int a = 0; a < 2; ++a)
#pragma unroll
        for (int b = 0; b < 2; ++b)
#pragma unroll
            for (int m = 0; m < 4; ++m)
#pragma unroll
                for (int n = 0; n < 2; ++n) acc[a][b][m][n] = (f32x4){0.f, 0.f, 0.f, 0.f};
    bf16x8 At[4][2], B0[2][2], B1[2][2];
    const char* cA = (const char*)g.A + (size_t)cur.pm * tstep; const char* cB = (const char*)g.Bt + (size_t)cur.pn * tstep;
    S.a_ready(cur);
    if constexpr (SP2) {
        PG8_STAGE(PG8_SB(0, 0), cB, voffB); PG8_STAGE(PG8_SB(0, 1), cB + hstep, voffB); PG8_STAGE(PG8_SA(0, 0), cA, voffA); PG8_STAGE(PG8_SA(0, 1), cA + hstep, voffA);
        if (wr == 1) PG8_BAR;
        PG8_WAIT_V(2); PG8_BAR;
        PG8_STAGE(PG8_SB(1, 0), cB + kstep, voffB); PG8_STAGE(PG8_SA(1, 0), cA + kstep, voffA); PG8_STAGE(PG8_SB(1, 1), cB + hstep + kstep, voffB);
        PG8_WAIT_V(6); PG8_BAR;
    } else {
        PG8_STAGE(PG8_SB(0, 0), cB, voffB); PG8_STAGE(PG8_SA(0, 0), cA, voffA); PG8_STAGE(PG8_SB(0, 1), cB + hstep, voffB); PG8_STAGE(PG8_SA(0, 1), cA + hstep, voffA);
        if (wr == 1) PG8_BAR;
        PG8_WAIT_V(4); PG8_BAR;
        PG8_STAGE(PG8_SB(1, 0), cB + kstep, voffB); PG8_STAGE(PG8_SA(1, 0), cA + kstep, voffA); PG8_STAGE(PG8_SB(1, 1), cB + hstep + kstep, voffB);
        PG8_WAIT_V(6); PG8_BAR;
    }
    for (;;) {
        const bool has_next = S.next(ui + 1, nxt);
        const char* nA = has_next ? (const char*)g.A + (size_t)nxt.pm * tstep : cA; const char* nB = has_next ? (const char*)g.Bt + (size_t)nxt.pn * tstep : cB;
        for (int t = 0; t < nt; t += 2) {
            const bool last = (t == nt - 2);
            const char* a1 = cA + (size_t)(t + 1) * kstep;
            const char* a2 = last ? nA : cA + (size_t)(t + 2) * kstep; const char* b2 = last ? nB : cB + (size_t)(t + 2) * kstep;
            const char* a3 = a2 + kstep; const char* b3 = b2 + kstep;
            if (last && has_next) S.a_ready(nxt);
            if constexpr (SP2) {
            PG8_LDB(B0, 0, 0); PG8_LDB(B1, 0, 1); PG8_SCHED; PG8_LDA(At, 0, 0); PG8_STAGE(PG8_SA(1, 1), a1 + hstep, voffA);
            PG8_WAIT_V(8); PG8_WAIT_L(0); PG8_BAR; PG8_MMA(0, 0, At, B0); PG8_MMA(0, 1, At, B1); PG8_BAR; PG8_SCHED;
            PG8_LDA(At, 0, 1); PG8_STAGE(PG8_SB(0, 0), b2, voffB); PG8_STAGE(PG8_SB(0, 1), b2 + hstep, voffB); PG8_STAGE(PG8_SA(0, 0), a2, voffA);
            PG8_WAIT_V(8); PG8_WAIT_L(0); PG8_BAR; PG8_MMA(1, 0, At, B0); PG8_MMA(1, 1, At, B1); PG8_BAR; PG8_SCHED;
            PG8_LDB(B0, 1, 0); PG8_LDB(B1, 1, 1); PG8_SCHED; PG8_LDA(At, 1, 0); PG8_STAGE(PG8_SA(0, 1), a2 + hstep, voffA);
            PG8_WAIT_V(8); PG8_WAIT_L(0); PG8_BAR; PG8_MMA(0, 0, At, B0); PG8_MMA(0, 1, At, B1); PG8_BAR; PG8_SCHED;
            PG8_LDA(At, 1, 1); PG8_STAGE(PG8_SB(1, 0), b3, voffB); PG8_STAGE(PG8_SB(1, 1), b3 + hstep, voffB); PG8_STAGE(PG8_SA(1, 0), a3, voffA);
            PG8_WAIT_V(8); PG8_WAIT_L(0); PG8_BAR; PG8_MMA(1, 0, At, B0); PG8_MMA(1, 1, At, B1); PG8_BAR; PG8_SCHED;
            } else {
            PG8_LDB(B0, 0, 0); PG8_SCHED; PG8_LDA(At, 0, 0); PG8_STAGE(PG8_SA(1, 1), a1 + hstep, voffA);
            PG8_WAIT_L(8); PG8_BAR; PG8_WAIT_L(0); PG8_MMA(0, 0, At, B0); PG8_BAR; PG8_SCHED;
            PG8_LDB(B1, 0, 1); PG8_STAGE(PG8_SB(0, 0), b2, voffB);
            PG8_BAR; PG8_WAIT_L(0); PG8_MMA(0, 1, At, B1); PG8_BAR;
            PG8_LDA(At, 0, 1); PG8_STAGE(PG8_SA(0, 0), a2, voffA);
            PG8_BAR; PG8_WAIT_L(0); PG8_MMA(1, 0, At, B0); PG8_BAR; PG8_SCHED;
            PG8_STAGE(PG8_SB(0, 1), b2 + hstep, voffB);
            PG8_WAIT_V(6); PG8_BAR; PG8_MMA(1, 1, At, B1); PG8_BAR;
            PG8_LDB(B0, 1, 0); PG8_SCHED; PG8_LDA(At, 1, 0); PG8_STAGE(PG8_SA(0, 1), a2 + hstep, voffA);
            PG8_WAIT_L(8); PG8_BAR; PG8_WAIT_L(0); PG8_MMA(0, 0, At, B0); PG8_BAR; PG8_SCHED;
            PG8_LDB(B1, 1, 1); PG8_STAGE(PG8_SB(1, 0), b3, voffB);
            PG8_BAR; PG8_WAIT_L(0); PG8_MMA(0, 1, At, B1); PG8_BAR;
            PG8_LDA(At, 1, 1); PG8_STAGE(PG8_SA(1, 0), a3, voffA);
            PG8_BAR; PG8_WAIT_L(0); PG8_MMA(1, 0, At, B0); PG8_BAR; PG8_SCHED;
            PG8_STAGE(PG8_SB(1, 1), b3 + hstep, voffB);
            PG8_WAIT_V(6); PG8_BAR; PG8_MMA(1, 1, At, B1); PG8_BAR;
            }
        }
        if constexpr (ALIGN_EPI) { if (wr == 0) PG8_BAR; }
        if constexpr (!Epi::AFTER_DRAIN) { E(acc, cur, wr, wc, fr, fq); S.done(cur); }
        if (!has_next) break;
#pragma unroll
        for (int a = 0; a < 2; ++a)
#pragma unroll
            for (int b = 0; b < 2; ++b)
#pragma unroll
                for (int m = 0; m < 4; ++m)
#pragma unroll
                    for (int n = 0; n < 2; ++n) acc[a][b][m][n] = (f32x4){0.f, 0.f, 0.f, 0.f};
        cur = nxt; cA = nA; cB = nB; ++ui;
        if constexpr (ALIGN_EPI) { if (wr == 1) PG8_BAR; }
    }
    PG8_WAIT_V(0);
    if constexpr (!ALIGN_EPI) { if (wr == 0) PG8_BAR; }
    PG8_BAR;
    if constexpr (Epi::AFTER_DRAIN) { E.fused(acc, cur, wr, wc, fr, fq, lds, wid, lane); S.done(cur); }
#undef PG8_SA
#undef PG8_SB
#undef PG8_STAGE
#undef PG8_LDA
#undef PG8_LDB
#undef PG8_MMA
#undef PG8_WAIT_V
#undef PG8_WAIT_L
#undef PG8_BAR
#undef PG8_SCHED
}
}

namespace mixer {
typedef short bf16x8 __attribute__((ext_vector_type(8)));
typedef short s16x4 __attribute__((ext_vector_type(4)));
typedef float f32x16 __attribute__((ext_vector_type(16)));
typedef unsigned u32x4 __attribute__((ext_vector_type(4)));
typedef float f32x2_t __attribute__((ext_vector_type(2))); typedef __bf16 bf16x2_t __attribute__((ext_vector_type(2)));
__device__ __forceinline__ int crow(int r, int hi) { return (r & 3) + 8 * (r >> 2) + 4 * hi; }
__device__ __forceinline__ unsigned cvtpk(float lo, float hi) { f32x2_t v = {lo, hi}; bf16x2_t b = __builtin_convertvector(v, bf16x2_t); return __builtin_bit_cast(unsigned, b); }
#define MX_SBAR() __builtin_amdgcn_sched_barrier(0)

constexpr int A_K = 0, A_V = 8192, A_G = 16384, A_WS = 16640, A_OST = 18688, A_BYTES = A_OST + 8 * 8192;
__device__ __forceinline__ void pv(f32x16* o, int vb, bf16x8 pa0, bf16x8 pa1, bf16x8 pa2, bf16x8 pa3) {
#pragma unroll
    for (int d0 = 0; d0 < 2; ++d0) { s16x4 lo[4], hi[4];
#pragma unroll
        for (int ks = 0; ks < 4; ++ks) {
            asm volatile("ds_read_b64_tr_b16 %0,%1 offset:%c2" : "=&v"(lo[ks]) : "v"(vb), "i"(d0 * 4096 + ks * 1024) : "memory");
            asm volatile("ds_read_b64_tr_b16 %0,%1 offset:%c2" : "=&v"(hi[ks]) : "v"(vb), "i"(d0 * 4096 + ks * 1024 + 512) : "memory"); }
        asm volatile("s_waitcnt lgkmcnt(0)" ::: "memory"); MX_SBAR();
#define MX_PK(k) (bf16x8){lo[k][0], lo[k][1], lo[k][2], lo[k][3], hi[k][0], hi[k][1], hi[k][2], hi[k][3]}
        o[d0] = __builtin_amdgcn_mfma_f32_32x32x16_bf16(pa0, MX_PK(0), o[d0], 0, 0, 0);
        o[d0] = __builtin_amdgcn_mfma_f32_32x32x16_bf16(pa1, MX_PK(1), o[d0], 0, 0, 0);
        o[d0] = __builtin_amdgcn_mfma_f32_32x32x16_bf16(pa2, MX_PK(2), o[d0], 0, 0, 0);
        o[d0] = __builtin_amdgcn_mfma_f32_32x32x16_bf16(pa3, MX_PK(3), o[d0], 0, 0, 0);
#undef MX_PK
    }
}
__device__ __forceinline__ void attn_unit(int b, int h, int qb, const bf16_t* Q, const bf16_t* K, const bf16_t* V, const float* GQ, const float* out_g, bf16_t* Y, char* shm) {
    const int tid = TIDX, lane = tid & 63, r32 = lane & 31, hi = lane >> 5; const int wid = __builtin_amdgcn_readfirstlane(tid >> 6);
    const size_t rowbase = (size_t)b * SEQ; const int q0 = qb * 256;
    const bf16_t* Qw = Q + (rowbase + q0 + wid * 32) * 512 + h * 64;
    const bf16_t* Kh = K + rowbase * 512 + h * 64; const bf16_t* Vh = V + rowbase * 512 + h * 64;
    const unsigned lds0 = (unsigned)(uintptr_t)shm;
    float* wsf = (float*)(shm + A_WS) + wid * 64;
    const float* gbl = (const float*)(shm + A_G);
    const bf16_t* ksrc = Kh + (size_t)lane * 512 + wid * 8;
    const bf16_t* vsrc = Vh + (size_t)(16 * (wid & 3) + (lane >> 2)) * 512 + (wid >> 2) * 32 + (lane & 3) * 8;
    uint4* kdst = (uint4*)(shm + A_K + wid * 1024 + lane * 16); uint4* vdst = (uint4*)(shm + A_V + wid * 1024 + lane * 16);
    const int vb0 = (int)(lds0 + A_V) + ((lane >> 4) & 1) * 32 + (lane & 3) * 8 + (4 * hi + ((lane & 15) >> 2)) * 64;
    const char* kb = shm + A_K + hi * 1024 + r32 * 16;
    const int NTL = (q0 + 256) / 64;
    bf16x8 qr[4];
#pragma unroll
    for (int d0 = 0; d0 < 4; ++d0) qr[d0] = *reinterpret_cast<const bf16x8*>(&Qw[(size_t)r32 * 512 + d0 * 16 + hi * 8]);
    const int qrow = q0 + wid * 32 + r32;
    const float Gq = GQ[(rowbase + qrow) * 8 + h];
    float m_run = -INFINITY, l_run = 0.f; f32x16 o[2]; o[0] = f32x16{}; o[1] = f32x16{};
    uint4 kreg = *(const uint4*)ksrc, vreg = *(const uint4*)vsrc; float greg = (tid < 64) ? GQ[(rowbase + tid) * 8 + h] : 0.f;
    for (int t = 0; t < NTL; ++t) {
        __syncthreads();
        *kdst = kreg; *vdst = vreg; if (tid < 64) ((float*)(shm + A_G))[tid] = greg;
        __syncthreads();
        if (t + 1 < NTL) { kreg = *(const uint4*)(ksrc + (size_t)(t + 1) * 64 * 512); vreg = *(const uint4*)(vsrc + (size_t)(t + 1) * 64 * 512); if (tid < 64) greg = GQ[(rowbase + (t + 1) * 64 + tid) * 8 + h]; }
        f32x16 p0 = f32x16{}, p1 = f32x16{};
#pragma unroll
        for (int d0 = 0; d0 < 4; ++d0) {
            const bf16x8 b0 = *reinterpret_cast<const bf16x8*>(kb + d0 * 2048), b1 = *reinterpret_cast<const bf16x8*>(kb + d0 * 2048 + 512);
            p0 = __builtin_amdgcn_mfma_f32_32x32x16_bf16(b0, qr[d0], p0, 0, 0, 0); p1 = __builtin_amdgcn_mfma_f32_32x32x16_bf16(b1, qr[d0], p1, 0, 0, 0); }
        const int kbase = t * 64 + 4 * hi;
#pragma unroll
        for (int g = 0; g < 4; ++g) {
            const float4 ga = *(const float4*)(gbl + 8 * g + 4 * hi), gc = *(const float4*)(gbl + 32 + 8 * g + 4 * hi);
            p0[4 * g + 0] += Gq - ga.x; p0[4 * g + 1] += Gq - ga.y; p0[4 * g + 2] += Gq - ga.z; p0[4 * g + 3] += Gq - ga.w;
            p1[4 * g + 0] += Gq - gc.x; p1[4 * g + 1] += Gq - gc.y; p1[4 * g + 2] += Gq - gc.z; p1[4 * g + 3] += Gq - gc.w; }
        if (t >= NTL - 4) {
#pragma unroll
            for (int r = 0; r < 16; ++r) { const int kv = kbase + (r & 3) + 8 * (r >> 2); if (kv > qrow) p0[r] = -INFINITY; if (kv + 32 > qrow) p1[r] = -INFINITY; } }
        float rm = fmaxf(p0[0], p1[0]);
#pragma unroll
        for (int r = 1; r < 16; ++r) rm = fmaxf(rm, fmaxf(p0[r], p1[r]));
        rm = fmaxf(rm, __shfl_xor(rm, 32));
        const float m_new = fmaxf(m_run, rm), alpha = __builtin_amdgcn_exp2f(m_run - m_new); m_run = m_new;
        float ps = 0.f;
#pragma unroll
        for (int r = 0; r < 16; ++r) { p0[r] = __builtin_amdgcn_exp2f(p0[r] - m_new); p1[r] = __builtin_amdgcn_exp2f(p1[r] - m_new); ps += p0[r] + p1[r]; }
        l_run = l_run * alpha + ps;
        if (hi == 0) wsf[r32] = alpha;
        WAVE_LDS_FENCE();
#pragma unroll
        for (int g = 0; g < 4; ++g) { const float4 al = *(const float4*)(wsf + 8 * g + 4 * hi);
#pragma unroll
            for (int d = 0; d < 2; ++d) { o[d][4 * g + 0] *= al.x; o[d][4 * g + 1] *= al.y; o[d][4 * g + 2] *= al.z; o[d][4 * g + 3] *= al.w; } }
        WAVE_LDS_FENCE();
        u32x4 pw0, pw1, pw2, pw3;
        pw0 = (u32x4){cvtpk(p0[0], p0[1]), cvtpk(p0[2], p0[3]), cvtpk(p0[4], p0[5]), cvtpk(p0[6], p0[7])};
        pw1 = (u32x4){cvtpk(p0[8], p0[9]), cvtpk(p0[10], p0[11]), cvtpk(p0[12], p0[13]), cvtpk(p0[14], p0[15])};
        pw2 = (u32x4){cvtpk(p1[0], p1[1]), cvtpk(p1[2], p1[3]), cvtpk(p1[4], p1[5]), cvtpk(p1[6], p1[7])};
        pw3 = (u32x4){cvtpk(p1[8], p1[9]), cvtpk(p1[10], p1[11]), cvtpk(p1[12], p1[13]), cvtpk(p1[14], p1[15])};
        MX_SBAR();
        pv(o, vb0, __builtin_bit_cast(bf16x8, pw0), __builtin_bit_cast(bf16x8, pw1), __builtin_bit_cast(bf16x8, pw2), __builtin_bit_cast(bf16x8, pw3));
    }
    l_run += __shfl_xor(l_run, 32);
    if (hi == 0) wsf[r32] = 1.0f / l_run;
    WAVE_LDS_FENCE();
    float* stg = (float*)(shm + A_OST) + wid * 2048;
#pragma unroll
    for (int r = 0; r < 16; ++r) { const int orow = crow(r, hi); const float rl = wsf[orow];
#pragma unroll
        for (int d0 = 0; d0 < 2; ++d0) stg[orow * 64 + d0 * 32 + r32] = o[d0][r] * rl; }
    WAVE_LDS_FENCE();
    bf16_t* Yw = Y + (rowbase + q0 + wid * 32) * DM + 512 + h * 64;
#pragma unroll
    for (int i = 0; i < 4; ++i) { const int row = i * 8 + (lane >> 3), ch = lane & 7;
        const float4 a = *(const float4*)(stg + row * 64 + ch * 8), c = *(const float4*)(stg + row * 64 + ch * 8 + 4);
        float ss = (a.x * a.x + a.y * a.y) + (a.z * a.z + a.w * a.w) + (c.x * c.x + c.y * c.y) + (c.z * c.z + c.w * c.w);
        ss += __shfl_xor(ss, 1); ss += __shfl_xor(ss, 2); ss += __shfl_xor(ss, 4);
        const float rs = rsqrtf(ss * (1.f / 64) + EPS);
        const float4 g0 = *(const float4*)(out_g + h * 64 + ch * 8), g1 = *(const float4*)(out_g + h * 64 + ch * 8 + 4);
        u32x4 w; w.x = cvtpk(a.x * rs * g0.x, a.y * rs * g0.y); w.y = cvtpk(a.z * rs * g0.z, a.w * rs * g0.w); w.z = cvtpk(c.x * rs * g1.x, c.y * rs * g1.y); w.w = cvtpk(c.z * rs * g1.z, c.w * rs * g1.w);
        *(u32x4*)(Yw + (size_t)row * DM + ch * 8) = w; }
    WAVE_LDS_FENCE();
}

constexpr int SG_PITCH = 136, SG_SLOT = 64 * SG_PITCH * 2;
__device__ __forceinline__ void sgu_pair(int task0, const bf16_t* ZU, const bf16_t* ZV, const bf16_t* SGWB, const float* ln_g, const float* ln_b, const float* sg_b, const float* out_g, bf16_t* Y, char* shm) {
    const int tid = TIDX, lane = tid & 63, r32 = lane & 31, hi = lane >> 5; const int wid = __builtin_amdgcn_readfirstlane(tid >> 6);
    const int slot = wid >> 2, j = wid & 3, task = task0 + slot;
    const int h = task % NH, bc = task / NH, t0 = bc * CHUNK;
    bf16_t* vnT = (bf16_t*)(shm + slot * SG_SLOT);
    __syncthreads();
    {
        const int tl = tid & 255, s = tl >> 1, half = tl & 1;
        const bf16_t* zr = ZV + (size_t)(t0 + s) * 512 + h * 64 + half * 32;
        uint4 raw[4]; float v[32]; float sum = 0.f;
#pragma unroll
        for (int i = 0; i < 4; ++i) raw[i] = *(const uint4*)(zr + 8 * i);
#pragma unroll
        for (int i = 0; i < 4; ++i) { const unsigned w[4] = {raw[i].x, raw[i].y, raw[i].z, raw[i].w};
#pragma unroll
            for (int k = 0; k < 4; ++k) { v[8 * i + 2 * k] = __uint_as_float(w[k] << 16); v[8 * i + 2 * k + 1] = __uint_as_float(w[k] & 0xffff0000u); } }
#pragma unroll
        for (int i = 0; i < 32; ++i) sum += v[i];
        sum += __shfl_xor(sum, 1);
        const float mu = sum * (1.f / 64); float var = 0.f;
#pragma unroll
        for (int i = 0; i < 32; ++i) { v[i] -= mu; var += v[i] * v[i]; }
        var += __shfl_xor(var, 1);
        const float rs = rsqrtf(var * (1.f / 64) + EPS);
#pragma unroll
        for (int i = 0; i < 32; ++i) { const int d = half * 32 + i; vnT[d * SG_PITCH + s] = (bf16_t)f2bf(v[i] * rs * ln_g[h * 64 + d] + ln_b[h * 64 + d]); }
    }
    __syncthreads();
    f32x16 acc[2]; acc[0] = f32x16{}; acc[1] = f32x16{};
    const bf16_t* wrow = SGWB + ((size_t)h * 128 + 32 * j + r32) * 128 + 8 * hi;
    const int nks = 2 * (j + 1);
    for (int ks = 0; ks < nks; ++ks) {
        const bf16x8 bw = *reinterpret_cast<const bf16x8*>(wrow + 16 * ks);
        const bf16x8 a0 = *reinterpret_cast<const bf16x8*>(vnT + (size_t)r32 * SG_PITCH + 16 * ks + 8 * hi);
        const bf16x8 a1 = *reinterpret_cast<const bf16x8*>(vnT + (size_t)(32 + r32) * SG_PITCH + 16 * ks + 8 * hi);
        acc[0] = __builtin_amdgcn_mfma_f32_32x32x16_bf16(a0, bw, acc[0], 0, 0, 0);
        acc[1] = __builtin_amdgcn_mfma_f32_32x32x16_bf16(a1, bw, acc[1], 0, 0, 0);
    }
    const int tl = 32 * j + r32; const size_t row = (size_t)t0 + tl;
    const float bs = sg_b[h * 128 + tl];
    float ss = 0.f;
#pragma unroll
    for (int mb = 0; mb < 2; ++mb)
#pragma unroll
        for (int g = 0; g < 4; ++g) { const int d = 32 * mb + 8 * g + 4 * hi;
            const uint2 z = *(const uint2*)(ZU + row * 512 + h * 64 + d);
            const float z0 = __uint_as_float(z.x << 16), z1 = __uint_as_float(z.x & 0xffff0000u), z2 = __uint_as_float(z.y << 16), z3 = __uint_as_float(z.y & 0xffff0000u);
            acc[mb][4 * g + 0] = z0 * (acc[mb][4 * g + 0] + bs); acc[mb][4 * g + 1] = z1 * (acc[mb][4 * g + 1] + bs);
            acc[mb][4 * g + 2] = z2 * (acc[mb][4 * g + 2] + bs); acc[mb][4 * g + 3] = z3 * (acc[mb][4 * g + 3] + bs);
            ss += (acc[mb][4 * g + 0] * acc[mb][4 * g + 0] + acc[mb][4 * g + 1] * acc[mb][4 * g + 1]) + (acc[mb][4 * g + 2] * acc[mb][4 * g + 2] + acc[mb][4 * g + 3] * acc[mb][4 * g + 3]); }
    ss += __shfl_xor(ss, 32);
    const float rs = rsqrtf(ss * (1.f / 64) + EPS);
#pragma unroll
    for (int mb = 0; mb < 2; ++mb)
#pragma unroll
        for (int g = 0; g < 4; ++g) { const int d = 32 * mb + 8 * g + 4 * hi;
            const float4 og = *(const float4*)(out_g + h * 64 + d);
            uint2 w; w.x = cvtpk(acc[mb][4 * g + 0] * rs * og.x, acc[mb][4 * g + 1] * rs * og.y); w.y = cvtpk(acc[mb][4 * g + 2] * rs * og.z, acc[mb][4 * g + 3] * rs * og.w);
            *(uint2*)(Y + row * DM + h * 64 + d) = w; }
}
#undef MX_SBAR
}

namespace peer {
typedef short bf16x8 __attribute__((ext_vector_type(8)));
typedef float f32x16 __attribute__((ext_vector_type(16)));
__device__ __forceinline__ unsigned umax(unsigned a, unsigned b) { return a > b ? a : b; }
__device__ __forceinline__ unsigned umin(unsigned a, unsigned b) { return a < b ? a : b; }
__device__ __forceinline__ unsigned f2ord(float f) { const unsigned u = __float_as_uint(f); return u ^ ((u >> 31) ? 0xffffffffu : 0x80000000u); }
__device__ __forceinline__ float ord2f(unsigned k) { const unsigned u = k ^ ((k >> 31) ? 0x80000000u : 0xffffffffu); return __uint_as_float(u); }
__device__ __forceinline__ void sort16(unsigned* a) {
#pragma unroll
    for (int k = 2; k <= 16; k <<= 1)
#pragma unroll
        for (int j = k >> 1; j > 0; j >>= 1)
#pragma unroll
            for (int i = 0; i < 16; ++i) { const int l = i ^ j; if (l > i) { const unsigned hi_ = umax(a[i], a[l]), lo_ = umin(a[i], a[l]); if ((i & k) == 0) { a[i] = hi_; a[l] = lo_; } else { a[i] = lo_; a[l] = hi_; } } }
}
__device__ __forceinline__ void merge16(unsigned* a) {
#pragma unroll
    for (int j = 8; j > 0; j >>= 1)
#pragma unroll
        for (int i = 0; i < 16; ++i) { const int l = i ^ j; if (l > i) { const unsigned hi_ = umax(a[i], a[l]), lo_ = umin(a[i], a[l]); a[i] = hi_; a[l] = lo_; } }
}
__device__ __forceinline__ void top16_of_two(unsigned* a, const unsigned* b) {
#pragma unroll
    for (int i = 0; i < 16; ++i) a[i] = umax(a[i], b[15 - i]);
    merge16(a);
}
__device__ __forceinline__ void top16_of_64(unsigned* k) {
    sort16(k); sort16(k + 16); sort16(k + 32); sort16(k + 48);
    top16_of_two(k, k + 16); top16_of_two(k + 32, k + 48); top16_of_two(k, k + 32);
}

constexpr int P_IDX = 0, P_GATE = 32768, P_SI = 65536, P_BYTES = P_SI + 8 * 8192;
__device__ __forceinline__ void topk_head(int t0, int tl0, int h, const bf16_t* QV, const bf16_t* SUBK, char* shm) {
    const int lane = TIDX & 63, r32 = lane & 31, hi = lane >> 5; const int wid = __builtin_amdgcn_readfirstlane(TIDX >> 6);
    unsigned* lsk = (unsigned*)(shm + P_SI) + wid * 2048;
#pragma unroll 1
    for (int p = 0; p < 2; ++p) {
        f32x16 acc[4]; acc[0] = f32x16{}; acc[1] = f32x16{}; acc[2] = f32x16{}; acc[3] = f32x16{};
        const bf16_t* qp = QV + (size_t)(t0 + r32) * NQ + h * 256 + p * 128 + 8 * hi;
        const bf16_t* kp = SUBK + (((size_t)h * 2 + p) * NKEYS + r32) * DHALF + 8 * hi;
#pragma unroll 2
        for (int ks = 0; ks < 8; ++ks) {
            const bf16x8 bq = *reinterpret_cast<const bf16x8*>(qp + 16 * ks);
#pragma unroll
            for (int nb = 0; nb < 4; ++nb) { const bf16x8 ak = *reinterpret_cast<const bf16x8*>(kp + (size_t)nb * 32 * DHALF + 16 * ks);
                acc[nb] = __builtin_amdgcn_mfma_f32_32x32x16_bf16(ak, bq, acc[nb], 0, 0, 0); }
        }
        unsigned key[64];
#pragma unroll
        for (int nb = 0; nb < 4; ++nb)
#pragma unroll
            for (int r = 0; r < 16; ++r) { const int n = 32 * nb + (r & 3) + 8 * (r >> 2) + 4 * hi; key[16 * nb + r] = (f2ord(acc[nb][r]) & ~127u) | (unsigned)(127 - n); }
        top16_of_64(key);
        unsigned part[16];
#pragma unroll
        for (int i = 0; i < 16; ++i) part[i] = (unsigned)__shfl_xor((int)key[i], 32);
        top16_of_two(key, part);
#pragma unroll
        for (int i = 0; i < 16; ++i) lsk[(p * 16 + i) * 64 + lane] = key[i];
    }
    WAVE_LDS_FENCE();
    unsigned ck[64];
    {
        float s0[16], s1[16];
#pragma unroll
        for (int i = 0; i < 16; ++i) { s0[i] = ord2f(lsk[i * 64 + lane] & ~127u); s1[i] = ord2f(lsk[(16 + i) * 64 + lane] & ~127u); }
        int n = 0;
#pragma unroll
        for (int a = 0; a < 16; ++a)
#pragma unroll
            for (int b = 0; b < 16; ++b) if ((a + 1) * (b + 1) <= 16) { ck[n] = (f2ord(s0[a] + s1[b]) & ~255u) | (unsigned)(255 - (a * 16 + b)); ++n; }
#pragma unroll
        for (int i = 50; i < 64; ++i) ck[i] = 0u;
    }
    top16_of_64(ck);
    float sc[16]; float sum = 0.f;
#pragma unroll
    for (int i = 0; i < 16; ++i) { sc[i] = ord2f(ck[i] & ~255u); }
    const float mx = sc[0];
#pragma unroll
    for (int i = 0; i < 16; ++i) { sc[i] = __expf(sc[i] - mx); sum += sc[i]; }
    const float inv = 1.0f / sum;
    int* lidx = (int*)(shm + P_IDX) + (tl0 + r32) * 128 + h * 16; float* lgate = (float*)(shm + P_GATE) + (tl0 + r32) * 128 + h * 16;
#pragma unroll
    for (int i = 0; i < 16; ++i) if ((i >> 3) == hi) {
        const int pos = 255 - (int)(ck[i] & 255u), ia = 127 - (int)(lsk[(pos >> 4) * 64 + lane] & 127u), ib = 127 - (int)(lsk[(16 + (pos & 15)) * 64 + lane] & 127u);
        lidx[i] = ia * NKEYS + ib; lgate[i] = sc[i] * inv; }
    WAVE_LDS_FENCE();
}

__device__ __forceinline__ float gelu_as(float v) {
    const float av = fabsf(v), t = __builtin_amdgcn_rcpf(av * 0.2316418882f + 1.0f);
    float q = t * 0.5307027145f + (-0.7265760135f); q = q * t + 0.7107068705f; q = q * t + (-0.142248368f); q = q * t + 0.127414796f; q = q * t;
    const float e = __builtin_amdgcn_exp2f((v * v) * (-0.72134752044f));
    const float m = v * (q * e);
    return v < 0.f ? m : v - m;
}
typedef float f32x2 __attribute__((ext_vector_type(2)));
constexpr float U_SCALE = 256.f, V_SCALE = 16.f;
__device__ __forceinline__ float dot16_fp8(const uint4 u, const float* hv) {
    const int w[4] = {(int)u.x, (int)u.y, (int)u.z, (int)u.w}; float d0 = 0.f, d1 = 0.f;
#pragma unroll
    for (int k = 0; k < 4; ++k) { const f32x2 a = __builtin_amdgcn_cvt_pk_f32_fp8(w[k], false), b = __builtin_amdgcn_cvt_pk_f32_fp8(w[k], true);
        d0 = fmaf(a.x, hv[4 * k], d0); d1 = fmaf(a.y, hv[4 * k + 1], d1); d0 = fmaf(b.x, hv[4 * k + 2], d0); d1 = fmaf(b.y, hv[4 * k + 3], d1); }
    return d0 + d1;
}
__device__ __forceinline__ void gather_token(int t, int tl, const bf16_t* XG, const float* SSQ, const float* ADA, const unsigned char* EU, const unsigned char* EV, const float* final_g, float* out, const char* shm, bool do_store) {
    const int lane = TIDX & 63; const int b = t / SEQ;
    const int* lidx = (const int*)(shm + P_IDX) + tl * 128; const float* lgate = (const float*)(shm + P_GATE) + tl * 128;
    const float4 s4 = *(const float4*)(SSQ + (size_t)t * 4);
    const float rstd2 = rsqrtf(((s4.x + s4.y) + (s4.z + s4.w)) * (1.f / DM) + EPS);
    float hv[16], acc[16];
    {
        const int c = 16 * lane; const uint4 xa = *(const uint4*)(XG + (size_t)t * DM + c), xb = *(const uint4*)(XG + (size_t)t * DM + c + 8);
        const unsigned w[8] = {xa.x, xa.y, xa.z, xa.w, xb.x, xb.y, xb.z, xb.w};
#pragma unroll
        for (int k = 0; k < 4; ++k) { const float4 sh = *(const float4*)(ADA + b * 6 * DM + 3 * DM + c + 4 * k);
            hv[4 * k + 0] = __uint_as_float(w[2 * k] << 16) * rstd2 + sh.x; hv[4 * k + 1] = __uint_as_float(w[2 * k] & 0xffff0000u) * rstd2 + sh.y;
            hv[4 * k + 2] = __uint_as_float(w[2 * k + 1] << 16) * rstd2 + sh.z; hv[4 * k + 3] = __uint_as_float(w[2 * k + 1] & 0xffff0000u) * rstd2 + sh.w; }
    }
#pragma unroll
    for (int i = 0; i < 16; ++i) acc[i] = 0.f;
    const bool b5 = (lane & 32) != 0, b4 = (lane & 16) != 0, b3 = (lane & 8) != 0;
    for (int e0 = 0; e0 < 128; e0 += 8) {
        uint4 u[8], v[8];
#pragma unroll
        for (int q = 0; q < 8; ++q) { const size_t ro = (size_t)lidx[e0 + q] * DM + 16 * lane; u[q] = *(const uint4*)(EU + ro); v[q] = *(const uint4*)(EV + ro); }
        const float myg = lgate[e0 + (lane >> 3)];
        float s[8];
#pragma unroll
        for (int q = 0; q < 8; ++q) s[q] = dot16_fp8(u[q], hv);
        float r4[4], r2[2];
#pragma unroll
        for (int k = 0; k < 4; ++k) { const float mine = b5 ? s[k + 4] : s[k], oth = b5 ? s[k] : s[k + 4]; r4[k] = mine + __shfl_xor(oth, 32); }
#pragma unroll
        for (int k = 0; k < 2; ++k) { const float mine = b4 ? r4[k + 2] : r4[k], oth = b4 ? r4[k] : r4[k + 2]; r2[k] = mine + __shfl_xor(oth, 16); }
        float z; { const float mine = b3 ? r2[1] : r2[0], oth = b3 ? r2[0] : r2[1]; z = mine + __shfl_xor(oth, 8); }
        z += __shfl_xor(z, 4); z += __shfl_xor(z, 2); z += __shfl_xor(z, 1);
        const float wl = myg * gelu_as(z * (1.0f / U_SCALE)) * (1.0f / V_SCALE);
#pragma unroll
        for (int q = 0; q < 8; ++q) { const float wgt = __uint_as_float((unsigned)__builtin_amdgcn_readlane((int)__float_as_uint(wl), 8 * q));
            const int w[4] = {(int)v[q].x, (int)v[q].y, (int)v[q].z, (int)v[q].w};
#pragma unroll
            for (int k = 0; k < 4; ++k) { const f32x2 x = __builtin_amdgcn_cvt_pk_f32_fp8(w[k], false), y = __builtin_amdgcn_cvt_pk_f32_fp8(w[k], true);
                acc[4 * k] = fmaf(wgt, x.x, acc[4 * k]); acc[4 * k + 1] = fmaf(wgt, x.y, acc[4 * k + 1]); acc[4 * k + 2] = fmaf(wgt, y.x, acc[4 * k + 2]); acc[4 * k + 3] = fmaf(wgt, y.y, acc[4 * k + 3]); } }
    }
    float ss = 0.f; float x2[16];
#pragma unroll
    for (int k = 0; k < 4; ++k) {
        const int c = 16 * lane + 4 * k;
        const float4 x1 = *(const float4*)(out + (size_t)t * DM + c), g2 = *(const float4*)(ADA + b * 6 * DM + 5 * DM + c);
        x2[4 * k] = x1.x + g2.x * acc[4 * k]; x2[4 * k + 1] = x1.y + g2.y * acc[4 * k + 1]; x2[4 * k + 2] = x1.z + g2.z * acc[4 * k + 2]; x2[4 * k + 3] = x1.w + g2.w * acc[4 * k + 3];
        ss += (x2[4 * k] * x2[4 * k] + x2[4 * k + 1] * x2[4 * k + 1]) + (x2[4 * k + 2] * x2[4 * k + 2] + x2[4 * k + 3] * x2[4 * k + 3]);
    }
    const float rstd = rsqrtf(wave_sum(ss) * (1.f / DM) + EPS);
    if (do_store) {
#pragma unroll
        for (int k = 0; k < 4; ++k) {
            const int c = 16 * lane + 4 * k; const float4 fg = *(const float4*)(final_g + c); float4 o;
            o.x = x2[4 * k] * rstd * fg.x; o.y = x2[4 * k + 1] * rstd * fg.y; o.z = x2[4 * k + 2] * rstd * fg.z; o.w = x2[4 * k + 3] * rstd * fg.w;
            *(float4*)(out + (size_t)t * DM + c) = o;
        }
    }
}

constexpr size_t SLICE_BYTES = (size_t)NEXP * 128;
__device__ __forceinline__ uint4 ld16_sc1(const void* p) { uint4 r; asm volatile("global_load_dwordx4 %0, %1, off sc1\n\ts_waitcnt vmcnt(0)" : "=&v"(r) : "v"(p) : "memory"); return r; }
__device__ __forceinline__ void gather_ts(int t0w, int tlw, const bf16_t* XG, const float* SSQ, const float* ADA, const unsigned char* EU, const unsigned char* EV, const float* final_g, float* out, char* shm, bool do_store) {
    int lane = lane_id(); int wid = wave_id();
    asm volatile("" : "+v"(lane), "+s"(wid), "+s"(t0w), "+s"(tlw));
    const int g = lane >> 3, c = lane & 7; const int b = t0w / SEQ;
    const bool c4 = (c & 4) != 0, c2 = (c & 2) != 0, c1 = (c & 1) != 0, g4 = (g & 4) != 0, g2 = (g & 2) != 0, g1 = (g & 1) != 0;
    const int* lidx = (const int*)(shm + P_IDX) + tlw * 128 + g; const float* lgate = (const float*)(shm + P_GATE) + tlw * 128;
    float* A2 = (float*)(shm + P_SI) + wid * 2048;
    float* SS = A2 + 1024;
#pragma unroll 1
    for (int s = 0; s < 8; ++s) {
        const unsigned char* Us = EU + (size_t)s * SLICE_BYTES + 16 * c;
#pragma unroll 1
        for (int i = 0; i < 8; ++i) {
            const int t = t0w + i;
            uint4 u[16];
#pragma unroll
            for (int j = 0; j < 16; ++j) u[j] = *(const uint4*)(Us + (size_t)lidx[i * 128 + 8 * j] * 128);
            float hv[16];
            { const float4 s4 = *(const float4*)(SSQ + (size_t)t * 4); const float rstd2 = rsqrtf(((s4.x + s4.y) + (s4.z + s4.w)) * (1.f / DM) + EPS);
              const int col = 128 * s + 16 * c; const uint4 xa = *(const uint4*)(XG + (size_t)t * DM + col), xb = *(const uint4*)(XG + (size_t)t * DM + col + 8);
              const unsigned w[8] = {xa.x, xa.y, xa.z, xa.w, xb.x, xb.y, xb.z, xb.w};
#pragma unroll
              for (int k = 0; k < 4; ++k) { const float4 sh = *(const float4*)(ADA + b * 6 * DM + 3 * DM + col + 4 * k);
                  hv[4 * k + 0] = __uint_as_float(w[2 * k] << 16) * rstd2 + sh.x; hv[4 * k + 1] = __uint_as_float(w[2 * k] & 0xffff0000u) * rstd2 + sh.y;
                  hv[4 * k + 2] = __uint_as_float(w[2 * k + 1] << 16) * rstd2 + sh.z; hv[4 * k + 3] = __uint_as_float(w[2 * k + 1] & 0xffff0000u) * rstd2 + sh.w; } }
#pragma unroll
            for (int k = 0; k < 2; ++k) {
                float sv[8];
#pragma unroll
                for (int j = 0; j < 8; ++j) sv[j] = dot16_fp8(u[8 * k + j], hv);
                float r4[4], r2[2];
#pragma unroll
                for (int q = 0; q < 4; ++q) { const float mine = c4 ? sv[q + 4] : sv[q], oth = c4 ? sv[q] : sv[q + 4]; r4[q] = mine + __shfl_xor(oth, 4); }
#pragma unroll
                for (int q = 0; q < 2; ++q) { const float mine = c2 ? r4[q + 2] : r4[q], oth = c2 ? r4[q] : r4[q + 2]; r2[q] = mine + __shfl_xor(oth, 2); }
                const float mine = c1 ? r2[1] : r2[0], oth = c1 ? r2[0] : r2[1];
                const float z = mine + __shfl_xor(oth, 1);
                float* ap = A2 + (i * 2 + k) * 64 + lane;
                *ap = (s == 0) ? z : *ap + z;
            }
        }
    }
#pragma unroll 1
    for (int i = 0; i < 8; ++i)
#pragma unroll
        for (int k = 0; k < 2; ++k) { float* ap = A2 + (i * 2 + k) * 64 + lane; *ap = lgate[i * 128 + 64 * k + 8 * c + g] * gelu_as(*ap * (1.0f / U_SCALE)) * (1.0f / V_SCALE); }
    WAVE_LDS_FENCE();
#pragma unroll 1
    for (int s = 0; s < 8; ++s) {
        const unsigned char* Vs = EV + (size_t)s * SLICE_BYTES + 16 * c;
#pragma unroll 1
        for (int i = 0; i < 8; ++i) {
            const int t = t0w + i;
            uint4 v[16];
#pragma unroll
            for (int j = 0; j < 16; ++j) v[j] = *(const uint4*)(Vs + (size_t)lidx[i * 128 + 8 * j] * 128);
            float acc[16];
#pragma unroll
            for (int q = 0; q < 16; ++q) acc[q] = 0.f;
#pragma unroll
            for (int j = 0; j < 16; ++j) {
                const float wgt = A2[(i * 2 + (j >> 3)) * 64 + (lane & 56) + (j & 7)];
                const int w[4] = {(int)v[j].x, (int)v[j].y, (int)v[j].z, (int)v[j].w};
#pragma unroll
                for (int k = 0; k < 4; ++k) { const f32x2 x = __builtin_amdgcn_cvt_pk_f32_fp8(w[k], false), y = __builtin_amdgcn_cvt_pk_f32_fp8(w[k], true);
                    acc[4 * k] = fmaf(wgt, x.x, acc[4 * k]); acc[4 * k + 1] = fmaf(wgt, x.y, acc[4 * k + 1]); acc[4 * k + 2] = fmaf(wgt, y.x, acc[4 * k + 2]); acc[4 * k + 3] = fmaf(wgt, y.y, acc[4 * k + 3]); }
            }
            float r8[8], r4[4], r2[2];
#pragma unroll
            for (int q = 0; q < 8; ++q) { const float mine = g4 ? acc[q + 8] : acc[q], oth = g4 ? acc[q] : acc[q + 8]; r8[q] = mine + __shfl_xor(oth, 32); }
#pragma unroll
            for (int q = 0; q < 4; ++q) { const float mine = g2 ? r8[q + 4] : r8[q], oth = g2 ? r8[q] : r8[q + 4]; r4[q] = mine + __shfl_xor(oth, 16); }
#pragma unroll
            for (int q = 0; q < 2; ++q) { const float mine = g1 ? r4[q + 2] : r4[q], oth = g1 ? r4[q] : r4[q + 2]; r2[q] = mine + __shfl_xor(oth, 8); }
            const int col = 128 * s + 16 * c + 8 * (g4 ? 1 : 0) + 4 * (g2 ? 1 : 0) + 2 * (g1 ? 1 : 0);
            const float2 x1 = *(const float2*)(out + (size_t)t * DM + col), gt = *(const float2*)(ADA + b * 6 * DM + 5 * DM + col);
            float2 x2; x2.x = x1.x + gt.x * r2[0]; x2.y = x1.y + gt.y * r2[1];
            const float sq = x2.x * x2.x + x2.y * x2.y;
            SS[i * 64 + lane] = (s == 0) ? sq : SS[i * 64 + lane] + sq;
            *(float2*)(out + (size_t)t * DM + col) = x2;
        }
    }
    asm volatile("s_waitcnt vmcnt(0)" ::: "memory");
#pragma unroll 1
    for (int i = 0; i < 8; ++i) {
        const int t = t0w + i;
        const float rstd = rsqrtf(wave_sum(SS[i * 64 + lane]) * (1.f / DM) + EPS);
#pragma unroll
        for (int k = 0; k < 4; ++k) {
            const int col = 256 * k + 4 * lane; float* p = out + (size_t)t * DM + col;
            const uint4 raw = ld16_sc1(p); const float4 fg = *(const float4*)(final_g + col); float4 o;
            o.x = __uint_as_float(raw.x) * rstd * fg.x; o.y = __uint_as_float(raw.y) * rstd * fg.y; o.z = __uint_as_float(raw.z) * rstd * fg.z; o.w = __uint_as_float(raw.w) * rstd * fg.w;
            if (do_store) *(float4*)p = o;
        }
    }
    WAVE_LDS_FENCE();
}
}

using pg8::bf16x8; using pg8::f32x4;
#define XB_TMO      128
#define XB_XCNT(j)  (256  + 64 * (j))
#define XB_XSUB(j)  (1280 + 64 * (j))
#define XB_XGEN(j)  (2304 + 64 * (j))
#define XB_TOP      3328
#define XB_TOPGEN   3392
#define XCD_BAR_WORDS 3456
#define XB_SPIN_CAP (1u << 18)
__device__ __forceinline__ unsigned xb_ld(unsigned* p)              { return __hip_atomic_load(p, __ATOMIC_RELAXED, __HIP_MEMORY_SCOPE_AGENT); }
__device__ __forceinline__ unsigned xb_add(unsigned* p, unsigned v) { return __hip_atomic_fetch_add(p, v, __ATOMIC_RELAXED, __HIP_MEMORY_SCOPE_AGENT); }
__device__ __forceinline__ unsigned xb_xcc_id() { return (unsigned)__builtin_amdgcn_s_getreg((3 << 11) | 20) & 0xFu; }
#define XB_SPIN(cond, bar) do { unsigned _sp = 0; while (cond) { __builtin_amdgcn_s_sleep(1); \
    if ((++_sp & 255u) == 0u) { if (xb_ld(&(bar)[XB_TMO])) break; if (_sp > XB_SPIN_CAP) { atomicAdd(&(bar)[XB_TMO], 1u); break; } } } } while (0)
struct XcdBarrier { unsigned* bar; unsigned x; volatile LAS unsigned* st; };
__device__ __forceinline__ XcdBarrier xcd_barrier_post(unsigned* bar, volatile LAS unsigned* st) {
    XcdBarrier b; b.bar = bar; b.x = xb_xcc_id(); b.st = st;
    if (TIDX == 0) (void)xb_add(&bar[XB_XCNT(b.x)], 1u);
    return b;
}
__device__ __forceinline__ void xcd_barrier_complete(unsigned* bar, unsigned x, unsigned& nloc, unsigned& nx) {
    const unsigned G = gridDim.x * gridDim.y * gridDim.z;
    unsigned sum, cnt, mine, sp = 0u;
    for (;;) {
        sum = 0u; cnt = 0u; mine = 0u;
#pragma unroll
        for (unsigned j = 0; j < 16; ++j) { const unsigned c = xb_ld(&bar[XB_XCNT(j)]); sum += c; cnt += (c > 0u) ? 1u : 0u; mine = (j == x) ? c : mine; }
        if (sum == G) break;
        __builtin_amdgcn_s_sleep(1);
        if ((++sp & 255u) == 0u) { if (xb_ld(&bar[XB_TMO])) break; if (sp > XB_SPIN_CAP) { atomicAdd(&bar[XB_TMO], 1u); break; } }
    }
    nloc = mine > 0u ? mine : 1u; nx = cnt > 0u ? cnt : 1u;
}
__device__ __forceinline__ void xcd_barrier(const XcdBarrier& b) {
    asm volatile("s_waitcnt vmcnt(0)" ::: "memory");
    __syncthreads();
    if (TIDX == 0) {
        unsigned* bar = b.bar;
        __builtin_amdgcn_s_waitcnt(0);
        unsigned nloc = b.st[0], nx = b.st[1];
        if (nloc == 0u) { xcd_barrier_complete(bar, b.x, nloc, nx); b.st[0] = nloc; b.st[1] = nx; }
        const unsigned old = xb_add(&bar[XB_XSUB(b.x)], 1u);
        const unsigned gen = old / nloc;
        if (old + 1u == (gen + 1u) * nloc) {
            __builtin_amdgcn_fence(__ATOMIC_RELEASE, "agent");
            asm volatile("s_waitcnt vmcnt(0)" ::: "memory");
            const unsigned og = xb_add(&bar[XB_TOP], 1u);
            const unsigned tg = og / nx;
            if (og + 1u == (tg + 1u) * nx) xb_add(&bar[XB_TOPGEN], 1u);
            else XB_SPIN(xb_ld(&bar[XB_TOPGEN]) == tg, bar);
            __builtin_amdgcn_fence(__ATOMIC_ACQUIRE, "agent");
            xb_add(&bar[XB_XGEN(b.x)], 1u);
            asm volatile("s_waitcnt vmcnt(0)" ::: "memory");
        } else {
            XB_SPIN(xb_ld(&bar[XB_XGEN(b.x)]) == gen, bar);
            __builtin_amdgcn_fence(__ATOMIC_ACQUIRE, "agent");
            asm volatile("s_waitcnt vmcnt(0)" ::: "memory");
        }
    }
    __syncthreads();
}
constexpr int LDS_BYTES = 147456, LDSCTL_OFF = 131072, MISC_OFF = LDSCTL_OFF + 320;

__device__ __forceinline__ void gemv8_task(float* lds, const float* W, int ldw, int n0, const float* bias, float* out, int ldo, int tid) {
    const int wave = tid >> 6, lane = tid & 63;
    float acc[8];
#pragma unroll
    for (int b = 0; b < 8; ++b) acc[b] = 0.f;
    const float* wp = W + (size_t)(wave * 128) * ldw + n0 + lane;
    const float* As = lds + wave * 128;
    for (int k = 0; k < 128; k += 8) {
        float wv[8];
#pragma unroll
        for (int i = 0; i < 8; ++i) wv[i] = wp[(size_t)(k + i) * ldw];
#pragma unroll
        for (int i = 0; i < 8; ++i)
#pragma unroll
            for (int b = 0; b < 8; ++b) acc[b] = fmaf(As[b * 1024 + k + i], wv[i], acc[b]);
    }
    float* red = lds + 8192;
#pragma unroll
    for (int b = 0; b < 8; ++b) red[(wave * 8 + b) * 64 + lane] = acc[b];
    __syncthreads();
    { const int b = tid >> 6; float s = 0.f;
#pragma unroll
      for (int w = 0; w < 8; ++w) s += red[(w * 8 + b) * 64 + lane];
      out[b * ldo + n0 + lane] = s + (bias ? bias[n0 + lane] : 0.f); }
    __syncthreads();
}
__device__ __forceinline__ void transpose_item(const float* W, int K, int ldw, int nblk, bf16_t* WT, float* scr, int item, int lane) {
    const int kb = item / nblk, nb = item % nblk, k0 = 64 * kb, n0 = 32 * nb;
#pragma unroll 8
    for (int i = 0; i < 32; ++i) { const int kk = 2 * i + (lane >> 5); scr[kk * 33 + (lane & 31)] = W[(size_t)(k0 + kk) * ldw + n0 + (lane & 31)]; }
    WAVE_LDS_FENCE();
    const int c = lane & 7;
#pragma unroll
    for (int j = 0; j < 4; ++j) { const int n = (lane >> 3) + 8 * j; const float* s = scr + (8 * c) * 33 + n;
        uint4 o; o.x = pk2(s[0 * 33], s[1 * 33]); o.y = pk2(s[2 * 33], s[3 * 33]); o.z = pk2(s[4 * 33], s[5 * 33]); o.w = pk2(s[6 * 33], s[7 * 33]);
        *(uint4*)(WT + (size_t)(n0 + n) * K + k0 + 8 * c) = o; }
    WAVE_LDS_FENCE();
}
__device__ __forceinline__ void cvt512(const float* src, bf16_t* dst, int lane) {
    const float4 a = *(const float4*)(src + 8 * lane), b = *(const float4*)(src + 8 * lane + 4);
    uint4 o; o.x = pk2(a.x, a.y); o.y = pk2(a.z, a.w); o.z = pk2(b.x, b.y); o.w = pk2(b.z, b.w);
    *(uint4*)(dst + 8 * lane) = o;
}

#ifndef PROBE_REP
#define PROBE_REP -1
#endif
#define REP(k) for (int rep_ = 0; rep_ < ((PROBE_REP) == (k) ? 2 : 1); ++rep_)
__global__ void __launch_bounds__(NTHR, 2) fwd_kernel(Args a) {
    extern __shared__ __attribute__((aligned(16))) unsigned char lds_raw[];
    float* lds = (float*)lds_raw;
    unsigned char* ws = a.ws;
    float* ADA = (float*)(ws + WS_ADA); float* SQB = (float*)(ws + WS_SQB); float* FL = (float*)(ws + WS_FL); float* GQ = (float*)(ws + WS_GQ); float* SSQ = (float*)(ws + WS_SSQ);
    bf16_t* WIN = (bf16_t*)(ws + WS_WIN); bf16_t* WOUT = (bf16_t*)(ws + WS_WOUT); bf16_t* WQ = (bf16_t*)(ws + WS_WQ); bf16_t* SUBK = (bf16_t*)(ws + WS_SUBK); bf16_t* SGWB = (bf16_t*)(ws + WS_SGW);
    bf16_t* GX = (bf16_t*)(ws + WS_GX); unsigned char* EU = ws + WS_EU; unsigned char* EV = ws + WS_EV; bf16_t* HB = (bf16_t*)(ws + WS_HB);
    bf16_t* ZU = (bf16_t*)(ws + WS_ZU); bf16_t* ZV = (bf16_t*)(ws + WS_ZV); bf16_t* Q = (bf16_t*)(ws + WS_Q); bf16_t* K = (bf16_t*)(ws + WS_K); bf16_t* V = (bf16_t*)(ws + WS_V);
    bf16_t* XG = (bf16_t*)(ws + WS_XG); bf16_t* QV = (bf16_t*)(ws + WS_QV); int* IDX = (int*)(ws + WS_IDX); float* GATE = (float*)(ws + WS_GATE);
    for (int u = threadIdx.x; u < (LDS_BYTES - LDSCTL_OFF) / 4; u += NTHR) ((LAS unsigned*)((LAS unsigned char*)lds_raw + LDSCTL_OFF))[u] = 0u;
    __syncthreads();
    if ((threadIdx.x & 63) == 0) *(LAS int*)(unsigned)(WTAB_OFF + 4 * hw_slot()) = (int)(threadIdx.x >> 6);
    __syncthreads();
    const int lane = lane_id(), wave = wave_id(), tid = wave * 64 + lane;
    const int gw = blockIdx.x * NWAVE + wave, ngw = gridDim.x * NWAVE;
    XcdBarrier bar = xcd_barrier_post((unsigned*)(ws + WS_CTL), (volatile LAS unsigned*)((LAS unsigned char*)lds_raw + MISC_OFF) + 8);
#define GRID_BAR() xcd_barrier(bar)

    REP(0) {
        if (blockIdx.x < 96) {
            for (int i = tid; i < NB * DM; i += NTHR) { const float cv = a.c[i]; lds[i] = cv / (1.f + expf(-cv)); }
            __syncthreads();
            gemv8_task(lds, a.w_ada, 6 * DM, blockIdx.x * 64, a.b_ada, ADA, 6 * DM, tid);
        }
        float* scr = lds + 12288 + wave * 2112;
        constexpr int I_IN = 16 * 80, I_OUT = 16 * 32, I_Q = 16 * 64;
        for (int it = gw; it < I_IN + I_OUT + I_Q; it += ngw) {
            int r = it;
            if (r < I_IN) { transpose_item(a.w_in, DM, INC, 80, WIN, scr, r, lane); continue; } r -= I_IN;
            if (r < I_OUT) { transpose_item(a.w_out, DM, DM, 32, WOUT, scr, r, lane); continue; } r -= I_OUT;
            transpose_item(a.w_query, DM, NQ, 64, WQ, scr, r, lane);
        }
        for (int it = gw; it < 512; it += ngw) cvt512(a.sub_keys + (size_t)it * 512, SUBK + (size_t)it * 512, lane);
        for (int it = gw; it < 256; it += ngw) {
            const int e0 = it * 512 + 8 * lane, t = (e0 >> 7) & 127, s0 = e0 & 127;
            const float4 p = *(const float4*)(a.sg_w + e0), q = *(const float4*)(a.sg_w + e0 + 4);
            const float v[8] = {p.x, p.y, p.z, p.w, q.x, q.y, q.z, q.w}; float m[8];
#pragma unroll
            for (int i = 0; i < 8; ++i) m[i] = (s0 + i <= t) ? v[i] : 0.f;
            uint4 o; o.x = pk2(m[0], m[1]); o.y = pk2(m[2], m[3]); o.z = pk2(m[4], m[5]); o.w = pk2(m[6], m[7]);
            *(uint4*)(SGWB + e0) = o;
        }
        for (int it = gw; it < 2 * 16384; it += ngw) {
            const bool isv = it >= 16384; const int r = isv ? it - 16384 : it; const float sc = isv ? peer::V_SCALE : peer::U_SCALE;
            const float* src = (isv ? a.expert_v : a.expert_u) + (size_t)r * DM + 16 * lane; unsigned char* dst = (isv ? EV : EU) + (size_t)(lane >> 3) * peer::SLICE_BYTES + (size_t)r * 128 + 16 * (lane & 7);
            uint4 o; unsigned* ow = (unsigned*)&o;
#pragma unroll
            for (int k = 0; k < 4; ++k) { const float4 f = *(const float4*)(src + 4 * k); int w = __builtin_amdgcn_cvt_pk_fp8_f32(f.x * sc, f.y * sc, 0, false); w = __builtin_amdgcn_cvt_pk_fp8_f32(f.z * sc, f.w * sc, w, true); ow[k] = (unsigned)w; }
            *(uint4*)dst = o;
        }
    }
    GRID_BAR();
    REP(1) {
        for (int i = tid; i < 8 * DM; i += NTHR) { const int k = i >> 3, j = i & 7; lds[j * DM + k] = a.w_in[(size_t)k * INC + NPROJ + j]; }
        __syncthreads();
        for (int t = gw; t < NT; t += ngw) {
            const int b = t / SEQ; const float* xr = a.x + (size_t)t * DM; const float* shift = ADA + b * 6 * DM; const float* scale = shift + DM;
            float4 v[4]; float s = 0.f;
#pragma unroll
            for (int j = 0; j < 4; ++j) { v[j] = *(const float4*)(xr + 256 * j + 4 * lane); s += v[j].x * v[j].x + v[j].y * v[j].y + v[j].z * v[j].z + v[j].w * v[j].w; }
            const float rstd = rsqrtf(wave_sum(s) * (1.f / DM) + EPS);
#pragma unroll
            for (int j = 0; j < 4; ++j) {
                const int c = 256 * j + 4 * lane;
                const float4 gg = *(const float4*)(a.norm1_g + c), sh = *(const float4*)(shift + c), sc = *(const float4*)(scale + c);
                v[j].x = v[j].x * rstd * gg.x * (1.f + sc.x) + sh.x; v[j].y = v[j].y * rstd * gg.y * (1.f + sc.y) + sh.y;
                v[j].z = v[j].z * rstd * gg.z * (1.f + sc.z) + sh.z; v[j].w = v[j].w * rstd * gg.w * (1.f + sc.w) + sh.w;
                uint2 o; o.x = pk2(v[j].x, v[j].y); o.y = pk2(v[j].z, v[j].w);
                *(uint2*)(HB + (size_t)t * DM + c) = o;
            }
            float fl = 0.f;
#pragma unroll
            for (int j8 = 0; j8 < 8; ++j8) { float d = 0.f;
#pragma unroll
                for (int j = 0; j < 4; ++j) { const float4 w = *(const float4*)(lds + j8 * DM + 256 * j + 4 * lane); d += v[j].x * w.x + v[j].y * w.y + v[j].z * w.z + v[j].w * w.w; }
                d = wave_sum(d); if (lane == j8) fl = d; }
            if (lane < 8) FL[(size_t)t * 8 + lane] = log_sigmoid(fl + a.b_f[lane]);
        }
        __syncthreads();
        if (blockIdx.x < 32) {
            for (int i = tid; i < NB * DM; i += NTHR) lds[i] = ADA[(i >> 10) * 6 * DM + 3 * DM + (i & 1023)];
            __syncthreads();
            gemv8_task(lds, a.w_query, NQ, blockIdx.x * 64, nullptr, SQB, NQ, tid);
        }
    }
    GRID_BAR();
    REP(2) {
        if (gw < NB * NH) {
            const int b = gw >> 3, h = gw & 7; float v[32]; float run = 0.f;
#pragma unroll
            for (int i = 0; i < 32; ++i) { run += FL[((size_t)b * SEQ + 32 * lane + i) * 8 + h]; v[i] = run; }
            float incl = run;
#pragma unroll
            for (int o = 1; o < 64; o <<= 1) { const float n = __shfl_up(incl, o); if (lane >= o) incl += n; }
            const float excl = incl - run;
#pragma unroll
            for (int i = 0; i < 32; ++i) {
                const size_t e = ((size_t)b * SEQ + 32 * lane + i) * 8 + h; const float g = (excl + v[i]) * LOG2E; GQ[e] = g;
                const float ng = -g; const unsigned g1 = f2bf(ng); const float r1 = ng - __uint_as_float(g1 << 16); const unsigned g2 = f2bf(r1); const float r2 = r1 - __uint_as_float(g2 << 16); const unsigned g3 = f2bf(r2);
                uint4 o; o.x = g1 | (g2 << 16); o.y = g3; o.z = 0u; o.w = 0u; *(uint4*)(GX + e * 8) = o;
            }
        }
        pg8::Gemm g{HB, WIN, NT, NPROJ, DM}; pg8::StaticOrder S; S.init(NT, NPROJ, gridDim.x, (int)blockIdx.x);
        pg8::EpiProj E{ZU};
        pg8::gemm_phase<pg8::EpiProj, pg8::StaticOrder, true, true>((PG8_LAS unsigned char*)lds_raw, g, S, E);
    }
    GRID_BAR();
    REP(3) {
        char* shm = (char*)lds_raw;
        for (int pt = blockIdx.x; pt < NB * (SEQ / CHUNK) * NH / 2; pt += gridDim.x)
            mixer::sgu_pair(2 * pt, ZU, ZV, SGWB, a.sg_ln_g, a.sg_ln_b, a.sg_b, a.out_g_sg, HB, shm);
        __syncthreads();
        const int G = gridDim.x, vcu = (G % 8 == 0) ? (blockIdx.x % 8) * (G / 8) + blockIdx.x / 8 : blockIdx.x;
        for (int pr = vcu; pr < NB * NH * 4; pr += G) {
            const int bh = pr >> 2, s = pr & 3;
            mixer::attn_unit(bh >> 3, bh & 7, 7 - s, Q, K, V, GQ, a.out_g_fox, HB, shm);
            mixer::attn_unit(bh >> 3, bh & 7, s, Q, K, V, GQ, a.out_g_fox, HB, shm);
        }
    }
    GRID_BAR();
    REP(4) {
        pg8::Gemm g{HB, WOUT, NT, DM, DM}; pg8::StaticOrder S; S.init(NT, DM, gridDim.x, (int)blockIdx.x);
        pg8::EpiOut E{a.x, ADA, a.norm2_g, a.out, XG, SSQ};
        pg8::gemm_phase<pg8::EpiOut, pg8::StaticOrder, false, true>((PG8_LAS unsigned char*)lds_raw, g, S, E);
    }
    GRID_BAR();
    REP(5) {
        pg8::Gemm g{XG, WQ, NT, NQ, DM}; pg8::StaticOrder S; S.init(NT, NQ, gridDim.x, (int)blockIdx.x);
        pg8::EpiQuery E{SSQ, SQB, QV};
        pg8::gemm_phase<pg8::EpiQuery, pg8::StaticOrder, true, true>((PG8_LAS unsigned char*)lds_raw, g, S, E);
    }
    GRID_BAR();
    REP(6) {
        char* shm = (char*)lds_raw;
        if (blockIdx.x < NT / 64) {
            const int t0 = blockIdx.x * 64;
            __syncthreads();
            peer::topk_head(t0, 0, wave, QV, SUBK, shm);
            peer::topk_head(t0 + 32, 32, wave, QV, SUBK, shm);
            __syncthreads();
            asm volatile("" : "+s"(shm));
            peer::gather_ts(t0 + wave * 8, wave * 8, XG, SSQ, ADA, EU, EV, a.final_g, a.out, shm, (rep_ == ((PROBE_REP) == 6 ? 1 : 0)) || a.ph_hi == 12345);
        }
    }
}

extern "C" void kernel_launch(void* const* d_in, const int* in_sizes, int n_in, void* d_out, int out_size, void* d_ws, size_t ws_size, hipStream_t stream) {
    if (n_in != 20 || ws_size < WS_END) { fprintf(stderr, "kernel_launch: unexpected n_in %d or ws_size %zu\n", n_in, ws_size); return; }
    Args a{};
    const float** p = (const float**)&a;
    for (int i = 0; i < 20; ++i) p[i] = (const float*)d_in[i];
    a.out = (float*)d_out; a.ws = (unsigned char*)d_ws;
    static int grid = 0;
    if (grid == 0) {
        int dev = 0, cus = 0, per_cu = 0;
        (void)hipGetDevice(&dev); (void)hipDeviceGetAttribute(&cus, hipDeviceAttributeMultiprocessorCount, dev);
        (void)hipFuncSetAttribute((const void*)fwd_kernel, hipFuncAttributeMaxDynamicSharedMemorySize, LDS_BYTES);
        (void)hipOccupancyMaxActiveBlocksPerMultiprocessor(&per_cu, (const void*)fwd_kernel, NTHR, LDS_BYTES);
        (void)hipGetLastError();
        if (per_cu < 1 || cus != 256) { fprintf(stderr, "kernel_launch: occupancy query says %d blocks/CU, %d CUs (built for one block on each of 256 CUs)\n", per_cu, cus); grid = -1; }
        else grid = cus;
    }
    if (grid < 0) return;
    (void)hipMemsetAsync((char*)d_ws + WS_CTL, 0, CTL_ZERO_BYTES, stream);
    a.ph_lo = 0; a.ph_hi = 10;
    hipLaunchKernelGGL(fwd_kernel, dim3(grid), dim3(NTHR), LDS_BYTES, stream, a);
}
```

```cpp
#include <hip/hip_runtime.h>
#include <cstdint>
#include <cstdio>
#include <cmath>

constexpr int DM = 1024, NB = 8, SEQ = 2048, NT = NB * SEQ;
constexpr int HD = 64, SGW = 512, FOXW = 512, NH = 8, CHUNK = 128;
constexpr int INC = 2 * SGW + 3 * FOXW + NH;
constexpr int NPROJ = 2560;
constexpr int PH = 8, NKEYS = 128, NEXP = NKEYS * NKEYS, TOPK = 16, DKEY = 256, DHALF = 128, NQ = PH * DKEY;
constexpr float EPS = 1e-6f;
constexpr int NTHR = 512, NWAVE = 8;
constexpr float LOG2E = 1.4426950408889634f;
constexpr float C2 = 0.125f * LOG2E;

typedef unsigned short bf16_t;

constexpr size_t MiB = 1u << 20;
constexpr size_t WS_CTL = 0, CTL_ZERO_BYTES = 64 * 1024;
constexpr size_t WS_ADA = 256 * 1024;
constexpr size_t WS_SQB = 512 * 1024;
constexpr size_t WS_FL = 1 * MiB;
constexpr size_t WS_GQ = WS_FL + MiB / 2;
constexpr size_t WS_SSQ = 2 * MiB;
constexpr size_t WS_WIN = 3 * MiB;
constexpr size_t WS_WOUT = WS_WIN + 5 * MiB;
constexpr size_t WS_WQ = WS_WOUT + 2 * MiB;
constexpr size_t WS_SUBK = WS_WQ + 4 * MiB;
constexpr size_t WS_SGW = WS_SUBK + MiB;
constexpr size_t WS_GX = WS_SGW + MiB;
constexpr size_t WS_EU = 20 * MiB;
constexpr size_t WS_EV = WS_EU + 32 * MiB;
constexpr size_t WS_HB = WS_EV + 32 * MiB;
constexpr size_t WS_ZU = WS_HB + 32 * MiB;
constexpr size_t WS_ZV = WS_ZU + 16 * MiB, WS_Q = WS_ZV + 16 * MiB, WS_K = WS_Q + 16 * MiB, WS_V = WS_K + 16 * MiB;
constexpr size_t WS_XG = WS_K;
constexpr size_t WS_QV = WS_HB;
constexpr size_t WS_IDX = WS_V + 16 * MiB;
constexpr size_t WS_GATE = WS_IDX + 8 * MiB;
constexpr size_t WS_END = WS_GATE + 8 * MiB;

struct Args {
    const float *x, *c, *w_ada, *b_ada, *norm1_g, *w_in, *b_f, *sg_ln_g, *sg_ln_b, *sg_w, *sg_b, *out_g_sg, *out_g_fox,
        *w_out, *norm2_g, *w_query, *sub_keys, *expert_u, *expert_v, *final_g;
    float* out; unsigned char* ws; int ph_lo, ph_hi;
};

#define GAS __attribute__((address_space(1)))
#define LAS __attribute__((address_space(3)))
#define WAVE_LDS_FENCE() do { __builtin_amdgcn_fence(__ATOMIC_ACQ_REL, "wavefront"); __builtin_amdgcn_wave_barrier(); } while (0)
constexpr int WTAB_OFF = 131072 + 1024;
__device__ __forceinline__ int lane_id() { return (int)__builtin_amdgcn_mbcnt_hi(~0u, __builtin_amdgcn_mbcnt_lo(~0u, 0u)); }
__device__ __forceinline__ int hw_slot() { return (int)(__builtin_amdgcn_s_getreg((5 << 11) | 4) & 63u); }
__device__ __forceinline__ int wave_id() { return __builtin_amdgcn_readfirstlane(*(const LAS int*)(unsigned)(WTAB_OFF + 4 * hw_slot())); }
#define TIDX (wave_id() * 64 + lane_id())
__device__ __forceinline__ float wave_sum(float v) {
#pragma unroll
    for (int o = 1; o < 64; o <<= 1) v += __shfl_xor(v, o);
    return v;
}
__device__ __forceinline__ float wave_max(float v) {
#pragma unroll
    for (int o = 1; o < 64; o <<= 1) v = fmaxf(v, __shfl_xor(v, o));
    return v;
}
__device__ __forceinline__ float gelu_exact(float v) { return 0.5f * v * (1.0f + erff(v * 0.70710678118654752f)); }
__device__ __forceinline__ float log_sigmoid(float v) { return fminf(v, 0.f) - log1pf(expf(-fabsf(v))); }
__device__ __forceinline__ float bf2f(bf16_t v) { return __uint_as_float((unsigned)v << 16); }
__device__ __forceinline__ unsigned f2bf(float f) { unsigned u = __builtin_bit_cast(unsigned, f); return (u + 0x7fffu + ((u >> 16) & 1u)) >> 16; }
__device__ __forceinline__ unsigned pk2(float lo, float hi) { return f2bf(lo) | (f2bf(hi) << 16); }

namespace pg8 {
#define PG8_LAS __attribute__((address_space(3)))
typedef unsigned short bf16_t;
typedef short bf16x8 __attribute__((ext_vector_type(8)));
typedef float f32x4 __attribute__((ext_vector_type(4)));
typedef unsigned u32x4 __attribute__((ext_vector_type(4)));
constexpr int BM = 256, BK = 64, HALF = 128, HTB = HALF * BK * 2  , STAGE_BYTES = 8 * HTB, NXCD = 8, WGM = 8;

__host__ __device__ __forceinline__ int lds_byte(int r, int c) { const int st = (r >> 4) * 2 + (c >> 5), rr = r & 15, cc = c & 31, ob = rr * 64 + cc * 2; return st * 1024 + (ob ^ (((ob >> 9) & 1) << 5)); }
__host__ __device__ __forceinline__ void stage_rc(int b, int& R, int& C) { const int st = b / 1024, sb = b % 1024, swz = sb ^ (((sb >> 9) & 1) << 5); R = (st >> 1) * 16 + swz / 64; C = (st & 1) * 32 + (swz % 64) / 2; }
__host__ __device__ __forceinline__ int perm32(int rho) { const int n = rho >> 4, i = rho & 15; return 8 * (i >> 2) + 4 * n + (i & 3); }

struct Unit { int pm, pn; };
struct Gemm { const bf16_t* A; const bf16_t* Bt; int M, N, K; };

struct StaticOrder {
    int nM, nN, nwg, G, c;
    __host__ __device__ void init(int M, int N, int G_, int c_) { nM = M / BM; nN = N / BM; nwg = nM * nN; G = G_; c = c_; }
    __host__ __device__ bool next(int i, Unit& u) const {
        const long L = (long)i * G + c; if (L >= nwg) return false;
        int wgid = (int)L; { const int q = nwg / NXCD, r = nwg % NXCD, xcd = wgid % NXCD, off = wgid / NXCD; wgid = (xcd < r ? xcd * (q + 1) : r * (q + 1) + (xcd - r) * q) + off; }
        const int nig = WGM * nN, gid = wgid / nig, fm = gid * WGM, gsz = (nM - fm) < WGM ? (nM - fm) : WGM;
        u.pm = fm + ((wgid % nig) % gsz); u.pn = (wgid % nig) / gsz; return true;
    }
    __device__ __forceinline__ void a_ready(const Unit&) const {}
    __device__ __forceinline__ void done(const Unit&) const {}
};


__device__ __forceinline__ unsigned cvt_pk_bf16(float lo, float hi) { unsigned r; asm volatile("v_cvt_pk_bf16_f32 %0, %1, %2" : "=v"(r) : "v"(lo), "v"(hi)); return r; }
typedef float f32x2 __attribute__((ext_vector_type(2)));
__device__ __forceinline__ f32x2 gelu_pk(f32x2 v) {
    const f32x2 av = __builtin_elementwise_abs(v), d = av * 0.2316418882f + 1.0f;
    f32x2 t; t.x = __builtin_amdgcn_rcpf(d.x); t.y = __builtin_amdgcn_rcpf(d.y);
    f32x2 q = t * 0.5307027145f + (-0.7265760135f); q = q * t + 0.7107068705f; q = q * t + (-0.142248368f); q = q * t + 0.127414796f; q = q * t;
    const f32x2 s = (v * v) * (-0.72134752044f);
    f32x2 e; e.x = __builtin_amdgcn_exp2f(s.x); e.y = __builtin_amdgcn_exp2f(s.y);
    const f32x2 m = v * (q * e), r = v - m;
    f32x2 o; o.x = v.x < 0.f ? m.x : r.x; o.y = v.y < 0.f ? m.y : r.y; return o;
}


typedef unsigned u32x4 __attribute__((ext_vector_type(4)));
struct EpiProj {
    static constexpr bool PERM = true, AFTER_DRAIN = false;
    bf16_t* base;
    __device__ __forceinline__ void operator()(const f32x4 (&acc)[2][2][4][2], const Unit& u, int wr, int wc, int fr, int fq) const {
        const int t = u.pn >> 1;
        bf16_t* O = base + (size_t)t * NT * 512;
        const bool act = t < 2; const float sc = (t == 2) ? C2 : 1.f;
        const int row0 = u.pm * BM + wr * 64 + fr, col0 = (u.pn & 1) * 256 + wc * 32 + 8 * fq;
#pragma unroll
        for (int ai = 0; ai < 2; ++ai)
#pragma unroll
            for (int m = 0; m < 4; ++m) { bf16_t* rowp = O + (size_t)(row0 + ai * HALF + m * 16) * 512 + col0;
#pragma unroll
                for (int bj = 0; bj < 2; ++bj) { f32x4 v0 = acc[ai][bj][m][0], v1 = acc[ai][bj][m][1];
                    if (act) { f32x2 a = gelu_pk((f32x2){v0[0], v0[1]}), b = gelu_pk((f32x2){v0[2], v0[3]}), c = gelu_pk((f32x2){v1[0], v1[1]}), d = gelu_pk((f32x2){v1[2], v1[3]});
                        v0 = (f32x4){a.x, a.y, b.x, b.y}; v1 = (f32x4){c.x, c.y, d.x, d.y}; }
                    v0 = v0 * sc; v1 = v1 * sc; u32x4 w; w.x = cvt_pk_bf16(v0[0], v0[1]); w.y = cvt_pk_bf16(v0[2], v0[3]); w.z = cvt_pk_bf16(v1[0], v1[1]); w.w = cvt_pk_bf16(v1[2], v1[3]);
                    *(u32x4*)(rowp + bj * HALF) = w; } }
    }
};
struct EpiOut {
    static constexpr bool PERM = true, AFTER_DRAIN = true;
    const float* x; const float* ada; const float* norm2_g; float* x1out; bf16_t* xg; float* ssq4;
    __device__ __forceinline__ void fused(f32x4 (&acc)[2][2][4][2], const Unit& u, int wr, int wc, int fr, int fq, PG8_LAS unsigned char* lds, int wid, int lane) const {
        const int b = (u.pm * BM) / SEQ;
        const float* gate1 = ada + b * 6 * DM + 2 * DM; const float* scale2 = ada + b * 6 * DM + 4 * DM;
        const int col0 = u.pn * BM + wc * 32 + 8 * fq;
        PG8_LAS float* P = (PG8_LAS float*)lds;
        f32x4 gt[2][2], g2[2][2];
#pragma unroll
        for (int bj = 0; bj < 2; ++bj)
#pragma unroll
            for (int n = 0; n < 2; ++n) { const int c = col0 + bj * HALF + 4 * n; gt[bj][n] = *(const f32x4*)(gate1 + c); g2[bj][n] = *(const f32x4*)(norm2_g + c) * (*(const f32x4*)(scale2 + c) + 1.0f); }
#pragma unroll
        for (int ai = 0; ai < 2; ++ai)
#pragma unroll
            for (int m = 0; m < 4; ++m) { const int rl = ai * HALF + wr * 64 + m * 16 + fr; const size_t off = (size_t)(u.pm * BM + rl) * DM + col0; float ss = 0.f;
#pragma unroll
                for (int bj = 0; bj < 2; ++bj) {
                    const f32x4 x0 = __builtin_nontemporal_load((const f32x4*)(x + off + bj * HALF)), x1 = __builtin_nontemporal_load((const f32x4*)(x + off + bj * HALF + 4));
                    const f32x4 v0 = x0 + gt[bj][0] * acc[ai][bj][m][0], v1 = x1 + gt[bj][1] * acc[ai][bj][m][1];
                    ss += (v0[0] * v0[0] + v0[1] * v0[1]) + (v0[2] * v0[2] + v0[3] * v0[3]) + (v1[0] * v1[0] + v1[1] * v1[1]) + (v1[2] * v1[2] + v1[3] * v1[3]);
                    const f32x4 w0 = v0 * g2[bj][0], w1 = v1 * g2[bj][1];
                    u32x4 w; w.x = cvt_pk_bf16(w0[0], w0[1]); w.y = cvt_pk_bf16(w0[2], w0[3]); w.z = cvt_pk_bf16(w1[0], w1[1]); w.w = cvt_pk_bf16(w1[2], w1[3]);
                    *(u32x4*)(xg + off + bj * HALF) = w; }
                ss += __shfl_xor(ss, 16); ss += __shfl_xor(ss, 32);
                if (fq == 0) P[rl * 4 + wc] = ss; }
        asm volatile("s_waitcnt lgkmcnt(0)" ::: "memory"); __builtin_amdgcn_s_barrier(); asm volatile("" ::: "memory");
        const int tid = wid * 64 + lane;
        if (tid < 256) ssq4[(size_t)(u.pm * BM + tid) * 4 + u.pn] = (P[tid * 4 + 0] + P[tid * 4 + 1]) + (P[tid * 4 + 2] + P[tid * 4 + 3]);
        asm volatile("s_waitcnt lgkmcnt(0)" ::: "memory"); __builtin_amdgcn_s_barrier(); asm volatile("" ::: "memory");
    }
};
struct EpiQuery {
    static constexpr bool PERM = true, AFTER_DRAIN = false;
    const float* ssq4; const float* sqb; bf16_t* qv;
    __device__ __forceinline__ void operator()(const f32x4 (&acc)[2][2][4][2], const Unit& u, int wr, int wc, int fr, int fq) const {
        const int b = (u.pm * BM) / SEQ;
        const int row0 = u.pm * BM + wr * 64 + fr, col0 = u.pn * BM + wc * 32 + 8 * fq;
        f32x4 bv[2][2];
#pragma unroll
        for (int bj = 0; bj < 2; ++bj)
#pragma unroll
            for (int n = 0; n < 2; ++n) bv[bj][n] = *(const f32x4*)(sqb + b * NQ + col0 + bj * HALF + 4 * n);
#pragma unroll
        for (int ai = 0; ai < 2; ++ai)
#pragma unroll
            for (int m = 0; m < 4; ++m) { const int row = row0 + ai * HALF + m * 16; const f32x4 s4 = *(const f32x4*)(ssq4 + (size_t)row * 4);
                const float rstd = rsqrtf(((s4[0] + s4[1]) + (s4[2] + s4[3])) * (1.f / DM) + EPS);
                bf16_t* rowp = qv + (size_t)row * NQ + col0;
#pragma unroll
                for (int bj = 0; bj < 2; ++bj) { const f32x4 v0 = acc[ai][bj][m][0] * rstd + bv[bj][0], v1 = acc[ai][bj][m][1] * rstd + bv[bj][1];
                    u32x4 w; w.x = cvt_pk_bf16(v0[0], v0[1]); w.y = cvt_pk_bf16(v0[2], v0[3]); w.z = cvt_pk_bf16(v1[0], v1[1]); w.w = cvt_pk_bf16(v1[2], v1[3]);
                    *(u32x4*)(rowp + bj * HALF) = w; } }
    }
};

template <class Epi, class Sched, bool ALIGN_EPI = false, bool SP2 = false>
__device__ __forceinline__ void gemm_phase(PG8_LAS unsigned char* lds, const Gemm g, const Sched& S, const Epi& E) {
    int tid_ = TIDX; asm volatile("" : "+v"(tid_));
    const int tid = tid_, wid = __builtin_amdgcn_readfirstlane(tid >> 6), lane = tid & 63, wr = wid >> 2, wc = wid & 3, fr = lane & 15, fq = lane >> 4;
    const int K = g.K, nt = K / BK;
    unsigned voffA[2], voffB[2];
#pragma unroll
    for (int i = 0; i < 2; ++i) { int R, C; stage_rc(tid * 16 + i * 8192, R, C); const int Rb = Epi::PERM ? ((R & ~31) + perm32(R & 31)) : R;
        voffA[i] = (unsigned)(R * K + C) * 2u; voffB[i] = (unsigned)(Rb * K + C) * 2u; }
    const size_t kstep = (size_t)(BK * 2);
    const size_t hstep = (size_t)HALF * K * 2;
    const size_t tstep = 2 * hstep;
    const unsigned ldsw = (unsigned)wid * 1024u;
    const int aoff = lds_byte(wr * 64 + fr, fq * 8), boff = lds_byte(wc * 32 + fr, fq * 8);
#define PG8_SA(b, h) (((b) * 2 + (h)) * HTB)
#define PG8_SB(b, h) ((4 + (b) * 2 + (h)) * HTB)
#define PG8_STAGE(bufoff, gbase, voff) do { _Pragma("unroll") for (int _i = 0; _i < 2; ++_i) \
        __builtin_amdgcn_global_load_lds((const unsigned*)((const char*)(gbase) + (voff)[_i]), (PG8_LAS unsigned*)(lds + (bufoff) + ldsw + _i * 8192), 16, 0, 0); } while (0)
#define PG8_LDA(dst, b, h) do { _Pragma("unroll") for (int m = 0; m < 4; ++m) _Pragma("unroll") for (int k = 0; k < 2; ++k) dst[m][k] = *(const PG8_LAS bf16x8*)(lds + PG8_SA(b, h) + aoff + m * 2048 + k * 1024); } while (0)
#define PG8_LDB(dst, b, h) do { _Pragma("unroll") for (int n = 0; n < 2; ++n) _Pragma("unroll") for (int k = 0; k < 2; ++k) dst[n][k] = *(const PG8_LAS bf16x8*)(lds + PG8_SB(b, h) + boff + n * 2048 + k * 1024); } while (0)
#define PG8_MMA(ai, bj, At, Bt) do { __builtin_amdgcn_s_setprio(1); _Pragma("unroll") for (int m = 0; m < 4; ++m) _Pragma("unroll") for (int n = 0; n < 2; ++n) _Pragma("unroll") for (int k = 0; k < 2; ++k) \
        acc[ai][bj][m][n] = __builtin_amdgcn_mfma_f32_16x16x32_bf16(Bt[n][k], At[m][k], acc[ai][bj][m][n], 0, 0, 0); __builtin_amdgcn_s_setprio(0); } while (0)
#define PG8_WAIT_V(n) asm volatile("s_waitcnt vmcnt(" #n ")" ::: "memory")
#define PG8_WAIT_L(n) asm volatile("s_waitcnt lgkmcnt(" #n ")" ::: "memory")
#define PG8_BAR __builtin_amdgcn_s_barrier()
#define PG8_SCHED __builtin_amdgcn_sched_barrier(0)
    Unit cur, nxt; int ui = 0;
    if (!S.next(0, cur)) return;
    f32x4 acc[2][2][4][2];
#pragma unroll
    for (int a = 0; a < 2; ++a)
#pragma unroll
        for (int b = 0; b < 2; ++b)
#pragma unroll
            for (int m = 0; m < 4; ++m)
#pragma unroll
                for (int n = 0; n < 2; ++n) acc[a][b][m][n] = (f32x4){0.f, 0.f, 0.f, 0.f};
    bf16x8 At[4][2], B0[2][2], B1[2][2];
    const char* cA = (const char*)g.A + (size_t)cur.pm * tstep; const char* cB = (const char*)g.Bt + (size_t)cur.pn * tstep;
    S.a_ready(cur);
    if constexpr (SP2) {
        PG8_STAGE(PG8_SB(0, 0), cB, voffB); PG8_STAGE(PG8_SB(0, 1), cB + hstep, voffB); PG8_STAGE(PG8_SA(0, 0), cA, voffA); PG8_STAGE(PG8_SA(0, 1), cA + hstep, voffA);
        if (wr == 1) PG8_BAR;
        PG8_WAIT_V(2); PG8_BAR;
        PG8_STAGE(PG8_SB(1, 0), cB + kstep, voffB); PG8_STAGE(PG8_SA(1, 0), cA + kstep, voffA); PG8_STAGE(PG8_SB(1, 1), cB + hstep + kstep, voffB);
        PG8_WAIT_V(6); PG8_BAR;
    } else {
        PG8_STAGE(PG8_SB(0, 0), cB, voffB); PG8_STAGE(PG8_SA(0, 0), cA, voffA); PG8_STAGE(PG8_SB(0, 1), cB + hstep, voffB); PG8_STAGE(PG8_SA(0, 1), cA + hstep, voffA);
        if (wr == 1) PG8_BAR;
        PG8_WAIT_V(4); PG8_BAR;
        PG8_STAGE(PG8_SB(1, 0), cB + kstep, voffB); PG8_STAGE(PG8_SA(1, 0), cA + kstep, voffA); PG8_STAGE(PG8_SB(1, 1), cB + hstep + kstep, voffB);
        PG8_WAIT_V(6); PG8_BAR;
    }
    for (;;) {
        const bool has_next = S.next(ui + 1, nxt);
        const char* nA = has_next ? (const char*)g.A + (size_t)nxt.pm * tstep : cA; const char* nB = has_next ? (const char*)g.Bt + (size_t)nxt.pn * tstep : cB;
        for (int t = 0; t < nt; t += 2) {
            const bool last = (t == nt - 2);
            const char* a1 = cA + (size_t)(t + 1) * kstep;
            const char* a2 = last ? nA : cA + (size_t)(t + 2) * kstep; const char* b2 = last ? nB : cB + (size_t)(t + 2) * kstep;
            const char* a3 = a2 + kstep; const char* b3 = b2 + kstep;
            if (last && has_next) S.a_ready(nxt);
            if constexpr (SP2) {
            PG8_LDB(B0, 0, 0); PG8_LDB(B1, 0, 1); PG8_SCHED; PG8_LDA(At, 0, 0); PG8_STAGE(PG8_SA(1, 1), a1 + hstep, voffA);
            PG8_WAIT_V(8); PG8_WAIT_L(0); PG8_BAR; PG8_MMA(0, 0, At, B0); PG8_MMA(0, 1, At, B1); PG8_BAR; PG8_SCHED;
            PG8_LDA(At, 0, 1); PG8_STAGE(PG8_SB(0, 0), b2, voffB); PG8_STAGE(PG8_SB(0, 1), b2 + hstep, voffB); PG8_STAGE(PG8_SA(0, 0), a2, voffA);
            PG8_WAIT_V(8); PG8_WAIT_L(0); PG8_BAR; PG8_MMA(1, 0, At, B0); PG8_MMA(1, 1, At, B1); PG8_BAR; PG8_SCHED;
            PG8_LDB(B0, 1, 0); PG8_LDB(B1, 1, 1); PG8_SCHED; PG8_LDA(At, 1, 0); PG8_STAGE(PG8_SA(0, 1), a2 + hstep, voffA);
            PG8_WAIT_V(8); PG8_WAIT_L(0); PG8_BAR; PG8_MMA(0, 0, At, B0); PG8_MMA(0, 1, At, B1); PG8_BAR; PG8_SCHED;
            PG8_LDA(At, 1, 1); PG8_STAGE(PG8_SB(1, 0), b3, voffB); PG8_STAGE(PG8_SB(1, 1), b3 + hstep, voffB); PG8_STAGE(PG8_SA(1, 0), a3, voffA);
            PG8_WAIT_V(8); PG8_WAIT_L(0); PG8_BAR; PG8_MMA(1, 0, At, B0); PG8_MMA(1, 1, At, B1); PG8_BAR; PG8_SCHED;
            } else {
            PG8_LDB(B0, 0, 0); PG8_SCHED; PG8_LDA(At, 0, 0); PG8_STAGE(PG8_SA(1, 1), a1 + hstep, voffA);
            PG8_WAIT_L(8); PG8_BAR; PG8_WAIT_L(0); PG8_MMA(0, 0, At, B0); PG8_BAR; PG8_SCHED;
            PG8_LDB(B1, 0, 1); PG8_STAGE(PG8_SB(0, 0), b2, voffB);
            PG8_BAR; PG8_WAIT_L(0); PG8_MMA(0, 1, At, B1); PG8_BAR;
            PG8_LDA(At, 0, 1); PG8_STAGE(PG8_SA(0, 0), a2, voffA);
            PG8_BAR; PG8_WAIT_L(0); PG8_MMA(1, 0, At, B0); PG8_BAR; PG8_SCHED;
            PG8_STAGE(PG8_SB(0, 1), b2 + hstep, voffB);
            PG8_WAIT_V(6); PG8_BAR; PG8_MMA(1, 1, At, B1); PG8_BAR;
            PG8_LDB(B0, 1, 0); PG8_SCHED; PG8_LDA(At, 1, 0); PG8_STAGE(PG8_SA(0, 1), a2 + hstep, voffA);
            PG8_WAIT_L(8); PG8_BAR; PG8_WAIT_L(0); PG8_MMA(0, 0, At, B0); PG8_BAR; PG8_SCHED;
            PG8_LDB(B1, 1, 1); PG8_STAGE(PG8_SB(1, 0), b3, voffB);
            PG8_BAR; PG8_WAIT_L(0); PG8_MMA(0, 1, At, B1); PG8_BAR;
            PG8_LDA(At, 1, 1); PG8_STAGE(PG8_SA(1, 0), a3, voffA);
            PG8_BAR; PG8_WAIT_L(0); PG8_MMA(1, 0, At, B0); PG8_BAR; PG8_SCHED;
            PG8_STAGE(PG8_SB(1, 1), b3 + hstep, voffB);
            PG8_WAIT_V(6); PG8_BAR; PG8_MMA(1, 1, At, B1); PG8_BAR;
            }
        }
        if constexpr (ALIGN_EPI) { if (wr == 0) PG8_BAR; }
        if constexpr (!Epi::AFTER_DRAIN) { E(acc, cur, wr, wc, fr, fq); S.done(cur); }
        if (!has_next) break;
#pragma unroll
        for (int a = 0; a < 2; ++a)
#pragma unroll
            for (int b = 0; b < 2; ++b)
#pragma unroll
                for (int m = 0; m < 4; ++m)
#pragma unroll
                    for (int n = 0; n < 2; ++n) acc[a][b][m][n] = (f32x4){0.f, 0.f, 0.f, 0.f};
        cur = nxt; cA = nA; cB = nB; ++ui;
        if constexpr (ALIGN_EPI) { if (wr == 1) PG8_BAR; }
    }
    PG8_WAIT_V(0);
    if constexpr (!ALIGN_EPI) { if (wr == 0) PG8_BAR; }
    PG8_BAR;
    if constexpr (Epi::AFTER_DRAIN) { E.fused(acc, cur, wr, wc, fr, fq, lds, wid, lane); S.done(cur); }
#undef PG8_SA
#undef PG8_SB
#undef PG8_STAGE
#undef PG8_LDA
#undef PG8_LDB
#undef PG8_MMA
#undef PG8_WAIT_V
#undef PG8_WAIT_L
#undef PG8_BAR
#undef PG8_SCHED
}
}

namespace mixer {
typedef short bf16x8 __attribute__((ext_vector_type(8)));
typedef short s16x4 __attribute__((ext_vector_type(4)));
typedef float f32x16 __attribute__((ext_vector_type(16)));
typedef unsigned u32x4 __attribute__((ext_vector_type(4)));
typedef float f32x2_t __attribute__((ext_vector_type(2))); typedef __bf16 bf16x2_t __attribute__((ext_vector_type(2)));
__device__ __forceinline__ int crow(int r, int hi) { return (r & 3) + 8 * (r >> 2) + 4 * hi; }
__device__ __forceinline__ unsigned cvtpk(float lo, float hi) { f32x2_t v = {lo, hi}; bf16x2_t b = __builtin_convertvector(v, bf16x2_t); return __builtin_bit_cast(unsigned, b); }
#define MX_SBAR() __builtin_amdgcn_sched_barrier(0)

constexpr int A_K = 0, A_V = 8192, A_G = 16384, A_BUF = 16640  , A_WS = 2 * A_BUF, A_OST = A_WS + 2048, A_BYTES = A_OST + 8 * 8192;
__device__ __forceinline__ void pv(f32x16* o, int vb, bf16x8 pa0, bf16x8 pa1, bf16x8 pa2, bf16x8 pa3) {
#pragma unroll
    for (int d0 = 0; d0 < 2; ++d0) { s16x4 lo[4], hi[4];
#pragma unroll
        for (int ks = 0; ks < 4; ++ks) {
            asm volatile("ds_read_b64_tr_b16 %0,%1 offset:%c2" : "=&v"(lo[ks]) : "v"(vb), "i"(d0 * 4096 + ks * 1024) : "memory");
            asm volatile("ds_read_b64_tr_b16 %0,%1 offset:%c2" : "=&v"(hi[ks]) : "v"(vb), "i"(d0 * 4096 + ks * 1024 + 512) : "memory"); }
        asm volatile("s_waitcnt lgkmcnt(0)" ::: "memory"); MX_SBAR();
#define MX_PK(k) (bf16x8){lo[k][0], lo[k][1], lo[k][2], lo[k][3], hi[k][0], hi[k][1], hi[k][2], hi[k][3]}
        o[d0] = __builtin_amdgcn_mfma_f32_32x32x16_bf16(pa0, MX_PK(0), o[d0], 0, 0, 0);
        o[d0] = __builtin_amdgcn_mfma_f32_32x32x16_bf16(pa1, MX_PK(1), o[d0], 0, 0, 0);
        o[d0] = __builtin_amdgcn_mfma_f32_32x32x16_bf16(pa2, MX_PK(2), o[d0], 0, 0, 0);
        o[d0] = __builtin_amdgcn_mfma_f32_32x32x16_bf16(pa3, MX_PK(3), o[d0], 0, 0, 0);
#undef MX_PK
    }
}
__device__ __forceinline__ void attn_unit(int b, int h, int qb, const bf16_t* Q, const bf16_t* K, const bf16_t* V, const float* GQ, const float* out_g, bf16_t* Y, char* shm) {
    const int tid = TIDX, lane = tid & 63, r32 = lane & 31, hi = lane >> 5; const int wid = __builtin_amdgcn_readfirstlane(tid >> 6);
    const size_t rowbase = (size_t)b * SEQ; const int q0 = qb * 256;
    const bf16_t* Qw = Q + (rowbase + q0 + wid * 32) * 512 + h * 64;
    const bf16_t* Kh = K + rowbase * 512 + h * 64; const bf16_t* Vh = V + rowbase * 512 + h * 64;
    const unsigned lds0 = (unsigned)(uintptr_t)shm;
    float* wsf = (float*)(shm + A_WS) + wid * 64;
    const bf16_t* ksrc = Kh + (size_t)lane * 512 + wid * 8;
    const bf16_t* vsrc = Vh + (size_t)(16 * (wid & 3) + (lane >> 2)) * 512 + (wid >> 2) * 32 + (lane & 3) * 8;
    const int kdo = A_K + wid * 1024 + lane * 16, vdo = A_V + wid * 1024 + lane * 16;
    const int vb0 = (int)(lds0 + A_V) + ((lane >> 4) & 1) * 32 + (lane & 3) * 8 + (4 * hi + ((lane & 15) >> 2)) * 64;
    const int kbo = A_K + hi * 1024 + r32 * 16;
    const int NTL = (q0 + 256) / 64;
    bf16x8 qr[4];
#pragma unroll
    for (int d0 = 0; d0 < 4; ++d0) qr[d0] = *reinterpret_cast<const bf16x8*>(&Qw[(size_t)r32 * 512 + d0 * 16 + hi * 8]);
    const int qrow = q0 + wid * 32 + r32;
    float m_run = -INFINITY, l_run = 0.f; f32x16 o[2]; o[0] = f32x16{}; o[1] = f32x16{};
    uint4 kreg = *(const uint4*)ksrc, vreg = *(const uint4*)vsrc; float greg = (tid < 64) ? -GQ[(rowbase + tid) * 8 + h] : 0.f;
    __syncthreads();
    *(uint4*)(shm + kdo) = kreg; *(uint4*)(shm + vdo) = vreg; if (tid < 64) ((float*)(shm + A_G))[tid] = greg;
    if (NTL > 1) { kreg = *(const uint4*)(ksrc + (size_t)64 * 512); vreg = *(const uint4*)(vsrc + (size_t)64 * 512); if (tid < 64) greg = -GQ[(rowbase + 64 + tid) * 8 + h]; }
    for (int t = 0; t < NTL; ++t) {
        const int cur = (t & 1) * A_BUF, nxt = A_BUF - cur;
        __syncthreads();
        if (t + 1 < NTL) { *(uint4*)(shm + nxt + kdo) = kreg; *(uint4*)(shm + nxt + vdo) = vreg; if (tid < 64) ((float*)(shm + nxt + A_G))[tid] = greg; }
        if (t + 2 < NTL) { kreg = *(const uint4*)(ksrc + (size_t)(t + 2) * 64 * 512); vreg = *(const uint4*)(vsrc + (size_t)(t + 2) * 64 * 512); if (tid < 64) greg = -GQ[(rowbase + (t + 2) * 64 + tid) * 8 + h]; }
        const float* gbl = (const float*)(shm + cur + A_G);
        f32x16 p0, p1;
#pragma unroll
        for (int g = 0; g < 4; ++g) {
            const float4 ga = *(const float4*)(gbl + 8 * g + 4 * hi), gc = *(const float4*)(gbl + 32 + 8 * g + 4 * hi);
            p0[4 * g + 0] = ga.x; p0[4 * g + 1] = ga.y; p0[4 * g + 2] = ga.z; p0[4 * g + 3] = ga.w;
            p1[4 * g + 0] = gc.x; p1[4 * g + 1] = gc.y; p1[4 * g + 2] = gc.z; p1[4 * g + 3] = gc.w; }
        const char* kb = shm + cur + kbo;
#pragma unroll
        for (int d0 = 0; d0 < 4; ++d0) {
            const bf16x8 b0 = *reinterpret_cast<const bf16x8*>(kb + d0 * 2048), b1 = *reinterpret_cast<const bf16x8*>(kb + d0 * 2048 + 512);
            p0 = __builtin_amdgcn_mfma_f32_32x32x16_bf16(b0, qr[d0], p0, 0, 0, 0); p1 = __builtin_amdgcn_mfma_f32_32x32x16_bf16(b1, qr[d0], p1, 0, 0, 0); }
        if (t >= NTL - 4) {
            const int kbase = t * 64 + 4 * hi;
#pragma unroll
            for (int r = 0; r < 16; ++r) { const int kv = kbase + (r & 3) + 8 * (r >> 2); if (kv > qrow) p0[r] = -INFINITY; if (kv + 32 > qrow) p1[r] = -INFINITY; } }
        float rm = fmaxf(p0[0], p1[0]);
#pragma unroll
        for (int r = 1; r < 16; ++r) rm = fmaxf(rm, fmaxf(p0[r], p1[r]));
        rm = fmaxf(rm, __shfl_xor(rm, 32));
        const float m_new = fmaxf(m_run, rm), alpha = __builtin_amdgcn_exp2f(m_run - m_new); m_run = m_new;
        float ps = 0.f;
#pragma unroll
        for (int r = 0; r < 16; ++r) { p0[r] = __builtin_amdgcn_exp2f(p0[r] - m_new); p1[r] = __builtin_amdgcn_exp2f(p1[r] - m_new); ps += p0[r] + p1[r]; }
        l_run = l_run * alpha + ps;
        if (hi == 0) wsf[r32] = alpha;
        WAVE_LDS_FENCE();
#pragma unroll
        for (int g = 0; g < 4; ++g) { const float4 al = *(const float4*)(wsf + 8 * g + 4 * hi);
#pragma unroll
            for (int d = 0; d < 2; ++d) { o[d][4 * g + 0] *= al.x; o[d][4 * g + 1] *= al.y; o[d][4 * g + 2] *= al.z; o[d][4 * g + 3] *= al.w; } }
        WAVE_LDS_FENCE();
        u32x4 pw0, pw1, pw2, pw3;
        pw0 = (u32x4){cvtpk(p0[0], p0[1]), cvtpk(p0[2], p0[3]), cvtpk(p0[4], p0[5]), cvtpk(p0[6], p0[7])};
        pw1 = (u32x4){cvtpk(p0[8], p0[9]), cvtpk(p0[10], p0[11]), cvtpk(p0[12], p0[13]), cvtpk(p0[14], p0[15])};
        pw2 = (u32x4){cvtpk(p1[0], p1[1]), cvtpk(p1[2], p1[3]), cvtpk(p1[4], p1[5]), cvtpk(p1[6], p1[7])};
        pw3 = (u32x4){cvtpk(p1[8], p1[9]), cvtpk(p1[10], p1[11]), cvtpk(p1[12], p1[13]), cvtpk(p1[14], p1[15])};
        MX_SBAR();
        pv(o, vb0 + cur, __builtin_bit_cast(bf16x8, pw0), __builtin_bit_cast(bf16x8, pw1), __builtin_bit_cast(bf16x8, pw2), __builtin_bit_cast(bf16x8, pw3));
    }
    l_run += __shfl_xor(l_run, 32);
    if (hi == 0) wsf[r32] = 1.0f / l_run;
    WAVE_LDS_FENCE();
    float* stg = (float*)(shm + A_OST) + wid * 2048;
#pragma unroll
    for (int r = 0; r < 16; ++r) { const int orow = crow(r, hi); const float rl = wsf[orow];
#pragma unroll
        for (int d0 = 0; d0 < 2; ++d0) stg[orow * 64 + d0 * 32 + r32] = o[d0][r] * rl; }
    WAVE_LDS_FENCE();
    bf16_t* Yw = Y + (rowbase + q0 + wid * 32) * DM + 512 + h * 64;
#pragma unroll
    for (int i = 0; i < 4; ++i) { const int row = i * 8 + (lane >> 3), ch = lane & 7;
        const float4 a = *(const float4*)(stg + row * 64 + ch * 8), c = *(const float4*)(stg + row * 64 + ch * 8 + 4);
        float ss = (a.x * a.x + a.y * a.y) + (a.z * a.z + a.w * a.w) + (c.x * c.x + c.y * c.y) + (c.z * c.z + c.w * c.w);
        ss += __shfl_xor(ss, 1); ss += __shfl_xor(ss, 2); ss += __shfl_xor(ss, 4);
        const float rs = rsqrtf(ss * (1.f / 64) + EPS);
        const float4 g0 = *(const float4*)(out_g + h * 64 + ch * 8), g1 = *(const float4*)(out_g + h * 64 + ch * 8 + 4);
        u32x4 w; w.x = cvtpk(a.x * rs * g0.x, a.y * rs * g0.y); w.y = cvtpk(a.z * rs * g0.z, a.w * rs * g0.w); w.z = cvtpk(c.x * rs * g1.x, c.y * rs * g1.y); w.w = cvtpk(c.z * rs * g1.z, c.w * rs * g1.w);
        *(u32x4*)(Yw + (size_t)row * DM + ch * 8) = w; }
    WAVE_LDS_FENCE();
}

constexpr int SG_PITCH = 136, SG_SLOT = 64 * SG_PITCH * 2;
__device__ __forceinline__ void sgu_pair(int task0, const bf16_t* ZU, const bf16_t* ZV, const bf16_t* SGWB, const float* ln_g, const float* ln_b, const float* sg_b, const float* out_g, bf16_t* Y, char* shm) {
    const int tid = TIDX, lane = tid & 63, r32 = lane & 31, hi = lane >> 5; const int wid = __builtin_amdgcn_readfirstlane(tid >> 6);
    const int slot = wid >> 2, j = wid & 3, task = task0 + slot;
    const int h = task % NH, bc = task / NH, t0 = bc * CHUNK;
    bf16_t* vnT = (bf16_t*)(shm + slot * SG_SLOT);
    bf16x8 bwf[8];
    { const bf16_t* wrow0 = SGWB + ((size_t)h * 128 + 32 * j + r32) * 128 + 8 * hi;
#pragma unroll
      for (int ks = 0; ks < 8; ++ks) bwf[ks] = *reinterpret_cast<const bf16x8*>(wrow0 + 16 * ks); }
    float* gbs = (float*)(shm + 2 * SG_SLOT) + slot * 128;
    { const int tq = tid & 255; if (tq < 128) gbs[tq] = (tq < 64) ? ln_g[h * 64 + tq] : ln_b[h * 64 + tq - 64]; }
    __syncthreads();
    {
        const int tl = tid & 255, s = tl >> 1, half = tl & 1;
        const bf16_t* zr = ZV + (size_t)(t0 + s) * 512 + h * 64 + half * 32;
        uint4 raw[4]; float v[32]; float sum = 0.f;
#pragma unroll
        for (int i = 0; i < 4; ++i) raw[i] = *(const uint4*)(zr + 8 * i);
#pragma unroll
        for (int i = 0; i < 4; ++i) { const unsigned w[4] = {raw[i].x, raw[i].y, raw[i].z, raw[i].w};
#pragma unroll
            for (int k = 0; k < 4; ++k) { v[8 * i + 2 * k] = __uint_as_float(w[k] << 16); v[8 * i + 2 * k + 1] = __uint_as_float(w[k] & 0xffff0000u); } }
#pragma unroll
        for (int i = 0; i < 32; ++i) sum += v[i];
        sum += __shfl_xor(sum, 1);
        const float mu = sum * (1.f / 64); float var = 0.f;
#pragma unroll
        for (int i = 0; i < 32; ++i) { v[i] -= mu; var += v[i] * v[i]; }
        var += __shfl_xor(var, 1);
        const float rs = rsqrtf(var * (1.f / 64) + EPS);
#pragma unroll
        for (int i = 0; i < 32; ++i) { const int d = half * 32 + i; vnT[d * SG_PITCH + s] = (bf16_t)f2bf(v[i] * rs * gbs[d] + gbs[64 + d]); }
    }
    __syncthreads();
    f32x16 acc[2]; acc[0] = f32x16{}; acc[1] = f32x16{};
    const int nks = 2 * (j + 1);
#pragma unroll
    for (int ks = 0; ks < 8; ++ks) {
        if (ks >= nks) break;
        const bf16x8 bw = bwf[ks];
        const bf16x8 a0 = *reinterpret_cast<const bf16x8*>(vnT + (size_t)r32 * SG_PITCH + 16 * ks + 8 * hi);
        const bf16x8 a1 = *reinterpret_cast<const bf16x8*>(vnT + (size_t)(32 + r32) * SG_PITCH + 16 * ks + 8 * hi);
        acc[0] = __builtin_amdgcn_mfma_f32_32x32x16_bf16(a0, bw, acc[0], 0, 0, 0);
        acc[1] = __builtin_amdgcn_mfma_f32_32x32x16_bf16(a1, bw, acc[1], 0, 0, 0);
    }
    const int tl = 32 * j + r32; const size_t row = (size_t)t0 + tl;
    const float bs = sg_b[h * 128 + tl];
    float ss = 0.f;
#pragma unroll
    for (int mb = 0; mb < 2; ++mb)
#pragma unroll
        for (int g = 0; g < 4; ++g) { const int d = 32 * mb + 8 * g + 4 * hi;
            const uint2 z = *(const uint2*)(ZU + row * 512 + h * 64 + d);
            const float z0 = __uint_as_float(z.x << 16), z1 = __uint_as_float(z.x & 0xffff0000u), z2 = __uint_as_float(z.y << 16), z3 = __uint_as_float(z.y & 0xffff0000u);
            acc[mb][4 * g + 0] = z0 * (acc[mb][4 * g + 0] + bs); acc[mb][4 * g + 1] = z1 * (acc[mb][4 * g + 1] + bs);
            acc[mb][4 * g + 2] = z2 * (acc[mb][4 * g + 2] + bs); acc[mb][4 * g + 3] = z3 * (acc[mb][4 * g + 3] + bs);
            ss += (acc[mb][4 * g + 0] * acc[mb][4 * g + 0] + acc[mb][4 * g + 1] * acc[mb][4 * g + 1]) + (acc[mb][4 * g + 2] * acc[mb][4 * g + 2] + acc[mb][4 * g + 3] * acc[mb][4 * g + 3]); }
    ss += __shfl_xor(ss, 32);
    const float rs = rsqrtf(ss * (1.f / 64) + EPS);
#pragma unroll
    for (int mb = 0; mb < 2; ++mb)
#pragma unroll
        for (int g = 0; g < 4; ++g) { const int d = 32 * mb + 8 * g + 4 * hi;
            const float4 og = *(const float4*)(out_g + h * 64 + d);
            uint2 w; w.x = cvtpk(acc[mb][4 * g + 0] * rs * og.x, acc[mb][4 * g + 1] * rs * og.y); w.y = cvtpk(acc[mb][4 * g + 2] * rs * og.z, acc[mb][4 * g + 3] * rs * og.w);
            *(uint2*)(Y + row * DM + h * 64 + d) = w; }
}
#undef MX_SBAR
}

namespace attn2 {
using bf16=unsigned short;
using bf16x8=__attribute__((ext_vector_type(8)))short;
using s16x4=__attribute__((ext_vector_type(4)))short;
using f32x16=__attribute__((ext_vector_type(16)))float;
using u32x4=__attribute__((ext_vector_type(4)))unsigned;
constexpr int BATCH=8,NHEAD=8,SEQ=2048,D=64,DM=NHEAD*D;
constexpr int NW=8,QBLK=32,QB=QBLK*NW,KVBLK=64,NQB=SEQ/QB;
constexpr int ATTN_PITCH=DM, ATTN_UNIT_ROWS=QB;
__device__ __forceinline__ int crow(int r,int hi){return (r&3)+8*(r>>2)+4*hi;}
#define SBAR() __builtin_amdgcn_sched_barrier(0)
__device__ __forceinline__ void cmask(f32x16&p0,f32x16&p1,int jb,int qrel,int hi){
  const float NEG=-INFINITY; int kb=64*jb+4*hi;
  #pragma unroll
  for(int r=0;r<16;++r){int kv=kb+(r&3)+8*(r>>2); if(kv>qrel)p0[r]=NEG; if(kv+32>qrel)p1[r]=NEG;}
}

constexpr int NSLOT=3, SLOTB=8192;
constexpr int LDS_K=0, LDS_V=NSLOT*SLOTB, LDS_G=2*NSLOT*SLOTB  , LDS_WS=LDS_G+1024, LDS_OST=LDS_WS+NW*64*4, LDS_BYTES=LDS_OST+NW*8192;
constexpr float C2_=0.125f*1.4426950408889634f;
__device__ __forceinline__ void glds16(const void*gsrc,unsigned lds_dst){unsigned keep;
  asm volatile("s_mov_b32 %0, m0\n\ts_mov_b32 m0, %2\n\ts_nop 0\n\tglobal_load_lds_dwordx4 %1, off\n\ts_mov_b32 m0, %0":"=&s"(keep):"v"(gsrc),"s"(lds_dst):"memory");}
__device__ __forceinline__ void glds4(const void*gsrc,unsigned lds_dst){unsigned keep;
  asm volatile("s_mov_b32 %0, m0\n\ts_mov_b32 m0, %2\n\ts_nop 0\n\tglobal_load_lds_dword %1, off\n\ts_mov_b32 m0, %0":"=&s"(keep):"v"(gsrc),"s"(lds_dst):"memory");}
__device__ __forceinline__ float max3f(float a,float b,float c){float r;asm("v_max3_f32 %0, %1, %2, %3":"=v"(r):"v"(a),"v"(b),"v"(c));return r;}
__device__ __forceinline__ float max2f(float a,float b){float r;asm("v_max_f32_e32 %0, %1, %2":"=v"(r):"v"(a),"v"(b));return r;}
__device__ __forceinline__ float fadd_s(float a,float b){float r;asm("v_add_f32_e32 %0, %1, %2":"=v"(r):"v"(a),"v"(b));return r;}
__device__ __forceinline__ float fsub_s(float a,float b){float r;asm("v_sub_f32_e32 %0, %1, %2":"=v"(r):"v"(a),"v"(b));return r;}
typedef float f32x2_t __attribute__((ext_vector_type(2))); typedef __bf16 bf16x2_t __attribute__((ext_vector_type(2)));
__device__ __forceinline__ unsigned cvtpk_s(float lo,float hi){f32x2_t v={lo,hi};bf16x2_t b=__builtin_convertvector(v,bf16x2_t);return __builtin_bit_cast(unsigned,b);}
#define WAIT_BAR(N) asm volatile("s_waitcnt vmcnt(" #N ") lgkmcnt(0)\n\ts_barrier":::"memory")

__device__ __forceinline__ void qkt(f32x16&p0,f32x16&p1,const char*Kslot,const bf16x8*qr,int r32,int hi){
  const char*kb=Kslot+hi*1024+r32*16;
  #pragma unroll
  for(int d0=0;d0<4;++d0){
    const bf16x8 b0=*reinterpret_cast<const bf16x8*>(kb+d0*2048);
    const bf16x8 b1=*reinterpret_cast<const bf16x8*>(kb+d0*2048+512);
    p0=__builtin_amdgcn_mfma_f32_32x32x16_bf16(b0,qr[d0],p0,0,0,0);p1=__builtin_amdgcn_mfma_f32_32x32x16_bf16(b1,qr[d0],p1,0,0,0);}
}
typedef __attribute__((address_space(3))) const char* lds_cptr;
typedef short v4i16_t __attribute__((ext_vector_type(4)));
__device__ __forceinline__ void kload8(bf16x8*kf,lds_cptr kp){
  kf[0]=*(const __attribute__((address_space(3))) bf16x8*)(kp);      kf[1]=*(const __attribute__((address_space(3))) bf16x8*)(kp+512);
  kf[2]=*(const __attribute__((address_space(3))) bf16x8*)(kp+2048); kf[3]=*(const __attribute__((address_space(3))) bf16x8*)(kp+2560);
  kf[4]=*(const __attribute__((address_space(3))) bf16x8*)(kp+4096); kf[5]=*(const __attribute__((address_space(3))) bf16x8*)(kp+4608);
  kf[6]=*(const __attribute__((address_space(3))) bf16x8*)(kp+6144); kf[7]=*(const __attribute__((address_space(3))) bf16x8*)(kp+6656);
}
__device__ __forceinline__ void kload2(bf16x8*kf,lds_cptr kp,int j){ kf[2*j]=*(const __attribute__((address_space(3))) bf16x8*)(kp+j*2048); kf[2*j+1]=*(const __attribute__((address_space(3))) bf16x8*)(kp+j*2048+512); }
__device__ __forceinline__ s16x4 vtr(lds_cptr p){ return __builtin_bit_cast(s16x4,__builtin_amdgcn_ds_read_tr16_b64_v4i16((__attribute__((address_space(3))) v4i16_t*)p)); }
__device__ __forceinline__ float rowmax(const f32x16&p0,const f32x16&p1){
  float a=max3f(p0[0],p0[1],p1[0]),b=max3f(p0[2],p0[3],p1[1]);a=max3f(a,p1[2],p1[3]);
  #pragma unroll
  for(int r=4;r<16;r+=4){a=max3f(a,p0[r],p0[r+1]);b=max3f(b,p0[r+2],p0[r+3]);a=max3f(a,p1[r],p1[r+1]);b=max3f(b,p1[r+2],p1[r+3]);}
  const float m=max2f(a,b);
  auto rr=__builtin_amdgcn_permlane32_swap(__float_as_uint(m),__float_as_uint(m),false,false);
  return max2f(__uint_as_float(rr[0]),__uint_as_float(rr[1]));
}
__device__ __forceinline__ void pv(f32x16*o,int vb,bf16x8 pa0,bf16x8 pa1,bf16x8 pa2,bf16x8 pa3){
  #pragma unroll
  for(int d0=0;d0<2;++d0){s16x4 lo[4],hi[4];
    #pragma unroll
    for(int ks=0;ks<4;++ks){
      asm volatile("ds_read_b64_tr_b16 %0,%1 offset:%c2":"=&v"(lo[ks]):"v"(vb),"i"(d0*4096+ks*1024):"memory");
      asm volatile("ds_read_b64_tr_b16 %0,%1 offset:%c2":"=&v"(hi[ks]):"v"(vb),"i"(d0*4096+ks*1024+512):"memory");}
    asm volatile("s_waitcnt lgkmcnt(0)":::"memory");SBAR();
    #define PK(k) (bf16x8){lo[k][0],lo[k][1],lo[k][2],lo[k][3],hi[k][0],hi[k][1],hi[k][2],hi[k][3]}
    o[d0]=__builtin_amdgcn_mfma_f32_32x32x16_bf16(pa0,PK(0),o[d0],0,0,0);
    o[d0]=__builtin_amdgcn_mfma_f32_32x32x16_bf16(pa1,PK(1),o[d0],0,0,0);
    o[d0]=__builtin_amdgcn_mfma_f32_32x32x16_bf16(pa2,PK(2),o[d0],0,0,0);
    o[d0]=__builtin_amdgcn_mfma_f32_32x32x16_bf16(pa3,PK(3),o[d0],0,0,0);
    #undef PK
  }
}

#ifndef ATTN_STORE16
#define ATTN_STORE16(p,v) (*(u32x4*)(p)=(v))
#endif
typedef __attribute__((address_space(3))) const float* lds_fptr; typedef float f32x4_t __attribute__((ext_vector_type(4)));
template<int THRL> __device__ __forceinline__ void attn_unit(int b,int h,int qb,const bf16*Q,const bf16*__restrict__ K,const bf16*__restrict__ V,const float*__restrict__ GT,const float*out_g,bf16*Y,char*shm){
  int tid_=TIDX; asm volatile("":"+v"(tid_));
  const int tid=tid_,lane=tid&63,r32=lane&31,hi=lane>>5; const int wid=__builtin_amdgcn_readfirstlane(tid>>6);
  const long rowbase=(long)b*SEQ; const int q0=qb*QB;
  const bf16*Qw=Q+(rowbase+q0+wid*QBLK)*DM+h*D;
  const bf16*Kh=K+rowbase*DM+h*D,*Vh=V+rowbase*DM+h*D;
  const unsigned lds0=(unsigned)(uintptr_t)shm;
  float*wsf=(float*)(shm+LDS_WS)+wid*64;
  const bf16*ksrc=Kh+(long)lane*DM+wid*8;
  const bf16*vsrc=Vh+(long)(16*(wid&3)+(lane>>2))*DM+(wid>>2)*32+(lane&3)*8;
  const unsigned kdst=lds0+LDS_K+wid*1024, vdst=lds0+LDS_V+wid*1024;
  #define DMA_K(t,slot) glds16(ksrc+(long)(t)*KVBLK*DM,(unsigned)__builtin_amdgcn_readfirstlane(kdst+(slot)))
  #define DMA_V(t,slot) glds16(vsrc+(long)(t)*KVBLK*DM,(unsigned)__builtin_amdgcn_readfirstlane(vdst+(slot)))
  const float*gsrc=GT+((long)b*NHEAD+h)*SEQ+lane; const unsigned gdst=lds0+LDS_G;
  #define DMA_G(t,goff) do{ if(wid==0) glds4(gsrc+(long)(t)*KVBLK,(unsigned)__builtin_amdgcn_readfirstlane(gdst+(goff))); }while(0)
  #define WAIT_BARG(N,N0) do{ if(wid==0){WAIT_BAR(N0);}else{WAIT_BAR(N);} }while(0)
  const int vb0=(int)(lds0+LDS_V)+((lane>>4)&1)*32+(lane&3)*8+(4*hi+((lane&15)>>2))*64;
  const char*Kbase=shm+LDS_K; bf16x8 kf[8];
  const lds_cptr shm3=(lds_cptr)shm; const lds_cptr kp0=shm3+LDS_K+hi*1024+r32*16; const lds_cptr vp0=shm3+LDS_V+((lane>>4)&1)*32+(lane&3)*8+(4*hi+((lane&15)>>2))*64;
  const int NT=(q0+QB)/KVBLK;
  DMA_K(0,0);DMA_G(0,0);DMA_G(1,256);DMA_G(2,512);DMA_V(0,0);DMA_K(1,SLOTB);
  bf16x8 qr[4];
  #pragma unroll
  for(int d0=0;d0<4;++d0)qr[d0]=*reinterpret_cast<const bf16x8*>(&Qw[(long)r32*DM+d0*16+hi*8]);
  float mhat=0.f,l_reg=0.f;f32x16 o[2];o[0]=f32x16{};o[1]=f32x16{};
  const int qrel=wid*QBLK+r32;
  #define CMASK(P0,P1,t) do{int jb_=(t)-(NT-4); if(jb_>=0)cmask(P0,P1,jb_,qrel,hi);}while(0)
  #define CINIT(P0,P1,goff) do{ const lds_fptr gb_=(lds_fptr)(shm3+LDS_G+(goff))+4*hi; \
    _Pragma("unroll") for(int g_=0;g_<4;++g_){ const f32x4_t a_=*(const __attribute__((address_space(3))) f32x4_t*)(gb_+8*g_), c_=*(const __attribute__((address_space(3))) f32x4_t*)(gb_+32+8*g_); \
      P0[4*g_+0]=a_[0]-mhat;P0[4*g_+1]=a_[1]-mhat;P0[4*g_+2]=a_[2]-mhat;P0[4*g_+3]=a_[3]-mhat; P1[4*g_+0]=c_[0]-mhat;P1[4*g_+1]=c_[1]-mhat;P1[4*g_+2]=c_[2]-mhat;P1[4*g_+3]=c_[3]-mhat; } }while(0)
  bool resc=false;
  #define START(P0,P1) do{ const float rm=rowmax(P0,P1); resc=false; \
    { const float dl=rm; mhat=fadd_s(mhat,dl); \
      _Pragma("unroll") for(int r=0;r<16;++r){P0[r]=fsub_s(P0[r],dl);P1[r]=fsub_s(P1[r],dl);} \
      } \
    _Pragma("unroll") for(int r=0;r<16;++r)P0[r]=__builtin_amdgcn_exp2f(P0[r]); }while(0)
  #define RESC() do{ if(resc){ asm volatile("s_waitcnt lgkmcnt(0)":::"memory"); \
      _Pragma("unroll") for(int d_=0;d_<2;++d_) _Pragma("unroll") for(int r=0;r<16;++r)o[d_][r]*=wsf[crow(r,hi)]; } }while(0)
  f32x16 pA0,pA1,pB0,pB1;
  int sl_prev=0,sl_cur=0,sl_next=SLOTB;
  #define ROT() do{sl_prev=sl_cur;sl_cur=sl_next;sl_next=(sl_next==(NSLOT-1)*SLOTB)?0:sl_next+SLOTB;}while(0)
  DMA_K(2,2*SLOTB);
  WAIT_BAR(3);
  CINIT(pA0,pA1,0);
  qkt(pA0,pA1,Kbase,qr,r32,hi);asm volatile("s_nop 15\n\ts_nop 7":"+v"(pA0),"+v"(pA1));CMASK(pA0,pA1,0);
  START(pA0,pA1);
  _Pragma("unroll") for(int r=0;r<16;++r)pA1[r]=__builtin_amdgcn_exp2f(pA1[r]);
  WAIT_BAR(0);
  DMA_K(3,0);DMA_V(1,SLOTB);DMA_G(3,768);
  ROT();
  kload8(kf,kp0+sl_cur);
  CINIT(pB0,pB1,256);
  WAIT_BARG(2,3);
  s16x4 vlo[8],vhi[8]; u32x4 pw0,pw1,pw2,pw3;
  #define PKW(P,B) cvtpk_s(P[B],P[B+1])
  #define PAF(k) __builtin_bit_cast(bf16x8,pw##k)
  #define VFR(i) (bf16x8){vlo[i][0],vlo[i][1],vlo[i][2],vlo[i][3],vhi[i][0],vhi[i][1],vhi[i][2],vhi[i][3]}
  #define PIN(x) asm volatile("":"+v"(x))
  #define MX3(a,b,c) __builtin_fmaxf(__builtin_fmaxf((a),(b)),(c))
  #define GAPA(MF,A0,A1,A2,A3,W0,W1,PW) do{ MF; sacc+=A0; sacc+=A1; sacc+=A2; sacc+=A3; PIN(sacc); W0; W1; PIN(PW); SBAR(); }while(0)
  #define EX(v) __builtin_amdgcn_exp2f(v)
  #define GAPB(MF,X,B) do{ MF; X[B]=EX(X[B]); X[B+1]=EX(X[B+1]); X[B+2]=EX(X[B+2]); X[B+3]=EX(X[B+3]); PIN(X); SBAR(); }while(0)
  #define VRD(i) do{ vlo[i]=vtr(vp_+(((i)>>2)*4096+((i)&3)*1024)); vhi[i]=vtr(vp_+(((i)>>2)*4096+((i)&3)*1024+512)); }while(0)
  #define KRD(G,j) do{ if(G){ kload2(kf,kp0+sl_next,j); SBAR(); } }while(0)
  #define STEP(C0,C1,P0,P1,t,GK,GV,GL) do{ SBAR(); \
    const lds_cptr vp_=vp0+sl_prev; \
    VRD(0); SBAR(); float sacc=(P0[0]+P0[1]); \
    GAPA(C0=__builtin_amdgcn_mfma_f32_32x32x16_bf16(kf[0],qr[0],C0,0,0,0), P0[2],P0[3],P0[4],P0[5],     pw0[0]=PKW(P0,0), pw0[1]=PKW(P0,2), pw0); \
    VRD(4); SBAR(); GAPA(C1=__builtin_amdgcn_mfma_f32_32x32x16_bf16(kf[1],qr[0],C1,0,0,0), P0[6],P0[7],P0[8],P0[9],     pw0[2]=PKW(P0,4), pw0[3]=PKW(P0,6), pw0); \
    VRD(1); SBAR(); GAPA(C0=__builtin_amdgcn_mfma_f32_32x32x16_bf16(kf[2],qr[1],C0,0,0,0),   P0[10],P0[11],P0[12],P0[13], pw1[0]=PKW(P0,8), pw1[1]=PKW(P0,10), pw1); \
    VRD(5); SBAR(); GAPA(C1=__builtin_amdgcn_mfma_f32_32x32x16_bf16(kf[3],qr[1],C1,0,0,0),   P0[14],P0[15],P1[0],P1[1],   pw1[2]=PKW(P0,12),pw1[3]=PKW(P0,14), pw1); \
    VRD(2); SBAR(); GAPA(C0=__builtin_amdgcn_mfma_f32_32x32x16_bf16(kf[4],qr[2],C0,0,0,0),   P1[2],P1[3],P1[4],P1[5],     pw2[0]=PKW(P1,0), pw2[1]=PKW(P1,2), pw2); \
    VRD(6); SBAR(); GAPA(C1=__builtin_amdgcn_mfma_f32_32x32x16_bf16(kf[5],qr[2],C1,0,0,0),   P1[6],P1[7],P1[8],P1[9],     pw2[2]=PKW(P1,4), pw2[3]=PKW(P1,6), pw2); \
    VRD(3); SBAR(); GAPA(C0=__builtin_amdgcn_mfma_f32_32x32x16_bf16(kf[6],qr[3],C0,0,0,0),   P1[10],P1[11],P1[12],P1[13], pw3[0]=PKW(P1,8), pw3[1]=PKW(P1,10), pw3); \
    VRD(7); SBAR(); GAPA(C1=__builtin_amdgcn_mfma_f32_32x32x16_bf16(kf[7],qr[3],C1,0,0,0),   P1[14],P1[15],0.f,0.f,       pw3[2]=PKW(P1,12),pw3[3]=PKW(P1,14), pw3); \
    l_reg+=sacc; \
    if(GK){DMA_K((t)+3,sl_cur);DMA_G((t)+3,(((t)+3)&3)*256);} if(GV){DMA_V((t)+1,sl_next);} \
    CMASK(C0,C1,t); \
    { float a=MX3(C0[0],C0[1],C1[0]),b=MX3(C0[2],C0[3],C1[1]); a=MX3(a,C1[2],C1[3]); \
      _Pragma("unroll") for(int r=4;r<16;r+=4){a=MX3(a,C0[r],C0[r+1]);b=MX3(b,C0[r+2],C0[r+3]);a=MX3(a,C1[r],C1[r+1]);b=MX3(b,C1[r+2],C1[r+3]);} \
      float rm=__builtin_fmaxf(a,b); { auto rr=__builtin_amdgcn_permlane32_swap(__float_as_uint(rm),__float_as_uint(rm),false,false); rm=__builtin_fmaxf(__uint_as_float(rr[0]),__uint_as_float(rr[1])); } \
      resc=false; \
      if(__builtin_expect(__any(rm>(float)THRL),0)){ const float dl=__builtin_fmaxf(rm,0.f); mhat+=dl; \
        _Pragma("unroll") for(int r=0;r<16;++r){C0[r]-=dl;C1[r]-=dl;} \
        const float f=__builtin_amdgcn_exp2f(-dl); l_reg*=f; if(hi==0)wsf[r32]=f; resc=true; } } \
    SBAR(); \
    GAPB(o[0]=__builtin_amdgcn_mfma_f32_32x32x16_bf16(PAF(0),VFR(0),o[0],0,0,0), C0,0); \
    GAPB(o[1]=__builtin_amdgcn_mfma_f32_32x32x16_bf16(PAF(0),VFR(4),o[1],0,0,0), C0,4); \
    KRD(GL,0); GAPB(o[0]=__builtin_amdgcn_mfma_f32_32x32x16_bf16(PAF(1),VFR(1),o[0],0,0,0), C0,8); \
    KRD(GL,1); GAPB(o[1]=__builtin_amdgcn_mfma_f32_32x32x16_bf16(PAF(1),VFR(5),o[1],0,0,0), C0,12); \
    KRD(GL,2); GAPB(o[0]=__builtin_amdgcn_mfma_f32_32x32x16_bf16(PAF(2),VFR(2),o[0],0,0,0), C1,0); \
    KRD(GL,3); GAPB(o[1]=__builtin_amdgcn_mfma_f32_32x32x16_bf16(PAF(2),VFR(6),o[1],0,0,0), C1,4); \
    GAPB(o[0]=__builtin_amdgcn_mfma_f32_32x32x16_bf16(PAF(3),VFR(3),o[0],0,0,0), C1,8); \
    GAPB(o[1]=__builtin_amdgcn_mfma_f32_32x32x16_bf16(PAF(3),VFR(7),o[1],0,0,0), C1,12); \
    if(GL){ CINIT(P0,P1,(((t)+1)&3)*256); } \
    }while(0)
  int t=1;
  #undef CMASK
  #define CMASK(P0,P1,t) do{}while(0)
  for(;t+5<NT;t+=2){
    STEP(pB0,pB1,pA0,pA1,t,true,true,true);     WAIT_BARG(2,3); RESC(); ROT();
    STEP(pA0,pA1,pB0,pB1,t+1,true,true,true);   WAIT_BARG(2,3); RESC(); ROT();
  }
  #undef CMASK
  #define CMASK(P0,P1,t) do{int jb_=(t)-(NT-4); if(jb_>=0)cmask(P0,P1,jb_,qrel,hi);}while(0)
  #define ENDW(tt) do{ if((tt)+3<NT){WAIT_BARG(2,3);} else if((tt)+2<NT){WAIT_BAR(1);} else {WAIT_BAR(0);} }while(0)
  for(;t+1<NT;t+=2){
    STEP(pB0,pB1,pA0,pA1,t,(t+3<NT),(t+1<NT),(t+1<NT));       ENDW(t);   RESC(); ROT();
    STEP(pA0,pA1,pB0,pB1,t+1,(t+4<NT),(t+2<NT),(t+2<NT));     ENDW(t+1); RESC(); ROT();
  }
  STEP(pB0,pB1,pA0,pA1,NT-1,false,false,false); RESC();
  { float sacc=pB0[0]+pB0[1]; _Pragma("unroll") for(int r=2;r<16;++r)sacc+=pB0[r]; _Pragma("unroll") for(int r=0;r<16;++r)sacc+=pB1[r]; l_reg+=sacc;
    pw0=(u32x4){PKW(pB0,0),PKW(pB0,2),PKW(pB0,4),PKW(pB0,6)};pw1=(u32x4){PKW(pB0,8),PKW(pB0,10),PKW(pB0,12),PKW(pB0,14)};pw2=(u32x4){PKW(pB1,0),PKW(pB1,2),PKW(pB1,4),PKW(pB1,6)};pw3=(u32x4){PKW(pB1,8),PKW(pB1,10),PKW(pB1,12),PKW(pB1,14)};
    SBAR(); pv(o,vb0+sl_cur,PAF(0),PAF(1),PAF(2),PAF(3)); }
  #undef PKW
  #undef PAF
  #undef VFR
  #undef PIN
  #undef MX3
  #undef GAPA
  #undef GAPB
  #undef EX
  #undef VRD
  #undef KRD
  #undef STEP
  #undef ENDW
  {auto rr=__builtin_amdgcn_permlane32_swap(__float_as_uint(l_reg),__float_as_uint(l_reg),false,false);l_reg=__uint_as_float(rr[0])+__uint_as_float(rr[1]);}
  if(hi==0)wsf[32+r32]=l_reg;asm volatile("s_waitcnt lgkmcnt(0)":::"memory");
  float rli[16];
  #pragma unroll
  for(int r=0;r<16;++r)rli[r]=__builtin_amdgcn_rcpf(wsf[32+crow(r,hi)]);
  { float*stg=(float*)(shm+LDS_OST)+wid*2048;
    #pragma unroll
    for(int r=0;r<16;++r){const int orow=crow(r,hi);
      #pragma unroll
      for(int d0=0;d0<2;++d0)stg[orow*64+d0*32+r32]=o[d0][r]*rli[r];}
    asm volatile("s_waitcnt lgkmcnt(0)":::"memory");
    bf16*Yw=Y+(rowbase+q0+wid*QBLK)*1024+512+h*D;
    #pragma unroll
    for(int i=0;i<4;++i){const int row=i*8+(lane>>3),ch=lane&7;
      const float4 a=*(const float4*)(stg+row*64+ch*8), c=*(const float4*)(stg+row*64+ch*8+4);
      float ss=(a.x*a.x+a.y*a.y)+(a.z*a.z+a.w*a.w)+(c.x*c.x+c.y*c.y)+(c.z*c.z+c.w*c.w);
      ss+=__shfl_xor(ss,1);ss+=__shfl_xor(ss,2);ss+=__shfl_xor(ss,4);
      const float rs=rsqrtf(ss*(1.f/64)+1e-6f);
      const float4 g0=*(const float4*)(out_g+h*64+ch*8), g1=*(const float4*)(out_g+h*64+ch*8+4);
      u32x4 w; w.x=cvtpk_s(a.x*rs*g0.x,a.y*rs*g0.y); w.y=cvtpk_s(a.z*rs*g0.z,a.w*rs*g0.w); w.z=cvtpk_s(c.x*rs*g1.x,c.y*rs*g1.y); w.w=cvtpk_s(c.z*rs*g1.z,c.w*rs*g1.w);
      ATTN_STORE16(Yw+(long)row*1024+ch*8,w);} }
  asm volatile("s_waitcnt lgkmcnt(0)\n\ts_barrier":::"memory");
  #undef DMA_K
  #undef DMA_V
  #undef DMA_G
  #undef WAIT_BARG
  #undef CINIT
  #undef CMASK
  #undef START
  #undef RESC
  #undef ROT
}
constexpr int ATTN_LDS_BYTES=LDS_BYTES;
#undef SBAR
#undef WAIT_BAR
}

namespace peer {
typedef short bf16x8 __attribute__((ext_vector_type(8)));
typedef float f32x16 __attribute__((ext_vector_type(16)));
__device__ __forceinline__ unsigned umax(unsigned a, unsigned b) { return a > b ? a : b; }
__device__ __forceinline__ unsigned umin(unsigned a, unsigned b) { return a < b ? a : b; }
__device__ __forceinline__ unsigned f2ord(float f) { const unsigned u = __float_as_uint(f); return u ^ ((u >> 31) ? 0xffffffffu : 0x80000000u); }
__device__ __forceinline__ float ord2f(unsigned k) { const unsigned u = k ^ ((k >> 31) ? 0x80000000u : 0xffffffffu); return __uint_as_float(u); }
__device__ __forceinline__ void sort16(unsigned* a) {
#define PEER_CE(i, j) { const unsigned hi_ = umax(a[i], a[j]), lo_ = umin(a[i], a[j]); a[i] = hi_; a[j] = lo_; }
    PEER_CE(0, 13) PEER_CE(1, 12) PEER_CE(2, 15) PEER_CE(3, 14) PEER_CE(4, 8) PEER_CE(5, 6) PEER_CE(7, 11) PEER_CE(9, 10)
    PEER_CE(0, 5) PEER_CE(1, 7) PEER_CE(2, 9) PEER_CE(3, 4) PEER_CE(6, 13) PEER_CE(8, 14) PEER_CE(10, 15) PEER_CE(11, 12)
    PEER_CE(0, 1) PEER_CE(2, 3) PEER_CE(4, 5) PEER_CE(6, 8) PEER_CE(7, 9) PEER_CE(10, 11) PEER_CE(12, 13) PEER_CE(14, 15)
    PEER_CE(0, 2) PEER_CE(1, 3) PEER_CE(4, 10) PEER_CE(5, 11) PEER_CE(6, 7) PEER_CE(8, 9) PEER_CE(12, 14) PEER_CE(13, 15)
    PEER_CE(1, 2) PEER_CE(3, 12) PEER_CE(4, 6) PEER_CE(5, 7) PEER_CE(8, 10) PEER_CE(9, 11) PEER_CE(13, 14)
    PEER_CE(1, 4) PEER_CE(2, 6) PEER_CE(5, 8) PEER_CE(7, 10) PEER_CE(9, 13) PEER_CE(11, 14)
    PEER_CE(2, 4) PEER_CE(3, 6) PEER_CE(9, 12) PEER_CE(11, 13)
    PEER_CE(3, 5) PEER_CE(6, 8) PEER_CE(7, 9) PEER_CE(10, 12)
    PEER_CE(3, 4) PEER_CE(5, 6) PEER_CE(7, 8) PEER_CE(9, 10) PEER_CE(11, 12)
    PEER_CE(6, 7) PEER_CE(8, 9)
#undef PEER_CE
}
__device__ __forceinline__ void merge16(unsigned* a) {
#pragma unroll
    for (int j = 8; j > 0; j >>= 1)
#pragma unroll
        for (int i = 0; i < 16; ++i) { const int l = i ^ j; if (l > i) { const unsigned hi_ = umax(a[i], a[l]), lo_ = umin(a[i], a[l]); a[i] = hi_; a[l] = lo_; } }
}
__device__ __forceinline__ void top16_of_two(unsigned* a, const unsigned* b) {
#pragma unroll
    for (int i = 0; i < 16; ++i) a[i] = umax(a[i], b[15 - i]);
    merge16(a);
}
__device__ __forceinline__ void top16_of_64(unsigned* k) {
    sort16(k); sort16(k + 16); sort16(k + 32); sort16(k + 48);
    top16_of_two(k, k + 16); top16_of_two(k + 32, k + 48); top16_of_two(k, k + 32);
}

constexpr int T_SUBK = 0, T_SCR = 65536;
__device__ __forceinline__ void topk256(int h, int t0, const bf16_t* QV, const bf16_t* SUBK, unsigned short* IDX, float* GATE, char* shm, bool stage) {
    const int lane = lane_id(), r32 = lane & 31, hi = lane >> 5; const int wid = wave_id(); const int tid = wid * 64 + lane;
    __syncthreads();
    if (stage) {
        const uint4* src = (const uint4*)(SUBK + (size_t)h * 2 * NKEYS * DHALF);
#pragma unroll
        for (int q = 0; q < 8; ++q) { const int ci = tid + q * NTHR, n = ci >> 4, ch = ci & 15;
            *(uint4*)(shm + T_SUBK + n * 256 + ((ch ^ (n & 15)) << 4)) = src[ci]; }
    }
    __syncthreads();
    unsigned* lsk = (unsigned*)(shm + T_SCR) + wid * 2048;
    const int tw = t0 + wid * 32;
#pragma unroll 1
    for (int p = 0; p < 2; ++p) {
        f32x16 acc[4]; acc[0] = f32x16{}; acc[1] = f32x16{}; acc[2] = f32x16{}; acc[3] = f32x16{};
        const bf16_t* qp = QV + (size_t)(tw + r32) * NQ + h * 256 + p * 128 + 8 * hi;
        bf16x8 bq[8];
#pragma unroll
        for (int ks = 0; ks < 8; ++ks) bq[ks] = *reinterpret_cast<const bf16x8*>(qp + 16 * ks);
        const char* kb = shm + T_SUBK + p * 32768 + r32 * 256;
#pragma unroll
        for (int ks = 0; ks < 8; ++ks) {
#pragma unroll
            for (int nb = 0; nb < 4; ++nb) { const bf16x8 ak = *reinterpret_cast<const bf16x8*>(kb + nb * 8192 + (((2 * ks + hi) ^ (r32 & 15)) << 4));
                acc[nb] = __builtin_amdgcn_mfma_f32_32x32x16_bf16(ak, bq[ks], acc[nb], 0, 0, 0); }
        }
        unsigned key[64];
#pragma unroll
        for (int nb = 0; nb < 4; ++nb)
#pragma unroll
            for (int r = 0; r < 16; ++r) { const int n = 32 * nb + (r & 3) + 8 * (r >> 2) + 4 * hi; key[16 * nb + r] = (f2ord(acc[nb][r]) & ~127u) | (unsigned)(127 - n); }
        top16_of_64(key);
        unsigned part[16];
#pragma unroll
        for (int i = 0; i < 16; ++i) part[i] = (unsigned)__shfl_xor((int)key[i], 32);
        top16_of_two(key, part);
#pragma unroll
        for (int i = 0; i < 16; ++i) lsk[(p * 16 + i) * 64 + lane] = key[i];
    }
    WAVE_LDS_FENCE();
    unsigned ck[32];
    {
        float s0h[8], s1[16];
#pragma unroll
        for (int i = 0; i < 8; ++i) s0h[i] = ord2f(lsk[(2 * i + hi) * 64 + lane] & ~127u);
#pragma unroll
        for (int i = 0; i < 16; ++i) s1[i] = ord2f(lsk[(16 + i) * 64 + lane] & ~127u);
        int n = 0;
#pragma unroll
        for (int ah = 0; ah < 8; ++ah)
#pragma unroll
            for (int b = 0; b < 16; ++b) if ((2 * ah + 1) * (b + 1) <= 16) { ck[n] = (f2ord(s0h[ah] + s1[b]) & ~255u) | (unsigned)(255 - ((2 * ah + hi) * 16 + b)); ++n; }
        ck[30] = 0u; ck[31] = 0u;
    }
    sort16(ck); sort16(ck + 16); top16_of_two(ck, ck + 16);
    {
        unsigned part[16];
#pragma unroll
        for (int i = 0; i < 16; ++i) part[i] = (unsigned)__shfl_xor((int)ck[i], 32);
        top16_of_two(ck, part);
    }
    float sc[16]; float sum = 0.f;
#pragma unroll
    for (int i = 0; i < 16; ++i) { sc[i] = ord2f(ck[i] & ~255u); }
    const float mx = sc[0];
#pragma unroll
    for (int i = 0; i < 16; ++i) { sc[i] = __expf(sc[i] - mx); sum += sc[i]; }
    const float inv = 1.0f / sum;
    unsigned short* gidx = IDX + (size_t)(tw + r32) * 128 + 2 * h + hi; float* ggate = GATE + (size_t)(tw + r32) * 128 + h * 16 + 8 * hi;
    int oi[8]; float og[8];
#pragma unroll
    for (int i = 0; i < 16; ++i) {
        const int pos = 255 - (int)(ck[i] & 255u), ia = 127 - (int)(lsk[(pos >> 4) * 64 + lane] & 127u), ib = 127 - (int)(lsk[(16 + (pos & 15)) * 64 + lane] & 127u);
        if ((i >> 3) == 0) { if (hi == 0) { oi[i & 7] = ia * NKEYS + ib; og[i & 7] = sc[i] * inv; } }
        else { if (hi == 1) { oi[i & 7] = ia * NKEYS + ib; og[i & 7] = sc[i] * inv; } }
    }
#pragma unroll
    for (int e = 0; e < 8; ++e) gidx[16 * e] = (unsigned short)oi[e];
    *(float4*)ggate = make_float4(og[0], og[1], og[2], og[3]); *(float4*)(ggate + 4) = make_float4(og[4], og[5], og[6], og[7]);
    WAVE_LDS_FENCE();
}

__device__ __forceinline__ float gelu_as(float v) {
    const float av = fabsf(v), t = __builtin_amdgcn_rcpf(av * 0.2316418882f + 1.0f);
    float q = t * 0.5307027145f + (-0.7265760135f); q = q * t + 0.7107068705f; q = q * t + (-0.142248368f); q = q * t + 0.127414796f; q = q * t;
    const float e = __builtin_amdgcn_exp2f((v * v) * (-0.72134752044f));
    const float m = v * (q * e);
    return v < 0.f ? m : v - m;
}
typedef float f32x2 __attribute__((ext_vector_type(2)));
#ifndef TAB_U4
#define TAB_U4 1
#endif
#ifndef TAB_V4
#define TAB_V4 1
#endif
constexpr bool U4 = TAB_U4 != 0, V4 = TAB_V4 != 0;
constexpr float U_SCALE = U4 ? 64.f : 256.f, V_SCALE = V4 ? 5.65685425f : 16.f;
constexpr size_t SLICE_BYTES = (size_t)NEXP * 128;
__device__ __forceinline__ uint4 ld16_sc1(const void* p) { uint4 r; asm volatile("global_load_dwordx4 %0, %1, off sc1\n\ts_waitcnt vmcnt(0)" : "=&v"(r) : "v"(p) : "memory"); return r; }
}


namespace peer {
typedef int v8i __attribute__((ext_vector_type(8)));
typedef int v4i __attribute__((ext_vector_type(4)));
typedef int v2i __attribute__((ext_vector_type(2)));
typedef float v4f __attribute__((ext_vector_type(4)));
constexpr int G_RING = 0, G_WA = 133120, G_IDXB = G_WA + 16384, G_ZERO = G_IDXB + 2048, G_END = G_ZERO + 64;
constexpr int ONE_E8M0 = 0x7f7f7f7f;
constexpr float XS = 16.f, WSC = 32.f, LO = 16.f;

__device__ __forceinline__ void dma16s(unsigned voff, const void* sbase, unsigned ldsdst) {
    unsigned keep;
    asm volatile("s_mov_b32 %0, m0\n\ts_mov_b32 m0, %3\n\ts_nop 0\n\tglobal_load_lds_dwordx4 %1, %2\n\ts_mov_b32 m0, %0" : "=&s"(keep) : "v"(voff), "s"(sbase), "s"(ldsdst) : "memory");
}
__device__ __forceinline__ void dma4s(unsigned voff, const void* sbase, unsigned ldsdst) {
    unsigned keep;
    asm volatile("s_mov_b32 %0, m0\n\ts_mov_b32 m0, %3\n\ts_nop 0\n\tglobal_load_lds_dword %1, %2\n\ts_mov_b32 m0, %0" : "=&s"(keep) : "v"(voff), "s"(sbase), "s"(ldsdst) : "memory");
}
__device__ __forceinline__ int pk4_fp8(float a, float b, float c, float d) { int w = __builtin_amdgcn_cvt_pk_fp8_f32(a, b, 0, false); return __builtin_amdgcn_cvt_pk_fp8_f32(c, d, w, true); }
__device__ __forceinline__ float clamp_fp8(float v) { return __builtin_amdgcn_fmed3f(v, -448.f, 448.f); }
__device__ __forceinline__ void split4_fp8(float a, float b, float c, float d, int& hi, int& lo) {
    a = clamp_fp8(a); b = clamp_fp8(b); c = clamp_fp8(c); d = clamp_fp8(d);
    hi = pk4_fp8(a, b, c, d);
    const f32x2 h01 = __builtin_amdgcn_cvt_pk_f32_fp8(hi, false), h23 = __builtin_amdgcn_cvt_pk_f32_fp8(hi, true);
    lo = pk4_fp8((a - h01[0]) * LO, (b - h01[1]) * LO, (c - h23[0]) * LO, (d - h23[1]) * LO);
}
__device__ __forceinline__ unsigned sgpr(unsigned v) { return (unsigned)__builtin_amdgcn_readfirstlane((int)v); }
__device__ __forceinline__ const unsigned char* sgpr_ptr(const void* p) { const unsigned long long v = (unsigned long long)p; const unsigned lo = sgpr((unsigned)v), hi = sgpr((unsigned)(v >> 32)); return (const unsigned char*)(((unsigned long long)hi << 32) | lo); }
#define LDS_V4I(addr) (*(const LAS v4i*)(unsigned)(addr))
__device__ __forceinline__ v2i tr4(unsigned addr) { return __builtin_amdgcn_ds_read_tr4_b64_v2i32((LAS v2i*)(unsigned)addr); }
__device__ __forceinline__ v2i tr8(unsigned addr) { return __builtin_amdgcn_ds_read_tr8_b64_v2i32((LAS v2i*)(unsigned)addr); }

#define ISSUE8(BASE, SLOT, W, XC) do { asm volatile("s_waitcnt lgkmcnt(0)" ::: "memory");     \
        _Pragma("unroll") for (int jj = 0; jj < 8; ++jj) { const unsigned w_ = (unsigned)(W)[jj >> 1]; const unsigned e_ = (jj & 1) ? (w_ >> 16) : (w_ & 0xffffu); \
        dma16s((e_ << 7) + ((XC) ? c1 : c0), (BASE), (SLOT) + 1024u * jj); } } while (0)


template <bool UF4, bool VF4>
__device__ __forceinline__ void gather_mx(int t0w, const bf16_t* XG, const float* SSQ, const float* ADA, const unsigned char* EU, const unsigned char* EV,
                                          const unsigned short* IDXT, const float* GATE, const float* final_g, const float* norm2_g, float* out) {
    int lane = lane_id(); int wid = wave_id();
    t0w = __builtin_amdgcn_readfirstlane(t0w);
    asm volatile("" : "+v"(lane), "+s"(wid), "+s"(t0w));
    const int n = lane & 15, kc = lane >> 4, g = lane >> 3, q = lane & 7;
    const int b = t0w / SEQ;
    const unsigned ring = (unsigned)(G_RING + wid * 16384), idxb = (unsigned)(G_IDXB + wid * 256), wa = (unsigned)(G_WA + wid * 2048);
    if (lane < 16) *(LAS unsigned*)(unsigned)(G_ZERO + 4 * lane) = 0u;
    const unsigned c0 = (unsigned)(16 * (q ^ (g >> 1))), c1 = c0 ^ 64u;
    const unsigned char* idxrow = sgpr_ptr(IDXT + (size_t)t0w * 128);
    const unsigned ring_s = sgpr((unsigned)(G_RING + wid * 16384)), idxb_s = sgpr((unsigned)(G_IDXB + wid * 256));
    v4f acc[8];
    {
        v8i AX[8];
        {
            const int ti = n >> 1; const bool lo = (n & 1) != 0;
            const float4 s4 = *(const float4*)(SSQ + (size_t)(t0w + ti) * 4);
            const float rsx = rsqrtf(((s4.x + s4.y) + (s4.z + s4.w)) * (1.f / DM) + EPS) * XS;
            const int cA = UF4 ? 16 * kc : 32 * kc, cB = UF4 ? 64 + 16 * kc : 32 * kc + 16;
            const bf16_t* xr = XG + (size_t)(t0w + ti) * DM; const float* shp = ADA + b * 6 * DM + 3 * DM;
#define AX_LOAD(XW, S0, S1, SB) do { _Pragma("unroll") for (int k = 0; k < 4; ++k) { const int co = 128 * (SB) + ((k < 2) ? cA + 8 * k : cB + 8 * (k - 2)); \
                XW[k] = *(const uint4*)(xr + co); S0[k] = *(const float4*)(shp + co); S1[k] = *(const float4*)(shp + co + 4); } } while (0)
            uint4 xa[4]; float4 s0a[4], s1a[4];
            AX_LOAD(xa, s0a, s1a, 0);
#pragma unroll 1
            for (int sb = 0; sb < 8; ++sb) {
                uint4 xb[4]; float4 s0b[4], s1b[4];
                AX_LOAD(xb, s0b, s1b, (sb + 1) & 7);
                v8i ax;
#pragma unroll
                for (int k = 0; k < 4; ++k) {
                    const uint4 xw = xa[k]; const float4 s0 = s0a[k], s1 = s1a[k];
                    const float v0 = __uint_as_float(xw.x << 16) * rsx + s0.x * XS, v1 = __uint_as_float(xw.x & 0xffff0000u) * rsx + s0.y * XS;
                    const float v2 = __uint_as_float(xw.y << 16) * rsx + s0.z * XS, v3 = __uint_as_float(xw.y & 0xffff0000u) * rsx + s0.w * XS;
                    const float v4 = __uint_as_float(xw.z << 16) * rsx + s1.x * XS, v5 = __uint_as_float(xw.z & 0xffff0000u) * rsx + s1.y * XS;
                    const float v6 = __uint_as_float(xw.w << 16) * rsx + s1.z * XS, v7 = __uint_as_float(xw.w & 0xffff0000u) * rsx + s1.w * XS;
                    int h0, l0, h1, l1; split4_fp8(v0, v1, v2, v3, h0, l0); split4_fp8(v4, v5, v6, v7, h1, l1);
                    ax[2 * k] = lo ? l0 : h0; ax[2 * k + 1] = lo ? l1 : h1;
                }
                *(LAS v4i*)(unsigned)(ring + sb * 2048 + lane * 32) = (v4i){ax[0], ax[1], ax[2], ax[3]};
                *(LAS v4i*)(unsigned)(ring + sb * 2048 + lane * 32 + 16) = (v4i){ax[4], ax[5], ax[6], ax[7]};
#pragma unroll
                for (int k = 0; k < 4; ++k) { xa[k] = xb[k]; s0a[k] = s0b[k]; s1a[k] = s1b[k]; }
            }
#undef AX_LOAD
            WAVE_LDS_FENCE();
#pragma unroll
            for (int sb = 0; sb < 8; ++sb) { const v4i a0 = LDS_V4I(ring + sb * 2048 + lane * 32), a1 = LDS_V4I(ring + sb * 2048 + lane * 32 + 16); AX[sb] = (v8i){a0.x, a0.y, a0.z, a0.w, a1.x, a1.y, a1.z, a1.w}; }
            WAVE_LDS_FENCE();
        }
#pragma unroll
        for (int m = 0; m < 8; ++m) acc[m] = (v4f){0.f, 0.f, 0.f, 0.f};
        const unsigned aU0 = ring + (unsigned)(n * 128 + 16 * (kc ^ (n >> 1))), aU1 = aU0 ^ 64u;
        v4i ia, ib;
        dma4s(4u * lane, idxrow, idxb_s);
        asm volatile("s_waitcnt vmcnt(0)" ::: "memory");
        ia = LDS_V4I(idxb + 32 * g); ib = LDS_V4I(idxb + 32 * g + 16);
        ISSUE8(sgpr_ptr(EU), ring_s, ia, (jj & 1));
#pragma unroll
        for (int sl = 0; sl < (UF4 ? 4 : 8); ++sl) {
            const unsigned char* Ub = sgpr_ptr(EU + (size_t)sl * SLICE_BYTES); const unsigned char* Un = sgpr_ptr(EU + (size_t)((sl + 1) & (UF4 ? 3 : 7)) * SLICE_BYTES);
#pragma unroll 1
            for (int i = 0; i < 8; ++i) {
                dma4s(4u * lane, idxrow + ((i + 1) & 7) * 256, idxb_s);
                ISSUE8(Ub, ring_s + 8192u, ib, (jj & 1));
                asm volatile("s_waitcnt vmcnt(8)" ::: "memory");
                v8i A, A2;
                { const bool mine = (n >> 1) == i;
#pragma unroll
                  for (int k = 0; k < 8; ++k) { A[k] = mine ? AX[UF4 ? 2 * sl : sl][k] : 0; A2[k] = (UF4 && mine) ? AX[UF4 ? 2 * sl + 1 : 0][k] : 0; } }
#define U_MFMA(ACC, B0, B1) do { if (UF4) { const v8i Ba_ = {B0.x, B0.y, B0.z, B0.w, 0, 0, 0, 0}, Bb_ = {B1.x, B1.y, B1.z, B1.w, 0, 0, 0, 0}; \
            ACC = __builtin_amdgcn_mfma_scale_f32_16x16x128_f8f6f4(A, Ba_, ACC, 0, 4, 0, ONE_E8M0, 0, ONE_E8M0); ACC = __builtin_amdgcn_mfma_scale_f32_16x16x128_f8f6f4(A2, Bb_, ACC, 0, 4, 0, ONE_E8M0, 0, ONE_E8M0); } \
        else { const v8i B_ = {B0.x, B0.y, B0.z, B0.w, B1.x, B1.y, B1.z, B1.w}; ACC = __builtin_amdgcn_mfma_scale_f32_16x16x128_f8f6f4(A, B_, ACC, 0, 0, 0, 0, 0, 0); } } while (0)
#pragma unroll
                for (int m = 0; m < 4; ++m) { const v4i b0 = LDS_V4I(aU0 + 2048 * m), b1 = LDS_V4I(aU1 + 2048 * m); U_MFMA(acc[m], b0, b1); }
                ia = LDS_V4I(idxb + 32 * g); ib = LDS_V4I(idxb + 32 * g + 16);
                { const unsigned char* Ux = (i == 7) ? Un : Ub; ISSUE8(Ux, ring_s, ia, (jj & 1)); }
                asm volatile("s_waitcnt vmcnt(8)" ::: "memory");
#pragma unroll
                for (int m = 0; m < 4; ++m) { const v4i b0 = LDS_V4I(aU0 + 8192 + 2048 * m), b1 = LDS_V4I(aU1 + 8192 + 2048 * m); U_MFMA(acc[4 + m], b0, b1); }
#undef U_MFMA
            }
        }
        asm volatile("s_waitcnt vmcnt(0)" ::: "memory");
    }
    asm volatile("" : "+v"(lane) :: "memory");
    {
        const int n2 = lane & 15, rg = lane >> 4;
#pragma unroll
        for (int tt = 0; tt < 2; ++tt) {
            const int ti = 2 * rg + tt; const float* gp = GATE + (size_t)(t0w + ti) * 128 + n2;
#pragma unroll
            for (int m = 0; m < 8; ++m) {
                const float a = (acc[m][2 * tt] + acc[m][2 * tt + 1] * (1.f / LO)) * (1.f / (XS * U_SCALE));
                const float w = clamp_fp8(gp[16 * m] * gelu_as(a) * WSC);
                const int hi = __builtin_amdgcn_cvt_pk_fp8_f32(w, w, 0, false);
                const float wh = __builtin_amdgcn_cvt_pk_f32_fp8(hi, false)[0];
                const int lo = __builtin_amdgcn_cvt_pk_fp8_f32((w - wh) * LO, 0.f, 0, false);
                *(LAS unsigned char*)(unsigned)(wa + (2 * ti) * 128 + 16 * m + n2) = (unsigned char)(hi & 0xff);
                *(LAS unsigned char*)(unsigned)(wa + (2 * ti + 1) * 128 + 16 * m + n2) = (unsigned char)(lo & 0xff);
            }
        }
    }
    WAVE_LDS_FENCE();
    asm volatile("" : "+v"(lane) :: "memory");
    float ss0 = 0.f, ss1 = 0.f;
    constexpr int NSPILL = VF4 ? 0 : 2;
    uint2 X2K[((VF4 ? 4 : 8) - NSPILL) * 2 * (VF4 ? 4 : 2)];
    {
        constexpr int NSV = VF4 ? 4 : 8, NCB = VF4 ? 16 : 8, SLW = VF4 ? 256 : 128;
        const int n2 = lane & 15, kc2 = lane >> 4, kk = kc2 & 1, g2 = lane >> 3;
        unsigned tV[8];
#pragma unroll
        for (int c = 0; c < 8; ++c) tV[c] = VF4 ? ring + (unsigned)((32 * (kc2 >> 1) + n2) * 128 + 16 * (c ^ (n2 >> 1)))
                                                : ring + (unsigned)((32 * kk + (n2 >> 1)) * 128 + 8 * (n2 & 1) + 16 * (c ^ ((n2 >> 2) ^ (4 * kk))));
        const unsigned aW = VF4 ? wa + (unsigned)(n2 * 128 + 16 * kc2) : wa + (unsigned)(n2 * 128 + 32 * kk);
        v4i ia, ib;
        dma4s(4u * lane, idxrow, idxb_s);
        asm volatile("s_waitcnt vmcnt(0)" ::: "memory");
        ia = LDS_V4I(idxb + 32 * g2); ib = LDS_V4I(idxb + 32 * g2 + 16);
#define VXC (VF4 ? (jj & 1) : (jj >= 4))
        ISSUE8(sgpr_ptr(EV), ring_s, ia, VXC);
        const float* gate2 = ADA + b * 6 * DM + 5 * DM + 4 * n2;
        float* orow = out + (size_t)(t0w + 2 * kc2) * DM + 4 * n2; const bf16_t* xgrow = XG + (size_t)(t0w + 2 * kc2) * DM + 4 * n2;
#define V_CONSUME(SLOTOFF) do { _Pragma("unroll") for (int cb = 0; cb < NCB; ++cb) { \
            if (VF4) { const v2i b0 = tr4(tV[cb >> 1] + 8 * (cb & 1) + (SLOTOFF)), b1 = tr4(tV[cb >> 1] + 8 * (cb & 1) + (SLOTOFF) + 2048); \
                const v8i B = {b0.x, b0.y, b1.x, b1.y, 0, 0, 0, 0}; C[cb] = __builtin_amdgcn_mfma_scale_f32_16x16x128_f8f6f4(A, B, C[cb], 0, 4, 0, ONE_E8M0, 0, ONE_E8M0); } \
            else { const v2i b0 = tr8(tV[cb & 7] + (SLOTOFF)), b1 = tr8(tV[cb & 7] + (SLOTOFF) + 1024), b2 = tr8(tV[cb & 7] + (SLOTOFF) + 2048), b3 = tr8(tV[cb & 7] + (SLOTOFF) + 3072); \
                const v8i B = {b0.x, b0.y, b1.x, b1.y, b2.x, b2.y, b3.x, b3.y}; C[cb] = __builtin_amdgcn_mfma_scale_f32_16x16x128_f8f6f4(A, B, C[cb], 0, 0, 0, 0, 0, 0); } \
            if ((cb & 1) == 1) __builtin_amdgcn_sched_barrier(0);     } } while (0)
#pragma unroll 1
        for (int sl = 0; sl < NSV; ++sl) {
            const unsigned char* Vb = sgpr_ptr(EV + (size_t)sl * SLICE_BYTES); const unsigned char* Vn = sgpr_ptr(EV + (size_t)((sl + 1) & (NSV - 1)) * SLICE_BYTES);
            v4f C[NCB];
#pragma unroll
            for (int cb = 0; cb < NCB; ++cb) C[cb] = (v4f){0.f, 0.f, 0.f, 0.f};
#pragma unroll 1
            for (int i = 0; i < 8; ++i) {
                const bool mine = ((n2 >> 1) == i) && (kc2 < 2);
                const unsigned aA = mine ? aW : (unsigned)G_ZERO;
                dma4s(4u * lane, idxrow + ((i + 1) & 7) * 256, idxb_s);
                ISSUE8(Vb, ring_s + 8192u, ib, VXC);
                asm volatile("s_waitcnt vmcnt(8)" ::: "memory");
                { const v4i a0 = LDS_V4I(aA), a1 = LDS_V4I(aA + (VF4 ? 32 : 16)); const v8i A = {a0.x, a0.y, a0.z, a0.w, a1.x, a1.y, a1.z, a1.w};
                  V_CONSUME(0); }
                ia = LDS_V4I(idxb + 32 * g2); ib = LDS_V4I(idxb + 32 * g2 + 16);
                { const unsigned char* Vx = (i == 7) ? Vn : Vb; ISSUE8(Vx, ring_s, ia, VXC); }
                asm volatile("s_waitcnt vmcnt(8)" ::: "memory");
                { const v4i a0 = LDS_V4I(aA + (mine ? 64 : 0)), a1 = LDS_V4I(aA + (mine ? (VF4 ? 96 : 80) : (VF4 ? 32 : 16))); const v8i A = {a0.x, a0.y, a0.z, a0.w, a1.x, a1.y, a1.z, a1.w};
                  V_CONSUME(8192); }
            }
#pragma unroll
            for (int tt = 0; tt < 2; ++tt)
#pragma unroll
                for (int cg = 0; cg < NCB / 4; ++cg) {
                    float* p = orow + (size_t)tt * DM + SLW * sl + 64 * cg;
                    const uint2 xw = *(const uint2*)(xgrow + (size_t)tt * DM + SLW * sl + 64 * cg);
                    const float4 gn = *(const float4*)(norm2_g + 4 * n2 + SLW * sl + 64 * cg), s2 = *(const float4*)(gate2 - DM + SLW * sl + 64 * cg);
                    float4 x1; x1.x = __uint_as_float(xw.x << 16) * __builtin_amdgcn_rcpf(gn.x * (1.f + s2.x)); x1.y = __uint_as_float(xw.x & 0xffff0000u) * __builtin_amdgcn_rcpf(gn.y * (1.f + s2.y));
                    x1.z = __uint_as_float(xw.y << 16) * __builtin_amdgcn_rcpf(gn.z * (1.f + s2.z)); x1.w = __uint_as_float(xw.y & 0xffff0000u) * __builtin_amdgcn_rcpf(gn.w * (1.f + s2.w));
                    const float4 gt = *(const float4*)(gate2 + SLW * sl + 64 * cg);
                    constexpr float SC = 1.f / (WSC * V_SCALE);
                    float4 x2;
                    x2.x = x1.x + gt.x * ((C[4 * cg + 0][2 * tt] + C[4 * cg + 0][2 * tt + 1] * (1.f / LO)) * SC);
                    x2.y = x1.y + gt.y * ((C[4 * cg + 1][2 * tt] + C[4 * cg + 1][2 * tt + 1] * (1.f / LO)) * SC);
                    x2.z = x1.z + gt.z * ((C[4 * cg + 2][2 * tt] + C[4 * cg + 2][2 * tt + 1] * (1.f / LO)) * SC);
                    x2.w = x1.w + gt.w * ((C[4 * cg + 3][2 * tt] + C[4 * cg + 3][2 * tt + 1] * (1.f / LO)) * SC);
                    const float sq = (x2.x * x2.x + x2.y * x2.y) + (x2.z * x2.z + x2.w * x2.w);
                    if (tt == 0) ss0 += sq; else ss1 += sq;
                    const uint2 pk = make_uint2(pg8::cvt_pk_bf16(x2.x, x2.y), pg8::cvt_pk_bf16(x2.z, x2.w));
                    if (sl < NSPILL) *(float4*)p = x2;
#pragma unroll
                    for (int k = NSPILL; k < NSV; ++k) if (sl == k) X2K[((k - NSPILL) * 2 + tt) * (NCB / 4) + cg] = pk;
                    if (cg & 1) __builtin_amdgcn_sched_barrier(0);
                }
        }
#undef V_CONSUME
#undef VXC
        asm volatile("s_waitcnt vmcnt(0)" ::: "memory");
    }
#pragma unroll
    for (int o = 1; o < 16; o <<= 1) { ss0 += __shfl_xor(ss0, o); ss1 += __shfl_xor(ss1, o); }
    asm volatile("" : "+v"(lane) :: "memory");
    {
        constexpr int NSV = VF4 ? 4 : 8, NCG = VF4 ? 4 : 2, SLW = VF4 ? 256 : 128;
        const int n2 = lane & 15, rg = lane >> 4;
        const float r0 = rsqrtf(ss0 * (1.f / DM) + EPS), r1 = rsqrtf(ss1 * (1.f / DM) + EPS);
        float* orow = out + (size_t)(t0w + 2 * rg) * DM + 4 * n2; const float* fgp = final_g + 4 * n2;
#pragma unroll
        for (int sl = 0; sl < NSV; ++sl)
#pragma unroll
            for (int cg = 0; cg < NCG; ++cg) {
                const float4 fg = *(const float4*)(fgp + SLW * sl + 64 * cg);
#pragma unroll
                for (int tt = 0; tt < 2; ++tt) {
                    const float rs = tt ? r1 : r0; float4 o; float* p = orow + (size_t)tt * DM + SLW * sl + 64 * cg;
                    if (sl >= NSPILL) { const uint2 w = X2K[((sl - NSPILL) * 2 + tt) * NCG + cg];
                        o.x = __uint_as_float(w.x << 16) * rs * fg.x; o.y = __uint_as_float(w.x & 0xffff0000u) * rs * fg.y;
                        o.z = __uint_as_float(w.y << 16) * rs * fg.z; o.w = __uint_as_float(w.y & 0xffff0000u) * rs * fg.w; }
                    else { const uint4 raw = ld16_sc1(p);
                        o.x = __uint_as_float(raw.x) * rs * fg.x; o.y = __uint_as_float(raw.y) * rs * fg.y; o.z = __uint_as_float(raw.z) * rs * fg.z; o.w = __uint_as_float(raw.w) * rs * fg.w; }
                    __builtin_nontemporal_store((pg8::f32x4){o.x, o.y, o.z, o.w}, (pg8::f32x4*)p);
                }
            }
    }
    WAVE_LDS_FENCE();
}
}

using pg8::bf16x8; using pg8::f32x4;
#define XB_TMO      128
#define XB_XCNT(j)  (256  + 64 * (j))
#define XB_XSUB(j)  (1280 + 64 * (j))
#define XB_XGEN(j)  (2304 + 64 * (j))
#define XB_TOP      3328
#define XB_TOPGEN   3392
#define XCD_BAR_WORDS 3456
#define XB_SPIN_CAP (1u << 18)
__device__ __forceinline__ unsigned xb_ld(unsigned* p)              { return __hip_atomic_load(p, __ATOMIC_RELAXED, __HIP_MEMORY_SCOPE_AGENT); }
__device__ __forceinline__ unsigned xb_add(unsigned* p, unsigned v) { return __hip_atomic_fetch_add(p, v, __ATOMIC_RELAXED, __HIP_MEMORY_SCOPE_AGENT); }
__device__ __forceinline__ unsigned xb_xcc_id() { return (unsigned)__builtin_amdgcn_s_getreg((3 << 11) | 20) & 0xFu; }
#define XB_SPIN(cond, bar) do { unsigned _sp = 0; while (cond) { __builtin_amdgcn_s_sleep(1); \
    if ((++_sp & 255u) == 0u) { if (xb_ld(&(bar)[XB_TMO])) break; if (_sp > XB_SPIN_CAP) { atomicAdd(&(bar)[XB_TMO], 1u); break; } } } } while (0)
struct XcdBarrier { unsigned* bar; unsigned x; volatile LAS unsigned* st; };
__device__ __forceinline__ XcdBarrier xcd_barrier_post(unsigned* bar, volatile LAS unsigned* st) {
    XcdBarrier b; b.bar = bar; b.x = xb_xcc_id(); b.st = st;
    if (TIDX == 0) (void)xb_add(&bar[XB_XCNT(b.x)], 1u);
    return b;
}
__device__ __forceinline__ void xcd_barrier_complete(unsigned* bar, unsigned x, unsigned& nloc, unsigned& nx) {
    const unsigned G = gridDim.x * gridDim.y * gridDim.z;
    unsigned sum, cnt, mine, sp = 0u;
    for (;;) {
        sum = 0u; cnt = 0u; mine = 0u;
#pragma unroll
        for (unsigned j = 0; j < 16; ++j) { const unsigned c = xb_ld(&bar[XB_XCNT(j)]); sum += c; cnt += (c > 0u) ? 1u : 0u; mine = (j == x) ? c : mine; }
        if (sum == G) break;
        __builtin_amdgcn_s_sleep(1);
        if ((++sp & 255u) == 0u) { if (xb_ld(&bar[XB_TMO])) break; if (sp > XB_SPIN_CAP) { atomicAdd(&bar[XB_TMO], 1u); break; } }
    }
    nloc = mine > 0u ? mine : 1u; nx = cnt > 0u ? cnt : 1u;
}
__device__ __forceinline__ void xcd_barrier(const XcdBarrier& b) {
    asm volatile("s_waitcnt vmcnt(0)" ::: "memory");
    __syncthreads();
    if (TIDX == 0) {
        unsigned* bar = b.bar;
        __builtin_amdgcn_s_waitcnt(0);
        unsigned nloc = b.st[0], nx = b.st[1];
        if (nloc == 0u) { xcd_barrier_complete(bar, b.x, nloc, nx); b.st[0] = nloc; b.st[1] = nx; }
        const unsigned old = xb_add(&bar[XB_XSUB(b.x)], 1u);
        const unsigned gen = old / nloc;
        if (old + 1u == (gen + 1u) * nloc) {
            __builtin_amdgcn_fence(__ATOMIC_RELEASE, "agent");
            asm volatile("s_waitcnt vmcnt(0)" ::: "memory");
            const unsigned og = xb_add(&bar[XB_TOP], 1u);
            const unsigned tg = og / nx;
            if (og + 1u == (tg + 1u) * nx) xb_add(&bar[XB_TOPGEN], 1u);
            else XB_SPIN(xb_ld(&bar[XB_TOPGEN]) == tg, bar);
            __builtin_amdgcn_fence(__ATOMIC_ACQUIRE, "agent");
            xb_add(&bar[XB_XGEN(b.x)], 1u);
            asm volatile("s_waitcnt vmcnt(0)" ::: "memory");
        } else {
            XB_SPIN(xb_ld(&bar[XB_XGEN(b.x)]) == gen, bar);
            __builtin_amdgcn_fence(__ATOMIC_ACQUIRE, "agent");
            asm volatile("s_waitcnt vmcnt(0)" ::: "memory");
        }
    }
    __syncthreads();
}
__device__ unsigned g_bar[XCD_BAR_WORDS + 64];
constexpr int LDS_BYTES = 155648, LDSCTL_OFF = 131072, MISC_OFF = LDSCTL_OFF + 320;

__device__ __forceinline__ void gemv8_task(float* lds, const float* W, int ldw, int n0, const float* bias, float* out, int ldo, int tid) {
    const int wave = tid >> 6, lane = tid & 63;
    float acc[8];
#pragma unroll
    for (int b = 0; b < 8; ++b) acc[b] = 0.f;
    const float* wp = W + (size_t)(wave * 128) * ldw + n0 + lane;
    const float* As = lds + wave * 128;
#pragma unroll 1
    for (int k = 0; k < 128; k += 16) {
        float wv[16];
#pragma unroll
        for (int i = 0; i < 16; ++i) wv[i] = wp[(size_t)(k + i) * ldw];
#pragma unroll
        for (int i = 0; i < 16; ++i)
#pragma unroll
            for (int b = 0; b < 8; ++b) acc[b] = fmaf(As[b * 1024 + k + i], wv[i], acc[b]);
    }
    float* red = lds + 8192;
#pragma unroll
    for (int b = 0; b < 8; ++b) red[(wave * 8 + b) * 64 + lane] = acc[b];
    __syncthreads();
    { const int b = tid >> 6; float s = 0.f;
#pragma unroll
      for (int w = 0; w < 8; ++w) s += red[(w * 8 + b) * 64 + lane];
      out[b * ldo + n0 + lane] = s + (bias ? bias[n0 + lane] : 0.f); }
    __syncthreads();
}
__device__ __forceinline__ void gemv8_task32(float* lds, const float* W, int ldw, int n0, const float* bias, float* out, int ldo, int tid) {
    const int wave = tid >> 6, lane = tid & 63, col = lane & 31, kh = lane >> 5;
    float acc[8];
#pragma unroll
    for (int b = 0; b < 8; ++b) acc[b] = 0.f;
    const int kbase = wave * 128 + kh * 64;
    const float* wp = W + (size_t)kbase * ldw + n0 + col;
    const float* As = lds + kbase;
#pragma unroll 1
    for (int k = 0; k < 64; k += 16) {
        float wv[16];
#pragma unroll
        for (int i = 0; i < 16; ++i) wv[i] = __builtin_nontemporal_load(wp + (size_t)(k + i) * ldw);
#pragma unroll
        for (int i = 0; i < 16; ++i)
#pragma unroll
            for (int b = 0; b < 8; ++b) acc[b] = fmaf(As[b * 1024 + k + i], wv[i], acc[b]);
    }
    float* red = lds + 8192;
#pragma unroll
    for (int b = 0; b < 8; ++b) { acc[b] += __shfl_xor(acc[b], 32); if (kh == 0) red[(wave * 8 + b) * 32 + col] = acc[b]; }
    __syncthreads();
    if (tid < 256) { const int b = tid >> 5, c = tid & 31; float s = 0.f;
#pragma unroll
      for (int w = 0; w < 8; ++w) s += red[(w * 8 + b) * 32 + c];
      out[b * ldo + n0 + c] = s + (bias ? bias[n0 + c] : 0.f); }
    __syncthreads();
}
__device__ __forceinline__ void transpose_item(const float* W, int K, int ldw, int nblk, bf16_t* WT, float* scr, int item, int lane) {
    const int kb = item / nblk, nb = item % nblk, k0 = 64 * kb, n0 = 32 * nb;
#pragma unroll 8
    for (int i = 0; i < 32; ++i) { const int kk = 2 * i + (lane >> 5); scr[kk * 33 + (lane & 31)] = __builtin_nontemporal_load(W + (size_t)(k0 + kk) * ldw + n0 + (lane & 31)); }
    WAVE_LDS_FENCE();
    const int c = lane & 7;
#pragma unroll
    for (int j = 0; j < 4; ++j) { const int n = (lane >> 3) + 8 * j; const float* s = scr + (8 * c) * 33 + n;
        uint4 o; o.x = pk2(s[0 * 33], s[1 * 33]); o.y = pk2(s[2 * 33], s[3 * 33]); o.z = pk2(s[4 * 33], s[5 * 33]); o.w = pk2(s[6 * 33], s[7 * 33]);
        *(uint4*)(WT + (size_t)(n0 + n) * K + k0 + 8 * c) = o; }
    WAVE_LDS_FENCE();
}
__device__ __forceinline__ void cvt512(const float* src, bf16_t* dst, int lane) {
    const float4 a = *(const float4*)(src + 8 * lane), b = *(const float4*)(src + 8 * lane + 4);
    uint4 o; o.x = pk2(a.x, a.y); o.y = pk2(a.z, a.w); o.z = pk2(b.x, b.y); o.w = pk2(b.z, b.w);
    *(uint4*)(dst + 8 * lane) = o;
}

#ifndef PROBE_REP
#define PROBE_REP -1
#endif
#define PHASE_IDS() int lane = lane_id(); asm volatile("" : "+v"(lane)); const int wave = wave_id(); const int tid = wave * 64 + lane; const int gw = blockIdx.x * NWAVE + wave; (void)tid; (void)gw
#define REP(k) for (int rep_ = 0; rep_ < ((PROBE_REP) == (k) ? 2 : 1); ++rep_)
struct QueryOrder {
    int c;
    __device__ __forceinline__ bool next(int i, pg8::Unit& u) const { if (i >= 2) return false; const int x = c & 7, k = c >> 3; u.pn = k & 7; u.pm = 8 * x + 2 * (k >> 3) + i; return true; }
    __device__ __forceinline__ void a_ready(const pg8::Unit&) const {}
    __device__ __forceinline__ void done(const pg8::Unit&) const {}
};
__global__ void __launch_bounds__(NTHR, 2) fwd_kernel(Args a) {
    extern __shared__ __attribute__((aligned(16))) unsigned char lds_raw[];
    float* lds = (float*)lds_raw;
    unsigned char* ws = a.ws;
    float* ADA = (float*)(ws + WS_ADA); float* SQB = (float*)(ws + WS_SQB); float* FL = (float*)(ws + WS_FL); float* GQ = (float*)(ws + WS_GQ); float* SSQ = (float*)(ws + WS_SSQ);
    bf16_t* WIN = (bf16_t*)(ws + WS_WIN); bf16_t* WOUT = (bf16_t*)(ws + WS_WOUT); bf16_t* WQ = (bf16_t*)(ws + WS_WQ); bf16_t* SUBK = (bf16_t*)(ws + WS_SUBK); bf16_t* SGWB = (bf16_t*)(ws + WS_SGW);
    float* GT = (float*)(ws + WS_GX); unsigned char* EU = ws + WS_EU; unsigned char* EV = ws + WS_EV; bf16_t* HB = (bf16_t*)(ws + WS_HB);
    bf16_t* ZU = (bf16_t*)(ws + WS_ZU); bf16_t* ZV = (bf16_t*)(ws + WS_ZV); bf16_t* Q = (bf16_t*)(ws + WS_Q); bf16_t* K = (bf16_t*)(ws + WS_K); bf16_t* V = (bf16_t*)(ws + WS_V);
    bf16_t* XG = (bf16_t*)(ws + WS_XG); bf16_t* QV = (bf16_t*)(ws + WS_QV); unsigned short* IDX = (unsigned short*)(ws + WS_IDX); float* GATE = (float*)(ws + WS_GATE);
    for (int u = threadIdx.x; u < (LDS_BYTES - LDSCTL_OFF) / 4; u += NTHR) ((LAS unsigned*)((LAS unsigned char*)lds_raw + LDSCTL_OFF))[u] = 0u;
    __syncthreads();
    if ((threadIdx.x & 63) == 0) *(LAS int*)(unsigned)(WTAB_OFF + 4 * hw_slot()) = (int)(threadIdx.x >> 6);
    __syncthreads();
    const int lane = lane_id(), wave = wave_id(), tid = wave * 64 + lane;
    const int gw = blockIdx.x * NWAVE + wave, ngw = gridDim.x * NWAVE;
    XcdBarrier bar = xcd_barrier_post(g_bar, (volatile LAS unsigned*)((LAS unsigned char*)lds_raw + MISC_OFF) + 8);
#ifndef TS_SEL
#define TS_SEL -2
#endif
    unsigned long long ts_[8]; ts_[0] = 0ull;
    int ts_n = 0;
#define GRID_BAR() do { xcd_barrier(bar); if ((TS_SEL) > -2) ts_[++ts_n] = __builtin_amdgcn_s_memrealtime(); } while (0)
    if ((TS_SEL) > -2) ts_[0] = __builtin_amdgcn_s_memrealtime();

    REP(0) {
        PHASE_IDS();
        if (blockIdx.x < 192) {
            for (int i = tid; i < NB * DM; i += NTHR) { const float cv = a.c[i]; lds[i] = cv / (1.f + expf(-cv)); }
            __syncthreads();
            gemv8_task32(lds, a.w_ada, 6 * DM, blockIdx.x * 32, a.b_ada, ADA, 6 * DM, tid);
            if (blockIdx.x < 64) {
                asm volatile("s_waitcnt vmcnt(0)" ::: "memory"); __syncthreads();
                if (tid == 0) { __builtin_amdgcn_fence(__ATOMIC_RELEASE, "agent"); (void)xb_add(&g_bar[XCD_BAR_WORDS + 40], 1u); }
            }
        }
        float* scr = lds + 12288 + wave * 2112;
        constexpr int I_IN = 16 * 80, I_OUT = 16 * 32, I_Q = 16 * 64;
        for (int rnd = 0; rnd < 3; ++rnd) {
            int it;
            if (blockIdx.x >= 192) { const int w2 = gw - 192 * NWAVE; it = (rnd < 2) ? w2 + 512 * rnd : ((w2 < 256) ? 1024 + w2 : -1); }
            else it = (rnd == 0) ? 1280 + gw : -1;
            if (it < 0) continue;
            int r = it;
            if (r < I_IN) { transpose_item(a.w_in, DM, INC, 80, WIN, scr, r, lane); continue; } r -= I_IN;
            if (r < I_OUT) { transpose_item(a.w_out, DM, DM, 32, WOUT, scr, r, lane); continue; } r -= I_OUT;
            transpose_item(a.w_query, DM, NQ, 64, WQ, scr, r, lane);
        }
        for (int it = gw; it < 512; it += ngw) cvt512(a.sub_keys + (size_t)it * 512, SUBK + (size_t)it * 512, lane);
        for (int it = gw; it < 256; it += ngw) {
            const int e0 = it * 512 + 8 * lane, t = (e0 >> 7) & 127, s0 = e0 & 127;
            const float4 p = *(const float4*)(a.sg_w + e0), q = *(const float4*)(a.sg_w + e0 + 4);
            const float v[8] = {p.x, p.y, p.z, p.w, q.x, q.y, q.z, q.w}; float m[8];
#pragma unroll
            for (int i = 0; i < 8; ++i) m[i] = (s0 + i <= t) ? v[i] : 0.f;
            uint4 o; o.x = pk2(m[0], m[1]); o.y = pk2(m[2], m[3]); o.z = pk2(m[4], m[5]); o.w = pk2(m[6], m[7]);
            *(uint4*)(SGWB + e0) = o;
        }
    }
    REP(1) {
        PHASE_IDS();
        __syncthreads();
        for (int i = tid; i < 8 * DM; i += NTHR) { const int k = i >> 3, j = i & 7; lds[j * DM + k] = a.w_in[(size_t)k * INC + NPROJ + j]; }
        if (tid == 0) { XB_SPIN(xb_ld(&g_bar[XCD_BAR_WORDS + 40]) < 64u, g_bar); __builtin_amdgcn_fence(__ATOMIC_ACQUIRE, "agent"); asm volatile("s_waitcnt vmcnt(0)" ::: "memory"); }
        __syncthreads();
        for (int t0 = gw * 8; t0 < NT; t0 += ngw * 8) {
            const int b = t0 / SEQ; const float* shift = ADA + b * 6 * DM; const float* scale = shift + DM;
            float4 mm[4], sh[4];
#pragma unroll
            for (int j = 0; j < 4; ++j) { const int c = 256 * j + 4 * lane; const float4 gg = *(const float4*)(a.norm1_g + c), sc = *(const float4*)(scale + c); sh[j] = *(const float4*)(shift + c);
                mm[j].x = gg.x * (1.f + sc.x); mm[j].y = gg.y * (1.f + sc.y); mm[j].z = gg.z * (1.f + sc.z); mm[j].w = gg.w * (1.f + sc.w); }
#pragma unroll 1
            for (int hf = 0; hf < 2; ++hf) {
                float4 v[4][4];
#pragma unroll
                for (int r = 0; r < 4; ++r)
#pragma unroll
                    for (int j = 0; j < 4; ++j) { const pg8::f32x4 nt_ = __builtin_nontemporal_load((const pg8::f32x4*)(a.x + (size_t)(t0 + 4 * hf + r) * DM + 256 * j + 4 * lane)); v[r][j] = make_float4(nt_[0], nt_[1], nt_[2], nt_[3]); }
#pragma unroll
                for (int r = 0; r < 4; ++r) {
                    const int t = t0 + 4 * hf + r; float s = 0.f;
#pragma unroll
                    for (int j = 0; j < 4; ++j) s += v[r][j].x * v[r][j].x + v[r][j].y * v[r][j].y + v[r][j].z * v[r][j].z + v[r][j].w * v[r][j].w;
                    const float rstd = rsqrtf(wave_sum(s) * (1.f / DM) + EPS);
#pragma unroll
                    for (int j = 0; j < 4; ++j) {
                        float4& w = v[r][j];
                        w.x = w.x * rstd * mm[j].x + sh[j].x; w.y = w.y * rstd * mm[j].y + sh[j].y; w.z = w.z * rstd * mm[j].z + sh[j].z; w.w = w.w * rstd * mm[j].w + sh[j].w;
                        uint2 o; o.x = pk2(w.x, w.y); o.y = pk2(w.z, w.w);
                        *(uint2*)(HB + (size_t)t * DM + 256 * j + 4 * lane) = o;
                    }
                }
                float d[4][8];
#pragma unroll
                for (int j8 = 0; j8 < 8; ++j8) {
#pragma unroll
                    for (int r = 0; r < 4; ++r) d[r][j8] = 0.f;
#pragma unroll
                    for (int j = 0; j < 4; ++j) { const float4 w = *(const float4*)(lds + j8 * DM + 256 * j + 4 * lane);
#pragma unroll
                        for (int r = 0; r < 4; ++r) d[r][j8] += v[r][j].x * w.x + v[r][j].y * w.y + v[r][j].z * w.z + v[r][j].w * w.w; }
                    __builtin_amdgcn_sched_barrier(0);
                }
                const int hd = 4 * (lane >> 5) + 2 * ((lane >> 4) & 1) + ((lane >> 3) & 1); const float bfh = a.b_f[hd];
#pragma unroll
                for (int r = 0; r < 4; ++r) {
                    float e4[4], e2[2];
#pragma unroll
                    for (int k = 0; k < 4; ++k) { const bool up = (lane & 32) != 0; const float mine = up ? d[r][k + 4] : d[r][k], oth = up ? d[r][k] : d[r][k + 4]; e4[k] = mine + __shfl_xor(oth, 32); }
#pragma unroll
                    for (int k = 0; k < 2; ++k) { const bool up = (lane & 16) != 0; const float mine = up ? e4[k + 2] : e4[k], oth = up ? e4[k] : e4[k + 2]; e2[k] = mine + __shfl_xor(oth, 16); }
                    float fl; { const bool up = (lane & 8) != 0; const float mine = up ? e2[1] : e2[0], oth = up ? e2[0] : e2[1]; fl = mine + __shfl_xor(oth, 8); }
                    fl += __shfl_xor(fl, 4); fl += __shfl_xor(fl, 2); fl += __shfl_xor(fl, 1);
                    if ((lane & 7) == 0) FL[(size_t)(t0 + 4 * hf + r) * 8 + hd] = log_sigmoid(fl + bfh);
                }
            }
        }
    }
    GRID_BAR();
    REP(2) {
        PHASE_IDS();
        if (gw < NB * NH) {
            const int b = gw >> 3, h = gw & 7; float v[32]; float run = 0.f;
#pragma unroll
            for (int i = 0; i < 32; ++i) { run += FL[((size_t)b * SEQ + 32 * lane + i) * 8 + h]; v[i] = run; }
            float incl = run;
#pragma unroll
            for (int o = 1; o < 64; o <<= 1) { const float n = __shfl_up(incl, o); if (lane >= o) incl += n; }
            const float excl = incl - run;
#pragma unroll
            for (int i = 0; i < 32; ++i) {
                GT[((size_t)b * NH + h) * SEQ + 32 * lane + i] = -(excl + v[i]) * LOG2E;
            }
        }
        pg8::Gemm g{HB, WIN, NT, NPROJ, DM}; pg8::StaticOrder S; S.init(NT, NPROJ, gridDim.x, (int)blockIdx.x);
        pg8::EpiProj E{ZU};
        pg8::gemm_phase<pg8::EpiProj, pg8::StaticOrder, true, true>((PG8_LAS unsigned char*)lds_raw, g, S, E);
        const int nfull = (NT / 256) * (NPROJ / 256) % gridDim.x;
        {
            const bool tailblk = (int)blockIdx.x >= nfull;
            if (tailblk && (int)blockIdx.x - nfull < 32) {
                __syncthreads();
                for (int i = tid; i < NB * DM; i += NTHR) lds[i] = ADA[(i >> 10) * 6 * DM + 3 * DM + (i & 1023)];
                __syncthreads();
                gemv8_task(lds, a.w_query, NQ, ((int)blockIdx.x - nfull) * 64, nullptr, SQB, NQ, tid);
            }
            const int wq = ((int)blockIdx.x - (tailblk ? nfull : 0)) * NWAVE + wave; const bool sq = tailblk && wq < 32 * NWAVE;
            const int nconv = !tailblk ? nfull * NWAVE : sq ? 32 * NWAVE : (gridDim.x - nfull - 32) * NWAVE;
            const int wbase = !tailblk ? 28672 + wq : sq ? wq : 4096 + (wq - 32 * NWAVE), wend = !tailblk ? 2 * 16384 : sq ? 4096 : 28672;
            for (int it0 = wbase; it0 < wend; it0 += 4 * nconv) {
                float4 f[4][4];
#pragma unroll
                for (int q = 0; q < 4; ++q) { const int it = it0 + q * nconv; const bool isv = it >= 16384; const int r = isv ? it - 16384 : it;
                    const float* src = (isv ? a.expert_v : a.expert_u) + (size_t)r * DM + 16 * lane;
#pragma unroll
                    for (int k = 0; k < 4; ++k) f[q][k] = *(const float4*)(src + 4 * k); }
#pragma unroll
                for (int q = 0; q < 4; ++q) { const int it = it0 + q * nconv; const bool isv = it >= 16384; const int r = isv ? it - 16384 : it; const float sc = isv ? peer::V_SCALE : peer::U_SCALE;
                    const int cs = lane & 7;
                    if (!isv) {
                        if (peer::U4) {
                            unsigned w0 = 0u, w1 = 0u;
                            w0 = __builtin_amdgcn_cvt_scalef32_pk_fp4_f32(w0, f[q][0].x * sc, f[q][0].y * sc, 1.0f, 0); w0 = __builtin_amdgcn_cvt_scalef32_pk_fp4_f32(w0, f[q][0].z * sc, f[q][0].w * sc, 1.0f, 1);
                            w0 = __builtin_amdgcn_cvt_scalef32_pk_fp4_f32(w0, f[q][1].x * sc, f[q][1].y * sc, 1.0f, 2); w0 = __builtin_amdgcn_cvt_scalef32_pk_fp4_f32(w0, f[q][1].z * sc, f[q][1].w * sc, 1.0f, 3);
                            w1 = __builtin_amdgcn_cvt_scalef32_pk_fp4_f32(w1, f[q][2].x * sc, f[q][2].y * sc, 1.0f, 0); w1 = __builtin_amdgcn_cvt_scalef32_pk_fp4_f32(w1, f[q][2].z * sc, f[q][2].w * sc, 1.0f, 1);
                            w1 = __builtin_amdgcn_cvt_scalef32_pk_fp4_f32(w1, f[q][3].x * sc, f[q][3].y * sc, 1.0f, 2); w1 = __builtin_amdgcn_cvt_scalef32_pk_fp4_f32(w1, f[q][3].z * sc, f[q][3].w * sc, 1.0f, 3);
                            *(uint2*)(EU + (size_t)(lane >> 4) * peer::SLICE_BYTES + (size_t)r * 128 + 8 * (lane & 15)) = make_uint2(w0, w1);
                        } else {
                            unsigned char* dst = EU + (size_t)(lane >> 3) * peer::SLICE_BYTES + (size_t)r * 128 + 16 * ((cs >> 1) + 4 * (cs & 1));
                            uint4 o; unsigned* ow = (unsigned*)&o;
#pragma unroll
                            for (int k = 0; k < 4; ++k) { int w = __builtin_amdgcn_cvt_pk_fp8_f32(f[q][k].x * sc, f[q][k].y * sc, 0, false); w = __builtin_amdgcn_cvt_pk_fp8_f32(f[q][k].z * sc, f[q][k].w * sc, w, true); ow[k] = (unsigned)w; }
                            *(uint4*)dst = o;
                        }
                    } else if (peer::V4) {
                        const int c4 = lane & 15;
                        unsigned char* dst = EV + (size_t)(lane >> 4) * peer::SLICE_BYTES + (size_t)r * 128 + 32 * (c4 >> 2) + 2 * (c4 & 3);
                        unsigned w0 = 0u, w1 = 0u, w2 = 0u, w3 = 0u;
                        w0 = __builtin_amdgcn_cvt_scalef32_pk_fp4_f32(w0, f[q][0].x * sc, f[q][1].x * sc, 1.0f, 0); w0 = __builtin_amdgcn_cvt_scalef32_pk_fp4_f32(w0, f[q][2].x * sc, f[q][3].x * sc, 1.0f, 1);
                        w1 = __builtin_amdgcn_cvt_scalef32_pk_fp4_f32(w1, f[q][0].y * sc, f[q][1].y * sc, 1.0f, 0); w1 = __builtin_amdgcn_cvt_scalef32_pk_fp4_f32(w1, f[q][2].y * sc, f[q][3].y * sc, 1.0f, 1);
                        w2 = __builtin_amdgcn_cvt_scalef32_pk_fp4_f32(w2, f[q][0].z * sc, f[q][1].z * sc, 1.0f, 0); w2 = __builtin_amdgcn_cvt_scalef32_pk_fp4_f32(w2, f[q][2].z * sc, f[q][3].z * sc, 1.0f, 1);
                        w3 = __builtin_amdgcn_cvt_scalef32_pk_fp4_f32(w3, f[q][0].w * sc, f[q][1].w * sc, 1.0f, 0); w3 = __builtin_amdgcn_cvt_scalef32_pk_fp4_f32(w3, f[q][2].w * sc, f[q][3].w * sc, 1.0f, 1);
                        *(unsigned short*)(dst) = (unsigned short)w0; *(unsigned short*)(dst + 8) = (unsigned short)w1; *(unsigned short*)(dst + 16) = (unsigned short)w2; *(unsigned short*)(dst + 24) = (unsigned short)w3;
                    } else {
                        unsigned char* dst = EV + (size_t)(lane >> 3) * peer::SLICE_BYTES + (size_t)r * 128 + 64 * (cs >> 2) + 4 * (cs & 3);
                        int w0 = __builtin_amdgcn_cvt_pk_fp8_f32(f[q][0].x * sc, f[q][1].x * sc, 0, false); w0 = __builtin_amdgcn_cvt_pk_fp8_f32(f[q][2].x * sc, f[q][3].x * sc, w0, true);
                        int w1 = __builtin_amdgcn_cvt_pk_fp8_f32(f[q][0].y * sc, f[q][1].y * sc, 0, false); w1 = __builtin_amdgcn_cvt_pk_fp8_f32(f[q][2].y * sc, f[q][3].y * sc, w1, true);
                        int w2 = __builtin_amdgcn_cvt_pk_fp8_f32(f[q][0].z * sc, f[q][1].z * sc, 0, false); w2 = __builtin_amdgcn_cvt_pk_fp8_f32(f[q][2].z * sc, f[q][3].z * sc, w2, true);
                        int w3 = __builtin_amdgcn_cvt_pk_fp8_f32(f[q][0].w * sc, f[q][1].w * sc, 0, false); w3 = __builtin_amdgcn_cvt_pk_fp8_f32(f[q][2].w * sc, f[q][3].w * sc, w3, true);
                        *(int*)(dst) = w0; *(int*)(dst + 16) = w1; *(int*)(dst + 32) = w2; *(int*)(dst + 48) = w3;
                    } }
            }
        }
    }
    GRID_BAR();
    REP(3) {
        PHASE_IDS();
        char* shm = (char*)lds_raw;
        for (int pt = blockIdx.x; pt < NB * (SEQ / CHUNK) * NH / 2; pt += gridDim.x)
            mixer::sgu_pair(2 * pt, ZU, ZV, SGWB, a.sg_ln_g, a.sg_ln_b, a.sg_b, a.out_g_sg, HB, shm);
        __syncthreads();
        const int G = gridDim.x, vcu = (G % 8 == 0) ? (blockIdx.x % 8) * (G / 8) + blockIdx.x / 8 : blockIdx.x;
        for (int pr = vcu; pr < NB * NH * 4; pr += G) {
            const int bh = pr >> 2, s = pr & 3;
            attn2::attn_unit<8>(bh >> 3, bh & 7, 7 - s, Q, K, V, GT, a.out_g_fox, HB, shm);
            attn2::attn_unit<8>(bh >> 3, bh & 7, s, Q, K, V, GT, a.out_g_fox, HB, shm);
        }
    }
    GRID_BAR();
    REP(4) {
        PHASE_IDS();
        pg8::Gemm g{HB, WOUT, NT, DM, DM}; pg8::StaticOrder S; S.init(NT, DM, gridDim.x, (int)blockIdx.x);
        pg8::EpiOut E{a.x, ADA, a.norm2_g, a.out, XG, SSQ};
        pg8::gemm_phase<pg8::EpiOut, pg8::StaticOrder, false, true>((PG8_LAS unsigned char*)lds_raw, g, S, E);
    }
    GRID_BAR();
    REP(5) {
        PHASE_IDS();
        pg8::Gemm g{XG, WQ, NT, NQ, DM}; QueryOrder S; S.c = (int)blockIdx.x;
        pg8::EpiQuery E{SSQ, SQB, QV};
        pg8::gemm_phase<pg8::EpiQuery, QueryOrder, true, true>((PG8_LAS unsigned char*)lds_raw, g, S, E);
        asm volatile("s_waitcnt vmcnt(0)" ::: "memory"); __syncthreads();
        __builtin_amdgcn_fence(__ATOMIC_ACQUIRE, "agent");
        asm volatile("s_waitcnt vmcnt(0)" ::: "memory"); __syncthreads();
        pg8::Unit u;
        for (int r7 = 0; r7 < ((PROBE_REP) == 7 ? 2 : 1); ++r7)
        for (int i = 0; S.next(i, u); ++i) peer::topk256(u.pn, u.pm * 256, QV, SUBK, IDX, GATE, (char*)lds_raw, i == 0);
    }
    GRID_BAR();
    REP(6) {
        PHASE_IDS();
        char* shm = (char*)lds_raw;
        if (blockIdx.x < NT / 64) {
            __syncthreads();
            peer::gather_mx<peer::U4, peer::V4>((int)blockIdx.x * 64 + wave * 8, XG, SSQ, ADA, EU, EV, IDX, GATE, a.final_g, a.norm2_g, a.out);
        }
    }
    {
        volatile LAS unsigned* lastf = (volatile LAS unsigned*)((LAS unsigned char*)lds_raw + MISC_OFF) + 12;
        __syncthreads();
        if (tid == 0) *lastf = (xb_add(&g_bar[XCD_BAR_WORDS + 32], 1u) == gridDim.x - 1) ? 1u : 0u;
        __syncthreads();
        if (*lastf) for (int i = tid; i < XCD_BAR_WORDS + 64; i += NTHR) __hip_atomic_store(&g_bar[i], 0u, __ATOMIC_RELAXED, __HIP_MEMORY_SCOPE_AGENT);
    }
    if ((TS_SEL) > -2) {
        GRID_BAR();
        if (blockIdx.x == 0 && tid == 0) a.out[0] = ((TS_SEL) < 0) ? 200.f : 2.f * 0.01f * (float)(ts_[(TS_SEL) + 1] - ts_[0]);
    }
}

extern "C" void kernel_launch(void* const* d_in, const int* in_sizes, int n_in, void* d_out, int out_size, void* d_ws, size_t ws_size, hipStream_t stream) {
    if (n_in != 20 || ws_size < WS_END) { fprintf(stderr, "kernel_launch: unexpected n_in %d or ws_size %zu\n", n_in, ws_size); return; }
    Args a{};
    const float** p = (const float**)&a;
    for (int i = 0; i < 20; ++i) p[i] = (const float*)d_in[i];
    a.out = (float*)d_out; a.ws = (unsigned char*)d_ws;
    static int grid = 0;
    if (grid == 0) {
        int dev = 0, cus = 0, per_cu = 0;
        (void)hipGetDevice(&dev); (void)hipDeviceGetAttribute(&cus, hipDeviceAttributeMultiprocessorCount, dev);
        (void)hipFuncSetAttribute((const void*)fwd_kernel, hipFuncAttributeMaxDynamicSharedMemorySize, LDS_BYTES);
        (void)hipOccupancyMaxActiveBlocksPerMultiprocessor(&per_cu, (const void*)fwd_kernel, NTHR, LDS_BYTES);
        (void)hipGetLastError();
        if (per_cu < 1 || cus != 256) { fprintf(stderr, "kernel_launch: occupancy query says %d blocks/CU, %d CUs (built for one block on each of 256 CUs)\n", per_cu, cus); grid = -1; }
        else grid = cus;
    }
    if (grid < 0) return;
    a.ph_lo = 0; a.ph_hi = 10;
    hipLaunchKernelGGL(fwd_kernel, dim3(grid), dim3(NTHR), LDS_BYTES, stream, a);
}
```

```cpp
#include <hip/hip_runtime.h>
#include <cstdint>
#include <cstdio>
#include <cmath>

constexpr int DM = 1024, NB = 8, SEQ = 2048, NT = NB * SEQ;
constexpr int HD = 64, SGW = 512, FOXW = 512, NH = 8, CHUNK = 128;
constexpr int INC = 2 * SGW + 3 * FOXW + NH;
constexpr int NPROJ = 2560;
constexpr int PH = 8, NKEYS = 128, NEXP = NKEYS * NKEYS, TOPK = 16, DKEY = 256, DHALF = 128, NQ = PH * DKEY;
constexpr float EPS = 1e-6f;
constexpr int NTHR = 512, NWAVE = 8;
constexpr float LOG2E = 1.4426950408889634f;
constexpr float C2 = 0.125f * LOG2E;

typedef unsigned short bf16_t;

constexpr size_t MiB = 1u << 20;
constexpr size_t WS_CTL = 0, CTL_ZERO_BYTES = 64 * 1024;
constexpr size_t WS_ADA = 256 * 1024;
constexpr size_t WS_SQB = 512 * 1024;
constexpr size_t WS_FL = 1 * MiB;
constexpr size_t WS_GQ = WS_FL + MiB / 2;
constexpr size_t WS_SSQ = 2 * MiB;
constexpr size_t WS_WIN = 3 * MiB;
constexpr size_t WS_WOUT = WS_WIN + 5 * MiB;
constexpr size_t WS_WQ = WS_WOUT + 2 * MiB;
constexpr size_t WS_SUBK = WS_WQ + 4 * MiB;
constexpr size_t WS_SGW = WS_SUBK + MiB;
constexpr size_t WS_GX = WS_SGW + MiB;
constexpr size_t WS_EU = 20 * MiB;
constexpr size_t WS_EV = WS_EU + 32 * MiB;
constexpr size_t WS_HB = WS_EV + 32 * MiB;
constexpr size_t WS_ZU = WS_HB + 32 * MiB;
constexpr size_t WS_ZV = WS_ZU + 16 * MiB, WS_Q = WS_ZV + 16 * MiB, WS_K = WS_Q + 16 * MiB, WS_V = WS_K + 16 * MiB;
constexpr size_t WS_XG = WS_K;
constexpr size_t WS_QV = WS_HB;
constexpr size_t WS_IDX = WS_V + 16 * MiB;
constexpr size_t WS_GATE = WS_IDX + 8 * MiB;
constexpr size_t WS_END = WS_GATE + 8 * MiB;

struct Args {
    const float *x, *c, *w_ada, *b_ada, *norm1_g, *w_in, *b_f, *sg_ln_g, *sg_ln_b, *sg_w, *sg_b, *out_g_sg, *out_g_fox,
        *w_out, *norm2_g, *w_query, *sub_keys, *expert_u, *expert_v, *final_g;
    float* out; unsigned char* ws; int ph_lo, ph_hi;
};

#define GAS __attribute__((address_space(1)))
#define LAS __attribute__((address_space(3)))
#define WAVE_LDS_FENCE() do { __builtin_amdgcn_fence(__ATOMIC_ACQ_REL, "wavefront"); __builtin_amdgcn_wave_barrier(); } while (0)
constexpr int WTAB_OFF = 131072 + 1024;
__device__ __forceinline__ int lane_id() { return (int)__builtin_amdgcn_mbcnt_hi(~0u, __builtin_amdgcn_mbcnt_lo(~0u, 0u)); }
__device__ __forceinline__ int hw_slot() { return (int)(__builtin_amdgcn_s_getreg((5 << 11) | 4) & 63u); }
__device__ __forceinline__ int wave_id() { return __builtin_amdgcn_readfirstlane(*(const LAS int*)(unsigned)(WTAB_OFF + 4 * hw_slot())); }
#define TIDX (wave_id() * 64 + lane_id())
__device__ __forceinline__ float wave_sum(float v) {
#pragma unroll
    for (int o = 1; o < 64; o <<= 1) v += __shfl_xor(v, o);
    return v;
}
__device__ __forceinline__ float wave_max(float v) {
#pragma unroll
    for (int o = 1; o < 64; o <<= 1) v = fmaxf(v, __shfl_xor(v, o));
    return v;
}
__device__ __forceinline__ float gelu_exact(float v) { return 0.5f * v * (1.0f + erff(v * 0.70710678118654752f)); }
__device__ __forceinline__ float log_sigmoid(float v) { return fminf(v, 0.f) - log1pf(expf(-fabsf(v))); }
__device__ __forceinline__ float bf2f(bf16_t v) { return __uint_as_float((unsigned)v << 16); }
__device__ __forceinline__ unsigned f2bf(float f) { unsigned u = __builtin_bit_cast(unsigned, f); return (u + 0x7fffu + ((u >> 16) & 1u)) >> 16; }
__device__ __forceinline__ unsigned pk2(float lo, float hi) { return f2bf(lo) | (f2bf(hi) << 16); }

namespace pg8 {
#define PG8_LAS __attribute__((address_space(3)))
typedef unsigned short bf16_t;
typedef short bf16x8 __attribute__((ext_vector_type(8)));
typedef float f32x4 __attribute__((ext_vector_type(4)));
typedef unsigned u32x4 __attribute__((ext_vector_type(4)));
constexpr int BM = 256, BK = 64, HALF = 128, HTB = HALF * BK * 2  , STAGE_BYTES = 8 * HTB, NXCD = 8, WGM = 8;

__host__ __device__ __forceinline__ int lds_byte(int r, int c) { const int st = (r >> 4) * 2 + (c >> 5), rr = r & 15, cc = c & 31, ob = rr * 64 + cc * 2; return st * 1024 + (ob ^ (((ob >> 9) & 1) << 5)); }
__host__ __device__ __forceinline__ void stage_rc(int b, int& R, int& C) { const int st = b / 1024, sb = b % 1024, swz = sb ^ (((sb >> 9) & 1) << 5); R = (st >> 1) * 16 + swz / 64; C = (st & 1) * 32 + (swz % 64) / 2; }
__host__ __device__ __forceinline__ int perm32(int rho) { const int n = rho >> 4, i = rho & 15; return 8 * (i >> 2) + 4 * n + (i & 3); }

struct Unit { int pm, pn; };
struct Gemm { const bf16_t* A; const bf16_t* Bt; int M, N, K; };

struct StaticOrder {
    int nM, nN, nwg, G, c;
    __host__ __device__ void init(int M, int N, int G_, int c_) { nM = M / BM; nN = N / BM; nwg = nM * nN; G = G_; c = c_; }
    __host__ __device__ bool next(int i, Unit& u) const {
        const long L = (long)i * G + c; if (L >= nwg) return false;
        int wgid = (int)L; { const int q = nwg / NXCD, r = nwg % NXCD, xcd = wgid % NXCD, off = wgid / NXCD; wgid = (xcd < r ? xcd * (q + 1) : r * (q + 1) + (xcd - r) * q) + off; }
        const int nig = WGM * nN, gid = wgid / nig, fm = gid * WGM, gsz = (nM - fm) < WGM ? (nM - fm) : WGM;
        u.pm = fm + ((wgid % nig) % gsz); u.pn = (wgid % nig) / gsz; return true;
    }
    __device__ __forceinline__ void a_ready(const Unit&) const {}
    __device__ __forceinline__ void done(const Unit&) const {}
};


__device__ __forceinline__ unsigned cvt_pk_bf16(float lo, float hi) { unsigned r; asm volatile("v_cvt_pk_bf16_f32 %0, %1, %2" : "=v"(r) : "v"(lo), "v"(hi)); return r; }
typedef float f32x2 __attribute__((ext_vector_type(2)));
__device__ __forceinline__ f32x2 gelu_pk(f32x2 v) {
    const f32x2 av = __builtin_elementwise_abs(v), d = av * 0.2316418882f + 1.0f;
    f32x2 t; t.x = __builtin_amdgcn_rcpf(d.x); t.y = __builtin_amdgcn_rcpf(d.y);
    f32x2 q = t * 0.5307027145f + (-0.7265760135f); q = q * t + 0.7107068705f; q = q * t + (-0.142248368f); q = q * t + 0.127414796f; q = q * t;
    const f32x2 s = (v * v) * (-0.72134752044f);
    f32x2 e; e.x = __builtin_amdgcn_exp2f(s.x); e.y = __builtin_amdgcn_exp2f(s.y);
    const f32x2 m = v * (q * e), r = v - m;
    f32x2 o; o.x = v.x < 0.f ? m.x : r.x; o.y = v.y < 0.f ? m.y : r.y; return o;
}


typedef unsigned u32x4 __attribute__((ext_vector_type(4)));
struct EpiProj {
    static constexpr bool PERM = true, AFTER_DRAIN = false;
    bf16_t* base;
    __device__ __forceinline__ void operator()(const f32x4 (&acc)[2][2][4][2], const Unit& u, int wr, int wc, int fr, int fq) const {
        const int t = u.pn >> 1;
        bf16_t* O = base + (size_t)t * NT * 512;
        const bool act = t < 2; const float sc = (t == 2) ? C2 : 1.f;
        const int row0 = u.pm * BM + wr * 64 + fr, col0 = (u.pn & 1) * 256 + wc * 32 + 8 * fq;
#pragma unroll
        for (int ai = 0; ai < 2; ++ai)
#pragma unroll
            for (int m = 0; m < 4; ++m) { bf16_t* rowp = O + (size_t)(row0 + ai * HALF + m * 16) * 512 + col0;
#pragma unroll
                for (int bj = 0; bj < 2; ++bj) { f32x4 v0 = acc[ai][bj][m][0], v1 = acc[ai][bj][m][1];
                    if (act) { f32x2 a = gelu_pk((f32x2){v0[0], v0[1]}), b = gelu_pk((f32x2){v0[2], v0[3]}), c = gelu_pk((f32x2){v1[0], v1[1]}), d = gelu_pk((f32x2){v1[2], v1[3]});
                        v0 = (f32x4){a.x, a.y, b.x, b.y}; v1 = (f32x4){c.x, c.y, d.x, d.y}; }
                    v0 = v0 * sc; v1 = v1 * sc; u32x4 w; w.x = cvt_pk_bf16(v0[0], v0[1]); w.y = cvt_pk_bf16(v0[2], v0[3]); w.z = cvt_pk_bf16(v1[0], v1[1]); w.w = cvt_pk_bf16(v1[2], v1[3]);
                    *(u32x4*)(rowp + bj * HALF) = w; } }
    }
};
struct EpiOut {
    static constexpr bool PERM = true, AFTER_DRAIN = true;
    const float* x; const float* ada; const float* norm2_g; float* x1out; bf16_t* xg; float* ssq4;
    __device__ __forceinline__ void fused(f32x4 (&acc)[2][2][4][2], const Unit& u, int wr, int wc, int fr, int fq, PG8_LAS unsigned char* lds, int wid, int lane) const {
        const int b = (u.pm * BM) / SEQ;
        const float* gate1 = ada + b * 6 * DM + 2 * DM; const float* scale2 = ada + b * 6 * DM + 4 * DM;
        const int col0 = u.pn * BM + wc * 32 + 8 * fq;
        PG8_LAS float* P = (PG8_LAS float*)lds;
        f32x4 gt[2][2], g2[2][2];
#pragma unroll
        for (int bj = 0; bj < 2; ++bj)
#pragma unroll
            for (int n = 0; n < 2; ++n) { const int c = col0 + bj * HALF + 4 * n; gt[bj][n] = *(const f32x4*)(gate1 + c); g2[bj][n] = *(const f32x4*)(norm2_g + c) * (*(const f32x4*)(scale2 + c) + 1.0f); }
#pragma unroll
        for (int ai = 0; ai < 2; ++ai)
#pragma unroll
            for (int m = 0; m < 4; ++m) { const int rl = ai * HALF + wr * 64 + m * 16 + fr; const size_t off = (size_t)(u.pm * BM + rl) * DM + col0; float ss = 0.f;
#pragma unroll
                for (int bj = 0; bj < 2; ++bj) {
                    const f32x4 x0 = __builtin_nontemporal_load((const f32x4*)(x + off + bj * HALF)), x1 = __builtin_nontemporal_load((const f32x4*)(x + off + bj * HALF + 4));
                    const f32x4 v0 = x0 + gt[bj][0] * acc[ai][bj][m][0], v1 = x1 + gt[bj][1] * acc[ai][bj][m][1];
                    ss += (v0[0] * v0[0] + v0[1] * v0[1]) + (v0[2] * v0[2] + v0[3] * v0[3]) + (v1[0] * v1[0] + v1[1] * v1[1]) + (v1[2] * v1[2] + v1[3] * v1[3]);
                    const f32x4 w0 = v0 * g2[bj][0], w1 = v1 * g2[bj][1];
                    u32x4 w; w.x = cvt_pk_bf16(w0[0], w0[1]); w.y = cvt_pk_bf16(w0[2], w0[3]); w.z = cvt_pk_bf16(w1[0], w1[1]); w.w = cvt_pk_bf16(w1[2], w1[3]);
                    *(u32x4*)(xg + off + bj * HALF) = w; }
                ss += __shfl_xor(ss, 16); ss += __shfl_xor(ss, 32);
                if (fq == 0) P[rl * 4 + wc] = ss; }
        asm volatile("s_waitcnt lgkmcnt(0)" ::: "memory"); __builtin_amdgcn_s_barrier(); asm volatile("" ::: "memory");
        const int tid = wid * 64 + lane;
        if (tid < 256) ssq4[(size_t)(u.pm * BM + tid) * 4 + u.pn] = (P[tid * 4 + 0] + P[tid * 4 + 1]) + (P[tid * 4 + 2] + P[tid * 4 + 3]);
        asm volatile("s_waitcnt lgkmcnt(0)" ::: "memory"); __builtin_amdgcn_s_barrier(); asm volatile("" ::: "memory");
    }
};
struct EpiQuery {
    static constexpr bool PERM = true, AFTER_DRAIN = false;
    const float* ssq4; const float* sqb; bf16_t* qv;
    __device__ __forceinline__ void operator()(const f32x4 (&acc)[2][2][4][2], const Unit& u, int wr, int wc, int fr, int fq) const {
        const int b = (u.pm * BM) / SEQ;
        const int row0 = u.pm * BM + wr * 64 + fr, col0 = u.pn * BM + wc * 32 + 8 * fq;
        f32x4 bv[2][2];
#pragma unroll
        for (int bj = 0; bj < 2; ++bj)
#pragma unroll
            for (int n = 0; n < 2; ++n) bv[bj][n] = *(const f32x4*)(sqb + b * NQ + col0 + bj * HALF + 4 * n);
#pragma unroll
        for (int ai = 0; ai < 2; ++ai)
#pragma unroll
            for (int m = 0; m < 4; ++m) { const int row = row0 + ai * HALF + m * 16; const f32x4 s4 = *(const f32x4*)(ssq4 + (size_t)row * 4);
                const float rstd = rsqrtf(((s4[0] + s4[1]) + (s4[2] + s4[3])) * (1.f / DM) + EPS);
                bf16_t* rowp = qv + (size_t)row * NQ + col0;
#pragma unroll
                for (int bj = 0; bj < 2; ++bj) { const f32x4 v0 = acc[ai][bj][m][0] * rstd + bv[bj][0], v1 = acc[ai][bj][m][1] * rstd + bv[bj][1];
                    u32x4 w; w.x = cvt_pk_bf16(v0[0], v0[1]); w.y = cvt_pk_bf16(v0[2], v0[3]); w.z = cvt_pk_bf16(v1[0], v1[1]); w.w = cvt_pk_bf16(v1[2], v1[3]);
                    *(u32x4*)(rowp + bj * HALF) = w; } }
    }
};

template <class Epi, class Sched, bool ALIGN_EPI = false, bool SP2 = false>
__device__ __forceinline__ void gemm_phase(PG8_LAS unsigned char* lds, const Gemm g, const Sched& S, const Epi& E) {
    int tid_ = TIDX; asm volatile("" : "+v"(tid_));
    const int tid = tid_, wid = __builtin_amdgcn_readfirstlane(tid >> 6), lane = tid & 63, wr = wid >> 2, wc = wid & 3, fr = lane & 15, fq = lane >> 4;
    const int K = g.K, nt = K / BK;
    unsigned voffA[2], voffB[2];
#pragma unroll
    for (int i = 0; i < 2; ++i) { int R, C; stage_rc(tid * 16 + i * 8192, R, C); const int Rb = Epi::PERM ? ((R & ~31) + perm32(R & 31)) : R;
        voffA[i] = (unsigned)(R * K + C) * 2u; voffB[i] = (unsigned)(Rb * K + C) * 2u; }
    const size_t kstep = (size_t)(BK * 2);
    const size_t hstep = (size_t)HALF * K * 2;
    const size_t tstep = 2 * hstep;
    const unsigned ldsw = (unsigned)wid * 1024u;
    const int aoff = lds_byte(wr * 64 + fr, fq * 8), boff = lds_byte(wc * 32 + fr, fq * 8);
#define PG8_SA(b, h) (((b) * 2 + (h)) * HTB)
#define PG8_SB(b, h) ((4 + (b) * 2 + (h)) * HTB)
#define PG8_STAGE(bufoff, gbase, voff) do { _Pragma("unroll") for (int _i = 0; _i < 2; ++_i) \
        __builtin_amdgcn_global_load_lds((const unsigned*)((const char*)(gbase) + (voff)[_i]), (PG8_LAS unsigned*)(lds + (bufoff) + ldsw + _i * 8192), 16, 0, 0); } while (0)
#define PG8_LDA(dst, b, h) do { _Pragma("unroll") for (int m = 0; m < 4; ++m) _Pragma("unroll") for (int k = 0; k < 2; ++k) dst[m][k] = *(const PG8_LAS bf16x8*)(lds + PG8_SA(b, h) + aoff + m * 2048 + k * 1024); } while (0)
#define PG8_LDB(dst, b, h) do { _Pragma("unroll") for (int n = 0; n < 2; ++n) _Pragma("unroll") for (int k = 0; k < 2; ++k) dst[n][k] = *(const PG8_LAS bf16x8*)(lds + PG8_SB(b, h) + boff + n * 2048 + k * 1024); } while (0)
#define PG8_MMA(ai, bj, At, Bt) do { __builtin_amdgcn_s_setprio(1); _Pragma("unroll") for (int m = 0; m < 4; ++m) _Pragma("unroll") for (int n = 0; n < 2; ++n) _Pragma("unroll") for (int k = 0; k < 2; ++k) \
        acc[ai][bj][m][n] = __builtin_amdgcn_mfma_f32_16x16x32_bf16(Bt[n][k], At[m][k], acc[ai][bj][m][n], 0, 0, 0); __builtin_amdgcn_s_setprio(0); } while (0)
#define PG8_WAIT_V(n) asm volatile("s_waitcnt vmcnt(" #n ")" ::: "memory")
#define PG8_WAIT_L(n) asm volatile("s_waitcnt lgkmcnt(" #n ")" ::: "memory")
#define PG8_BAR __builtin_amdgcn_s_barrier()
#define PG8_SCHED __builtin_amdgcn_sched_barrier(0)
    Unit cur, nxt; int ui = 0;
    if (!S.next(0, cur)) return;
    f32x4 acc[2][2][4][2];
#pragma unroll
    for (int a = 0; a < 2; ++a)
#pragma unroll
        for (int b = 0; b < 2; ++b)
#pragma unroll
            for (int m = 0; m < 4; ++m)
#pragma unroll
                for (int n = 0; n < 2; ++n) acc[a][b][m][n] = (f32x4){0.f, 0.f, 0.f, 0.f};
    bf16x8 At[4][2], B0[2][2], B1[2][2];
    const char* cA = (const char*)g.A + (size_t)cur.pm * tstep; const char* cB = (const char*)g.Bt + (size_t)cur.pn * tstep;
    S.a_ready(cur);
    if constexpr (SP2) {
        PG8_STAGE(PG8_SB(0, 0), cB, voffB); PG8_STAGE(PG8_SB(0, 1), cB + hstep, voffB); PG8_STAGE(PG8_SA(0, 0), cA, voffA); PG8_STAGE(PG8_SA(0, 1), cA + hstep, voffA);
        if (wr == 1) PG8_BAR;
        PG8_WAIT_V(2); PG8_BAR;
        PG8_STAGE(PG8_SB(1, 0), cB + kstep, voffB); PG8_STAGE(PG8_SA(1, 0), cA + kstep, voffA); PG8_STAGE(PG8_SB(1, 1), cB + hstep + kstep, voffB);
        PG8_WAIT_V(6); PG8_BAR;
    } else {
        PG8_STAGE(PG8_SB(0, 0), cB, voffB); PG8_STAGE(PG8_SA(0, 0), cA, voffA); PG8_STAGE(PG8_SB(0, 1), cB + hstep, voffB); PG8_STAGE(PG8_SA(0, 1), cA + hstep, voffA);
        if (wr == 1) PG8_BAR;
        PG8_WAIT_V(4); PG8_BAR;
        PG8_STAGE(PG8_SB(1, 0), cB + kstep, voffB); PG8_STAGE(PG8_SA(1, 0), cA + kstep, voffA); PG8_STAGE(PG8_SB(1, 1), cB + hstep + kstep, voffB);
        PG8_WAIT_V(6); PG8_BAR;
    }
    for (;;) {
        const bool has_next = S.next(ui + 1, nxt);
        const char* nA = has_next ? (const char*)g.A + (size_t)nxt.pm * tstep : cA; const char* nB = has_next ? (const char*)g.Bt + (size_t)nxt.pn * tstep : cB;
        for (int t = 0; t < nt; t += 2) {
            const bool last = (t == nt - 2);
            const char* a1 = cA + (size_t)(t + 1) * kstep;
            const char* a2 = last ? nA : cA + (size_t)(t + 2) * kstep; const char* b2 = last ? nB : cB + (size_t)(t + 2) * kstep;
            const char* a3 = a2 + kstep; const char* b3 = b2 + kstep;
            if (last && has_next) S.a_ready(nxt);
            if constexpr (SP2) {
            PG8_LDB(B0, 0, 0); PG8_LDB(B1, 0, 1); PG8_SCHED; PG8_LDA(At, 0, 0); PG8_STAGE(PG8_SA(1, 1), a1 + hstep, voffA);
            PG8_WAIT_V(8); PG8_WAIT_L(0); PG8_BAR; PG8_MMA(0, 0, At, B0); PG8_MMA(0, 1, At, B1); PG8_BAR; PG8_SCHED;
            PG8_LDA(At, 0, 1); PG8_STAGE(PG8_SB(0, 0), b2, voffB); PG8_STAGE(PG8_SB(0, 1), b2 + hstep, voffB); PG8_STAGE(PG8_SA(0, 0), a2, voffA);
            PG8_WAIT_V(8); PG8_WAIT_L(0); PG8_BAR; PG8_MMA(1, 0, At, B0); PG8_MMA(1, 1, At, B1); PG8_BAR; PG8_SCHED;
            PG8_LDB(B0, 1, 0); PG8_LDB(B1, 1, 1); PG8_SCHED; PG8_LDA(At, 1, 0); PG8_STAGE(PG8_SA(0, 1), a2 + hstep, voffA);
            PG8_WAIT_V(8); PG8_WAIT_L(0); PG8_BAR; PG8_MMA(0, 0, At, B0); PG8_MMA(0, 1, At, B1); PG8_BAR; PG8_SCHED;
            PG8_LDA(At, 1, 1); PG8_STAGE(PG8_SB(1, 0), b3, voffB); PG8_STAGE(PG8_SB(1, 1), b3 + hstep, voffB); PG8_STAGE(PG8_SA(1, 0), a3, voffA);
            PG8_WAIT_V(8); PG8_WAIT_L(0); PG8_BAR; PG8_MMA(1, 0, At, B0); PG8_MMA(1, 1, At, B1); PG8_BAR; PG8_SCHED;
            } else {
            PG8_LDB(B0, 0, 0); PG8_SCHED; PG8_LDA(At, 0, 0); PG8_STAGE(PG8_SA(1, 1), a1 + hstep, voffA);
            PG8_WAIT_L(8); PG8_BAR; PG8_WAIT_L(0); PG8_MMA(0, 0, At, B0); PG8_BAR; PG8_SCHED;
            PG8_LDB(B1, 0, 1); PG8_STAGE(PG8_SB(0, 0), b2, voffB);
            PG8_BAR; PG8_WAIT_L(0); PG8_MMA(0, 1, At, B1); PG8_BAR;
            PG8_LDA(At, 0, 1); PG8_STAGE(PG8_SA(0, 0), a2, voffA);
            PG8_BAR; PG8_WAIT_L(0); PG8_MMA(1, 0, At, B0); PG8_BAR; PG8_SCHED;
            PG8_STAGE(PG8_SB(0, 1), b2 + hstep, voffB);
            PG8_WAIT_V(6); PG8_BAR; PG8_MMA(1, 1, At, B1); PG8_BAR;
            PG8_LDB(B0, 1, 0); PG8_SCHED; PG8_LDA(At, 1, 0); PG8_STAGE(PG8_SA(0, 1), a2 + hstep, voffA);
            PG8_WAIT_L(8); PG8_BAR; PG8_WAIT_L(0); PG8_MMA(0, 0, At, B0); PG8_BAR; PG8_SCHED;
            PG8_LDB(B1, 1, 1); PG8_STAGE(PG8_SB(1, 0), b3, voffB);
            PG8_BAR; PG8_WAIT_L(0); PG8_MMA(0, 1, At, B1); PG8_BAR;
            PG8_LDA(At, 1, 1); PG8_STAGE(PG8_SA(1, 0), a3, voffA);
            PG8_BAR; PG8_WAIT_L(0); PG8_MMA(1, 0, At, B0); PG8_BAR; PG8_SCHED;
            PG8_STAGE(PG8_SB(1, 1), b3 + hstep, voffB);
            PG8_WAIT_V(6); PG8_BAR; PG8_MMA(1, 1, At, B1); PG8_BAR;
            }
        }
        if constexpr (ALIGN_EPI) { if (wr == 0) PG8_BAR; }
        if constexpr (!Epi::AFTER_DRAIN) { E(acc, cur, wr, wc, fr, fq); S.done(cur); }
        if (!has_next) break;
#pragma unroll
        for (int a = 0; a < 2; ++a)
#pragma unroll
            for (int b = 0; b < 2; ++b)
#pragma unroll
                for (int m = 0; m < 4; ++m)
#pragma unroll
                    for (int n = 0; n < 2; ++n) acc[a][b][m][n] = (f32x4){0.f, 0.f, 0.f, 0.f};
        cur = nxt; cA = nA; cB = nB; ++ui;
        if constexpr (ALIGN_EPI) { if (wr == 1) PG8_BAR; }
    }
    PG8_WAIT_V(0);
    if constexpr (!ALIGN_EPI) { if (wr == 0) PG8_BAR; }
    PG8_BAR;
    if constexpr (Epi::AFTER_DRAIN) { E.fused(acc, cur, wr, wc, fr, fq, lds, wid, lane); S.done(cur); }
#undef PG8_SA
#undef PG8_SB
#undef PG8_STAGE
#undef PG8_LDA
#undef PG8_LDB
#undef PG8_MMA
#undef PG8_WAIT_V
#undef PG8_WAIT_L
#undef PG8_BAR
#undef PG8_SCHED
}
}

namespace mixer {
typedef short bf16x8 __attribute__((ext_vector_type(8)));
typedef short s16x4 __attribute__((ext_vector_type(4)));
typedef float f32x16 __attribute__((ext_vector_type(16)));
typedef unsigned u32x4 __attribute__((ext_vector_type(4)));
typedef float f32x2_t __attribute__((ext_vector_type(2))); typedef __bf16 bf16x2_t __attribute__((ext_vector_type(2)));
__device__ __forceinline__ int crow(int r, int hi) { return (r & 3) + 8 * (r >> 2) + 4 * hi; }
__device__ __forceinline__ unsigned cvtpk(float lo, float hi) { f32x2_t v = {lo, hi}; bf16x2_t b = __builtin_convertvector(v, bf16x2_t); return __builtin_bit_cast(unsigned, b); }
#define MX_SBAR() __builtin_amdgcn_sched_barrier(0)

constexpr int A_K = 0, A_V = 8192, A_G = 16384, A_BUF = 16640  , A_WS = 2 * A_BUF, A_OST = A_WS + 2048, A_BYTES = A_OST + 8 * 8192;
__device__ __forceinline__ void pv(f32x16* o, int vb, bf16x8 pa0, bf16x8 pa1, bf16x8 pa2, bf16x8 pa3) {
#pragma unroll
    for (int d0 = 0; d0 < 2; ++d0) { s16x4 lo[4], hi[4];
#pragma unroll
        for (int ks = 0; ks < 4; ++ks) {
            asm volatile("ds_read_b64_tr_b16 %0,%1 offset:%c2" : "=&v"(lo[ks]) : "v"(vb), "i"(d0 * 4096 + ks * 1024) : "memory");
            asm volatile("ds_read_b64_tr_b16 %0,%1 offset:%c2" : "=&v"(hi[ks]) : "v"(vb), "i"(d0 * 4096 + ks * 1024 + 512) : "memory"); }
        asm volatile("s_waitcnt lgkmcnt(0)" ::: "memory"); MX_SBAR();
#define MX_PK(k) (bf16x8){lo[k][0], lo[k][1], lo[k][2], lo[k][3], hi[k][0], hi[k][1], hi[k][2], hi[k][3]}
        o[d0] = __builtin_amdgcn_mfma_f32_32x32x16_bf16(pa0, MX_PK(0), o[d0], 0, 0, 0);
        o[d0] = __builtin_amdgcn_mfma_f32_32x32x16_bf16(pa1, MX_PK(1), o[d0], 0, 0, 0);
        o[d0] = __builtin_amdgcn_mfma_f32_32x32x16_bf16(pa2, MX_PK(2), o[d0], 0, 0, 0);
        o[d0] = __builtin_amdgcn_mfma_f32_32x32x16_bf16(pa3, MX_PK(3), o[d0], 0, 0, 0);
#undef MX_PK
    }
}
__device__ __forceinline__ void attn_unit(int b, int h, int qb, const bf16_t* Q, const bf16_t* K, const bf16_t* V, const float* GQ, const float* out_g, bf16_t* Y, char* shm) {
    const int tid = TIDX, lane = tid & 63, r32 = lane & 31, hi = lane >> 5; const int wid = __builtin_amdgcn_readfirstlane(tid >> 6);
    const size_t rowbase = (size_t)b * SEQ; const int q0 = qb * 256;
    const bf16_t* Qw = Q + (rowbase + q0 + wid * 32) * 512 + h * 64;
    const bf16_t* Kh = K + rowbase * 512 + h * 64; const bf16_t* Vh = V + rowbase * 512 + h * 64;
    const unsigned lds0 = (unsigned)(uintptr_t)shm;
    float* wsf = (float*)(shm + A_WS) + wid * 64;
    const bf16_t* ksrc = Kh + (size_t)lane * 512 + wid * 8;
    const bf16_t* vsrc = Vh + (size_t)(16 * (wid & 3) + (lane >> 2)) * 512 + (wid >> 2) * 32 + (lane & 3) * 8;
    const int kdo = A_K + wid * 1024 + lane * 16, vdo = A_V + wid * 1024 + lane * 16;
    const int vb0 = (int)(lds0 + A_V) + ((lane >> 4) & 1) * 32 + (lane & 3) * 8 + (4 * hi + ((lane & 15) >> 2)) * 64;
    const int kbo = A_K + hi * 1024 + r32 * 16;
    const int NTL = (q0 + 256) / 64;
    bf16x8 qr[4];
#pragma unroll
    for (int d0 = 0; d0 < 4; ++d0) qr[d0] = *reinterpret_cast<const bf16x8*>(&Qw[(size_t)r32 * 512 + d0 * 16 + hi * 8]);
    const int qrow = q0 + wid * 32 + r32;
    float m_run = -INFINITY, l_run = 0.f; f32x16 o[2]; o[0] = f32x16{}; o[1] = f32x16{};
    uint4 kreg = *(const uint4*)ksrc, vreg = *(const uint4*)vsrc; float greg = (tid < 64) ? -GQ[(rowbase + tid) * 8 + h] : 0.f;
    __syncthreads();
    *(uint4*)(shm + kdo) = kreg; *(uint4*)(shm + vdo) = vreg; if (tid < 64) ((float*)(shm + A_G))[tid] = greg;
    if (NTL > 1) { kreg = *(const uint4*)(ksrc + (size_t)64 * 512); vreg = *(const uint4*)(vsrc + (size_t)64 * 512); if (tid < 64) greg = -GQ[(rowbase + 64 + tid) * 8 + h]; }
    for (int t = 0; t < NTL; ++t) {
        const int cur = (t & 1) * A_BUF, nxt = A_BUF - cur;
        __syncthreads();
        if (t + 1 < NTL) { *(uint4*)(shm + nxt + kdo) = kreg; *(uint4*)(shm + nxt + vdo) = vreg; if (tid < 64) ((float*)(shm + nxt + A_G))[tid] = greg; }
        if (t + 2 < NTL) { kreg = *(const uint4*)(ksrc + (size_t)(t + 2) * 64 * 512); vreg = *(const uint4*)(vsrc + (size_t)(t + 2) * 64 * 512); if (tid < 64) greg = -GQ[(rowbase + (t + 2) * 64 + tid) * 8 + h]; }
        const float* gbl = (const float*)(shm + cur + A_G);
        f32x16 p0, p1;
#pragma unroll
        for (int g = 0; g < 4; ++g) {
            const float4 ga = *(const float4*)(gbl + 8 * g + 4 * hi), gc = *(const float4*)(gbl + 32 + 8 * g + 4 * hi);
            p0[4 * g + 0] = ga.x; p0[4 * g + 1] = ga.y; p0[4 * g + 2] = ga.z; p0[4 * g + 3] = ga.w;
            p1[4 * g + 0] = gc.x; p1[4 * g + 1] = gc.y; p1[4 * g + 2] = gc.z; p1[4 * g + 3] = gc.w; }
        const char* kb = shm + cur + kbo;
#pragma unroll
        for (int d0 = 0; d0 < 4; ++d0) {
            const bf16x8 b0 = *reinterpret_cast<const bf16x8*>(kb + d0 * 2048), b1 = *reinterpret_cast<const bf16x8*>(kb + d0 * 2048 + 512);
            p0 = __builtin_amdgcn_mfma_f32_32x32x16_bf16(b0, qr[d0], p0, 0, 0, 0); p1 = __builtin_amdgcn_mfma_f32_32x32x16_bf16(b1, qr[d0], p1, 0, 0, 0); }
        if (t >= NTL - 4) {
            const int kbase = t * 64 + 4 * hi;
#pragma unroll
            for (int r = 0; r < 16; ++r) { const int kv = kbase + (r & 3) + 8 * (r >> 2); if (kv > qrow) p0[r] = -INFINITY; if (kv + 32 > qrow) p1[r] = -INFINITY; } }
        float rm = fmaxf(p0[0], p1[0]);
#pragma unroll
        for (int r = 1; r < 16; ++r) rm = fmaxf(rm, fmaxf(p0[r], p1[r]));
        rm = fmaxf(rm, __shfl_xor(rm, 32));
        const float m_new = fmaxf(m_run, rm), alpha = __builtin_amdgcn_exp2f(m_run - m_new); m_run = m_new;
        float ps = 0.f;
#pragma unroll
        for (int r = 0; r < 16; ++r) { p0[r] = __builtin_amdgcn_exp2f(p0[r] - m_new); p1[r] = __builtin_amdgcn_exp2f(p1[r] - m_new); ps += p0[r] + p1[r]; }
        l_run = l_run * alpha + ps;
        if (hi == 0) wsf[r32] = alpha;
        WAVE_LDS_FENCE();
#pragma unroll
        for (int g = 0; g < 4; ++g) { const float4 al = *(const float4*)(wsf + 8 * g + 4 * hi);
#pragma unroll
            for (int d = 0; d < 2; ++d) { o[d][4 * g + 0] *= al.x; o[d][4 * g + 1] *= al.y; o[d][4 * g + 2] *= al.z; o[d][4 * g + 3] *= al.w; } }
        WAVE_LDS_FENCE();
        u32x4 pw0, pw1, pw2, pw3;
        pw0 = (u32x4){cvtpk(p0[0], p0[1]), cvtpk(p0[2], p0[3]), cvtpk(p0[4], p0[5]), cvtpk(p0[6], p0[7])};
        pw1 = (u32x4){cvtpk(p0[8], p0[9]), cvtpk(p0[10], p0[11]), cvtpk(p0[12], p0[13]), cvtpk(p0[14], p0[15])};
        pw2 = (u32x4){cvtpk(p1[0], p1[1]), cvtpk(p1[2], p1[3]), cvtpk(p1[4], p1[5]), cvtpk(p1[6], p1[7])};
        pw3 = (u32x4){cvtpk(p1[8], p1[9]), cvtpk(p1[10], p1[11]), cvtpk(p1[12], p1[13]), cvtpk(p1[14], p1[15])};
        MX_SBAR();
        pv(o, vb0 + cur, __builtin_bit_cast(bf16x8, pw0), __builtin_bit_cast(bf16x8, pw1), __builtin_bit_cast(bf16x8, pw2), __builtin_bit_cast(bf16x8, pw3));
    }
    l_run += __shfl_xor(l_run, 32);
    if (hi == 0) wsf[r32] = 1.0f / l_run;
    WAVE_LDS_FENCE();
    float* stg = (float*)(shm + A_OST) + wid * 2048;
#pragma unroll
    for (int r = 0; r < 16; ++r) { const int orow = crow(r, hi); const float rl = wsf[orow];
#pragma unroll
        for (int d0 = 0; d0 < 2; ++d0) stg[orow * 64 + d0 * 32 + r32] = o[d0][r] * rl; }
    WAVE_LDS_FENCE();
    bf16_t* Yw = Y + (rowbase + q0 + wid * 32) * DM + 512 + h * 64;
#pragma unroll
    for (int i = 0; i < 4; ++i) { const int row = i * 8 + (lane >> 3), ch = lane & 7;
        const float4 a = *(const float4*)(stg + row * 64 + ch * 8), c = *(const float4*)(stg + row * 64 + ch * 8 + 4);
        float ss = (a.x * a.x + a.y * a.y) + (a.z * a.z + a.w * a.w) + (c.x * c.x + c.y * c.y) + (c.z * c.z + c.w * c.w);
        ss += __shfl_xor(ss, 1); ss += __shfl_xor(ss, 2); ss += __shfl_xor(ss, 4);
        const float rs = rsqrtf(ss * (1.f / 64) + EPS);
        const float4 g0 = *(const float4*)(out_g + h * 64 + ch * 8), g1 = *(const float4*)(out_g + h * 64 + ch * 8 + 4);
        u32x4 w; w.x = cvtpk(a.x * rs * g0.x, a.y * rs * g0.y); w.y = cvtpk(a.z * rs * g0.z, a.w * rs * g0.w); w.z = cvtpk(c.x * rs * g1.x, c.y * rs * g1.y); w.w = cvtpk(c.z * rs * g1.z, c.w * rs * g1.w);
        *(u32x4*)(Yw + (size_t)row * DM + ch * 8) = w; }
    WAVE_LDS_FENCE();
}

constexpr int SG_PITCH = 136, SG_SLOT = 64 * SG_PITCH * 2;
__device__ __forceinline__ void sgu_pair(int task0, const bf16_t* ZU, const bf16_t* ZV, const bf16_t* SGWB, const float* ln_g, const float* ln_b, const float* sg_b, const float* out_g, bf16_t* Y, char* shm) {
    const int tid = TIDX, lane = tid & 63, r32 = lane & 31, hi = lane >> 5; const int wid = __builtin_amdgcn_readfirstlane(tid >> 6);
    const int slot = wid >> 2, j = wid & 3, task = task0 + slot;
    const int h = task % NH, bc = task / NH, t0 = bc * CHUNK;
    bf16_t* vnT = (bf16_t*)(shm + slot * SG_SLOT);
    bf16x8 bwf[8];
    { const bf16_t* wrow0 = SGWB + ((size_t)h * 128 + 32 * j + r32) * 128 + 8 * hi;
#pragma unroll
      for (int ks = 0; ks < 8; ++ks) bwf[ks] = *reinterpret_cast<const bf16x8*>(wrow0 + 16 * ks); }
    float* gbs = (float*)(shm + 2 * SG_SLOT) + slot * 128;
    { const int tq = tid & 255; if (tq < 128) gbs[tq] = (tq < 64) ? ln_g[h * 64 + tq] : ln_b[h * 64 + tq - 64]; }
    char* stg = shm + 2 * SG_SLOT + 1024 + wid * 4608;
    const bf16_t* zup = ZU + ((size_t)t0 + 32 * j + (lane >> 3)) * 512 + h * 64 + 8 * (lane & 7);
    const uint4 zt0 = *(const uint4*)(zup), zt1 = *(const uint4*)(zup + 8 * 512), zt2 = *(const uint4*)(zup + 16 * 512), zt3 = *(const uint4*)(zup + 24 * 512);
    __syncthreads();
    {
        const int tl = tid & 255, s = tl >> 1, half = tl & 1;
        const bf16_t* zr = ZV + (size_t)(t0 + s) * 512 + h * 64 + half * 32;
        uint4 raw[4]; float v[32]; float sum = 0.f;
#pragma unroll
        for (int i = 0; i < 4; ++i) raw[i] = *(const uint4*)(zr + 8 * i);
#pragma unroll
        for (int i = 0; i < 4; ++i) { const unsigned w[4] = {raw[i].x, raw[i].y, raw[i].z, raw[i].w};
#pragma unroll
            for (int k = 0; k < 4; ++k) { v[8 * i + 2 * k] = __uint_as_float(w[k] << 16); v[8 * i + 2 * k + 1] = __uint_as_float(w[k] & 0xffff0000u); } }
#pragma unroll
        for (int i = 0; i < 32; ++i) sum += v[i];
        sum += __shfl_xor(sum, 1);
        const float mu = sum * (1.f / 64); float var = 0.f;
#pragma unroll
        for (int i = 0; i < 32; ++i) { v[i] -= mu; var += v[i] * v[i]; }
        var += __shfl_xor(var, 1);
        const float rs = rsqrtf(var * (1.f / 64) + EPS);
#pragma unroll
        for (int i = 0; i < 32; ++i) { const int d = half * 32 + i; vnT[d * SG_PITCH + s] = (bf16_t)f2bf(v[i] * rs * gbs[d] + gbs[64 + d]); }
    }
    __syncthreads();
    { char* sp = stg + (lane >> 3) * 144 + 16 * (lane & 7); *(uint4*)(sp) = zt0; *(uint4*)(sp + 8 * 144) = zt1; *(uint4*)(sp + 16 * 144) = zt2; *(uint4*)(sp + 24 * 144) = zt3; }
    f32x16 acc[2]; acc[0] = f32x16{}; acc[1] = f32x16{};
    const int nks = 2 * (j + 1);
#pragma unroll
    for (int ks = 0; ks < 8; ++ks) {
        if (ks >= nks) break;
        const bf16x8 bw = bwf[ks];
        const bf16x8 a0 = *reinterpret_cast<const bf16x8*>(vnT + (size_t)r32 * SG_PITCH + 16 * ks + 8 * hi);
        const bf16x8 a1 = *reinterpret_cast<const bf16x8*>(vnT + (size_t)(32 + r32) * SG_PITCH + 16 * ks + 8 * hi);
        acc[0] = __builtin_amdgcn_mfma_f32_32x32x16_bf16(a0, bw, acc[0], 0, 0, 0);
        acc[1] = __builtin_amdgcn_mfma_f32_32x32x16_bf16(a1, bw, acc[1], 0, 0, 0);
    }
    const int tl = 32 * j + r32; const size_t row = (size_t)t0 + tl;
    const float bs = sg_b[h * 128 + tl];
    float ss = 0.f;
    WAVE_LDS_FENCE();
#pragma unroll
    for (int mb = 0; mb < 2; ++mb)
#pragma unroll
        for (int g = 0; g < 4; ++g) { const int d = 32 * mb + 8 * g + 4 * hi;
            const uint2 z = *(const uint2*)(stg + r32 * 144 + 2 * d);
            const float z0 = __uint_as_float(z.x << 16), z1 = __uint_as_float(z.x & 0xffff0000u), z2 = __uint_as_float(z.y << 16), z3 = __uint_as_float(z.y & 0xffff0000u);
            acc[mb][4 * g + 0] = z0 * (acc[mb][4 * g + 0] + bs); acc[mb][4 * g + 1] = z1 * (acc[mb][4 * g + 1] + bs);
            acc[mb][4 * g + 2] = z2 * (acc[mb][4 * g + 2] + bs); acc[mb][4 * g + 3] = z3 * (acc[mb][4 * g + 3] + bs);
            ss += (acc[mb][4 * g + 0] * acc[mb][4 * g + 0] + acc[mb][4 * g + 1] * acc[mb][4 * g + 1]) + (acc[mb][4 * g + 2] * acc[mb][4 * g + 2] + acc[mb][4 * g + 3] * acc[mb][4 * g + 3]); }
    ss += __shfl_xor(ss, 32);
    const float rs = rsqrtf(ss * (1.f / 64) + EPS);
#pragma unroll
    for (int mb = 0; mb < 2; ++mb)
#pragma unroll
        for (int g = 0; g < 4; ++g) { const int d = 32 * mb + 8 * g + 4 * hi;
            const float4 og = *(const float4*)(out_g + h * 64 + d);
            uint2 w; w.x = cvtpk(acc[mb][4 * g + 0] * rs * og.x, acc[mb][4 * g + 1] * rs * og.y); w.y = cvtpk(acc[mb][4 * g + 2] * rs * og.z, acc[mb][4 * g + 3] * rs * og.w);
            *(uint2*)(stg + r32 * 144 + 2 * d) = w; }
    WAVE_LDS_FENCE();
#pragma unroll
    for (int i = 0; i < 4; ++i) *(uint4*)(Y + ((size_t)t0 + 32 * j + (lane >> 3) + 8 * i) * DM + h * 64 + 8 * (lane & 7)) = *(const uint4*)(stg + ((lane >> 3) + 8 * i) * 144 + 16 * (lane & 7));
    WAVE_LDS_FENCE();
}
#undef MX_SBAR
}

namespace attn2 {
using bf16=unsigned short;
using bf16x8=__attribute__((ext_vector_type(8)))short;
using s16x4=__attribute__((ext_vector_type(4)))short;
using f32x16=__attribute__((ext_vector_type(16)))float;
using u32x4=__attribute__((ext_vector_type(4)))unsigned;
constexpr int BATCH=8,NHEAD=8,SEQ=2048,D=64,DM=NHEAD*D;
constexpr int NW=8,QBLK=32,QB=QBLK*NW,KVBLK=64,NQB=SEQ/QB;
constexpr int ATTN_PITCH=DM, ATTN_UNIT_ROWS=QB;
__device__ __forceinline__ int crow(int r,int hi){return (r&3)+8*(r>>2)+4*hi;}
#define SBAR() __builtin_amdgcn_sched_barrier(0)
__device__ __forceinline__ void cmask(f32x16&p0,f32x16&p1,int jb,int qrel,int hi){
  const float NEG=-INFINITY; int kb=64*jb+4*hi;
  #pragma unroll
  for(int r=0;r<16;++r){int kv=kb+(r&3)+8*(r>>2); if(kv>qrel)p0[r]=NEG; if(kv+32>qrel)p1[r]=NEG;}
}

constexpr int NSLOT=3, SLOTB=8192;
constexpr int LDS_K=0, LDS_V=NSLOT*SLOTB, LDS_G=2*NSLOT*SLOTB  , LDS_WS=LDS_G+1024, LDS_OST=LDS_WS+NW*64*4, LDS_BYTES=LDS_OST+NW*8192;
constexpr float C2_=0.125f*1.4426950408889634f;
__device__ __forceinline__ void glds16(const void*gsrc,unsigned lds_dst){unsigned keep;
  asm volatile("s_mov_b32 %0, m0\n\ts_mov_b32 m0, %2\n\ts_nop 0\n\tglobal_load_lds_dwordx4 %1, off\n\ts_mov_b32 m0, %0":"=&s"(keep):"v"(gsrc),"s"(lds_dst):"memory");}
__device__ __forceinline__ void glds4(const void*gsrc,unsigned lds_dst){unsigned keep;
  asm volatile("s_mov_b32 %0, m0\n\ts_mov_b32 m0, %2\n\ts_nop 0\n\tglobal_load_lds_dword %1, off\n\ts_mov_b32 m0, %0":"=&s"(keep):"v"(gsrc),"s"(lds_dst):"memory");}
__device__ __forceinline__ float max3f(float a,float b,float c){float r;asm("v_max3_f32 %0, %1, %2, %3":"=v"(r):"v"(a),"v"(b),"v"(c));return r;}
__device__ __forceinline__ float max2f(float a,float b){float r;asm("v_max_f32_e32 %0, %1, %2":"=v"(r):"v"(a),"v"(b));return r;}
__device__ __forceinline__ float fadd_s(float a,float b){float r;asm("v_add_f32_e32 %0, %1, %2":"=v"(r):"v"(a),"v"(b));return r;}
__device__ __forceinline__ float fsub_s(float a,float b){float r;asm("v_sub_f32_e32 %0, %1, %2":"=v"(r):"v"(a),"v"(b));return r;}
typedef float f32x2_t __attribute__((ext_vector_type(2))); typedef __bf16 bf16x2_t __attribute__((ext_vector_type(2)));
__device__ __forceinline__ unsigned cvtpk_s(float lo,float hi){f32x2_t v={lo,hi};bf16x2_t b=__builtin_convertvector(v,bf16x2_t);return __builtin_bit_cast(unsigned,b);}
#define WAIT_BAR(N) asm volatile("s_waitcnt vmcnt(" #N ") lgkmcnt(0)\n\ts_barrier":::"memory")

__device__ __forceinline__ void qkt(f32x16&p0,f32x16&p1,const char*Kslot,const bf16x8*qr,int r32,int hi){
  const char*kb=Kslot+hi*1024+r32*16;
  #pragma unroll
  for(int d0=0;d0<4;++d0){
    const bf16x8 b0=*reinterpret_cast<const bf16x8*>(kb+d0*2048);
    const bf16x8 b1=*reinterpret_cast<const bf16x8*>(kb+d0*2048+512);
    p0=__builtin_amdgcn_mfma_f32_32x32x16_bf16(b0,qr[d0],p0,0,0,0);p1=__builtin_amdgcn_mfma_f32_32x32x16_bf16(b1,qr[d0],p1,0,0,0);}
}
typedef __attribute__((address_space(3))) const char* lds_cptr;
typedef short v4i16_t __attribute__((ext_vector_type(4)));
__device__ __forceinline__ void kload8(bf16x8*kf,lds_cptr kp){
  kf[0]=*(const __attribute__((address_space(3))) bf16x8*)(kp);      kf[1]=*(const __attribute__((address_space(3))) bf16x8*)(kp+512);
  kf[2]=*(const __attribute__((address_space(3))) bf16x8*)(kp+2048); kf[3]=*(const __attribute__((address_space(3))) bf16x8*)(kp+2560);
  kf[4]=*(const __attribute__((address_space(3))) bf16x8*)(kp+4096); kf[5]=*(const __attribute__((address_space(3))) bf16x8*)(kp+4608);
  kf[6]=*(const __attribute__((address_space(3))) bf16x8*)(kp+6144); kf[7]=*(const __attribute__((address_space(3))) bf16x8*)(kp+6656);
}
__device__ __forceinline__ void kload2(bf16x8*kf,lds_cptr kp,int j){ kf[2*j]=*(const __attribute__((address_space(3))) bf16x8*)(kp+j*2048); kf[2*j+1]=*(const __attribute__((address_space(3))) bf16x8*)(kp+j*2048+512); }
__device__ __forceinline__ s16x4 vtr(lds_cptr p){ return __builtin_bit_cast(s16x4,__builtin_amdgcn_ds_read_tr16_b64_v4i16((__attribute__((address_space(3))) v4i16_t*)p)); }
__device__ __forceinline__ float rowmax(const f32x16&p0,const f32x16&p1){
  float a=max3f(p0[0],p0[1],p1[0]),b=max3f(p0[2],p0[3],p1[1]);a=max3f(a,p1[2],p1[3]);
  #pragma unroll
  for(int r=4;r<16;r+=4){a=max3f(a,p0[r],p0[r+1]);b=max3f(b,p0[r+2],p0[r+3]);a=max3f(a,p1[r],p1[r+1]);b=max3f(b,p1[r+2],p1[r+3]);}
  const float m=max2f(a,b);
  auto rr=__builtin_amdgcn_permlane32_swap(__float_as_uint(m),__float_as_uint(m),false,false);
  return max2f(__uint_as_float(rr[0]),__uint_as_float(rr[1]));
}
__device__ __forceinline__ void pv(f32x16*o,int vb,bf16x8 pa0,bf16x8 pa1,bf16x8 pa2,bf16x8 pa3){
  #pragma unroll
  for(int d0=0;d0<2;++d0){s16x4 lo[4],hi[4];
    #pragma unroll
    for(int ks=0;ks<4;++ks){
      asm volatile("ds_read_b64_tr_b16 %0,%1 offset:%c2":"=&v"(lo[ks]):"v"(vb),"i"(d0*4096+ks*1024):"memory");
      asm volatile("ds_read_b64_tr_b16 %0,%1 offset:%c2":"=&v"(hi[ks]):"v"(vb),"i"(d0*4096+ks*1024+512):"memory");}
    asm volatile("s_waitcnt lgkmcnt(0)":::"memory");SBAR();
    #define PK(k) (bf16x8){lo[k][0],lo[k][1],lo[k][2],lo[k][3],hi[k][0],hi[k][1],hi[k][2],hi[k][3]}
    o[d0]=__builtin_amdgcn_mfma_f32_32x32x16_bf16(pa0,PK(0),o[d0],0,0,0);
    o[d0]=__builtin_amdgcn_mfma_f32_32x32x16_bf16(pa1,PK(1),o[d0],0,0,0);
    o[d0]=__builtin_amdgcn_mfma_f32_32x32x16_bf16(pa2,PK(2),o[d0],0,0,0);
    o[d0]=__builtin_amdgcn_mfma_f32_32x32x16_bf16(pa3,PK(3),o[d0],0,0,0);
    #undef PK
  }
}

#ifndef ATTN_STORE16
#define ATTN_STORE16(p,v) (*(u32x4*)(p)=(v))
#endif
typedef __attribute__((address_space(3))) const float* lds_fptr; typedef float f32x4_t __attribute__((ext_vector_type(4)));
template<int THRL> __device__ __forceinline__ void attn_unit(int b,int h,int qb,const bf16*Q,const bf16*__restrict__ K,const bf16*__restrict__ V,const float*__restrict__ GT,const float*out_g,bf16*Y,char*shm){
  int tid_=TIDX; asm volatile("":"+v"(tid_));
  const int tid=tid_,lane=tid&63,r32=lane&31,hi=lane>>5; const int wid=__builtin_amdgcn_readfirstlane(tid>>6);
  const long rowbase=(long)b*SEQ; const int q0=qb*QB;
  const bf16*Qw=Q+(rowbase+q0+wid*QBLK)*DM+h*D;
  const bf16*Kh=K+rowbase*DM+h*D,*Vh=V+rowbase*DM+h*D;
  const unsigned lds0=(unsigned)(uintptr_t)shm;
  float*wsf=(float*)(shm+LDS_WS)+wid*64;
  const bf16*ksrc=Kh+(long)lane*DM+wid*8;
  const bf16*vsrc=Vh+(long)(16*(wid&3)+(lane>>2))*DM+(wid>>2)*32+(lane&3)*8;
  const unsigned kdst=lds0+LDS_K+wid*1024, vdst=lds0+LDS_V+wid*1024;
  #define DMA_K(t,slot) glds16(ksrc+(long)(t)*KVBLK*DM,(unsigned)__builtin_amdgcn_readfirstlane(kdst+(slot)))
  #define DMA_V(t,slot) glds16(vsrc+(long)(t)*KVBLK*DM,(unsigned)__builtin_amdgcn_readfirstlane(vdst+(slot)))
  const float*gsrc=GT+((long)b*NHEAD+h)*SEQ+lane; const unsigned gdst=lds0+LDS_G;
  #define DMA_G(t,goff) do{ if(wid==0) glds4(gsrc+(long)(t)*KVBLK,(unsigned)__builtin_amdgcn_readfirstlane(gdst+(goff))); }while(0)
  #define WAIT_BARG(N,N0) do{ if(wid==0){WAIT_BAR(N0);}else{WAIT_BAR(N);} }while(0)
  const int vb0=(int)(lds0+LDS_V)+((lane>>4)&1)*32+(lane&3)*8+(4*hi+((lane&15)>>2))*64;
  const char*Kbase=shm+LDS_K; bf16x8 kf[8];
  const lds_cptr shm3=(lds_cptr)shm; const lds_cptr kp0=shm3+LDS_K+hi*1024+r32*16; const lds_cptr vp0=shm3+LDS_V+((lane>>4)&1)*32+(lane&3)*8+(4*hi+((lane&15)>>2))*64;
  const int NT=(q0+QB)/KVBLK;
  DMA_K(0,0);DMA_G(0,0);DMA_G(1,256);DMA_G(2,512);DMA_V(0,0);DMA_K(1,SLOTB);
  bf16x8 qr[4];
  #pragma unroll
  for(int d0=0;d0<4;++d0)qr[d0]=*reinterpret_cast<const bf16x8*>(&Qw[(long)r32*DM+d0*16+hi*8]);
  float mhat=0.f,l_reg=0.f;f32x16 o[2];o[0]=f32x16{};o[1]=f32x16{};
  const int qrel=wid*QBLK+r32;
  #define CMASK(P0,P1,t) do{int jb_=(t)-(NT-4); if(jb_>=0)cmask(P0,P1,jb_,qrel,hi);}while(0)
  #define CINIT(P0,P1,goff) do{ const lds_fptr gb_=(lds_fptr)(shm3+LDS_G+(goff))+4*hi; \
    _Pragma("unroll") for(int g_=0;g_<4;++g_){ const f32x4_t a_=*(const __attribute__((address_space(3))) f32x4_t*)(gb_+8*g_), c_=*(const __attribute__((address_space(3))) f32x4_t*)(gb_+32+8*g_); \
      P0[4*g_+0]=a_[0]-mhat;P0[4*g_+1]=a_[1]-mhat;P0[4*g_+2]=a_[2]-mhat;P0[4*g_+3]=a_[3]-mhat; P1[4*g_+0]=c_[0]-mhat;P1[4*g_+1]=c_[1]-mhat;P1[4*g_+2]=c_[2]-mhat;P1[4*g_+3]=c_[3]-mhat; } }while(0)
  bool resc=false;
  #define START(P0,P1) do{ const float rm=rowmax(P0,P1); resc=false; \
    { const float dl=rm; mhat=fadd_s(mhat,dl); \
      _Pragma("unroll") for(int r=0;r<16;++r){P0[r]=fsub_s(P0[r],dl);P1[r]=fsub_s(P1[r],dl);} \
      } \
    _Pragma("unroll") for(int r=0;r<16;++r)P0[r]=__builtin_amdgcn_exp2f(P0[r]); }while(0)
  #define RESC() do{ if(resc){ asm volatile("s_waitcnt lgkmcnt(0)":::"memory"); \
      _Pragma("unroll") for(int d_=0;d_<2;++d_) _Pragma("unroll") for(int r=0;r<16;++r)o[d_][r]*=wsf[crow(r,hi)]; } }while(0)
  f32x16 pA0,pA1,pB0,pB1;
  int sl_prev=0,sl_cur=0,sl_next=SLOTB;
  #define ROT() do{sl_prev=sl_cur;sl_cur=sl_next;sl_next=(sl_next==(NSLOT-1)*SLOTB)?0:sl_next+SLOTB;}while(0)
  DMA_K(2,2*SLOTB);
  WAIT_BAR(3);
  CINIT(pA0,pA1,0);
  qkt(pA0,pA1,Kbase,qr,r32,hi);asm volatile("s_nop 15\n\ts_nop 7":"+v"(pA0),"+v"(pA1));CMASK(pA0,pA1,0);
  START(pA0,pA1);
  _Pragma("unroll") for(int r=0;r<16;++r)pA1[r]=__builtin_amdgcn_exp2f(pA1[r]);
  WAIT_BAR(0);
  DMA_K(3,0);DMA_V(1,SLOTB);DMA_G(3,768);
  ROT();
  kload8(kf,kp0+sl_cur);
  CINIT(pB0,pB1,256);
  WAIT_BARG(2,3);
  s16x4 vlo[8],vhi[8]; u32x4 pw0,pw1,pw2,pw3;
  #define PKW(P,B) cvtpk_s(P[B],P[B+1])
  #define PAF(k) __builtin_bit_cast(bf16x8,pw##k)
  #define VFR(i) (bf16x8){vlo[i][0],vlo[i][1],vlo[i][2],vlo[i][3],vhi[i][0],vhi[i][1],vhi[i][2],vhi[i][3]}
  #define PIN(x) asm volatile("":"+v"(x))
  #define MX3(a,b,c) __builtin_fmaxf(__builtin_fmaxf((a),(b)),(c))
  #define GAPA(MF,A0,A1,A2,A3,W0,W1,PW) do{ MF; sacc+=A0; sacc+=A1; sacc+=A2; sacc+=A3; PIN(sacc); W0; W1; PIN(PW); SBAR(); }while(0)
  #define EX(v) __builtin_amdgcn_exp2f(v)
  #define GAPB(MF,X,B) do{ MF; X[B]=EX(X[B]); X[B+1]=EX(X[B+1]); X[B+2]=EX(X[B+2]); X[B+3]=EX(X[B+3]); PIN(X); SBAR(); }while(0)
  #define VRD(i) do{ vlo[i]=vtr(vp_+(((i)>>2)*4096+((i)&3)*1024)); vhi[i]=vtr(vp_+(((i)>>2)*4096+((i)&3)*1024+512)); }while(0)
  #define KRD(G,j) do{ if(G){ kload2(kf,kp0+sl_next,j); SBAR(); } }while(0)
  #define STEP(C0,C1,P0,P1,t,GK,GV,GL) do{ SBAR(); \
    const lds_cptr vp_=vp0+sl_prev; \
    VRD(0); SBAR(); float sacc=(P0[0]+P0[1]); \
    GAPA(C0=__builtin_amdgcn_mfma_f32_32x32x16_bf16(kf[0],qr[0],C0,0,0,0), P0[2],P0[3],P0[4],P0[5],     pw0[0]=PKW(P0,0), pw0[1]=PKW(P0,2), pw0); \
    VRD(4); SBAR(); GAPA(C1=__builtin_amdgcn_mfma_f32_32x32x16_bf16(kf[1],qr[0],C1,0,0,0), P0[6],P0[7],P0[8],P0[9],     pw0[2]=PKW(P0,4), pw0[3]=PKW(P0,6), pw0); \
    VRD(1); SBAR(); GAPA(C0=__builtin_amdgcn_mfma_f32_32x32x16_bf16(kf[2],qr[1],C0,0,0,0),   P0[10],P0[11],P0[12],P0[13], pw1[0]=PKW(P0,8), pw1[1]=PKW(P0,10), pw1); \
    VRD(5); SBAR(); GAPA(C1=__builtin_amdgcn_mfma_f32_32x32x16_bf16(kf[3],qr[1],C1,0,0,0),   P0[14],P0[15],P1[0],P1[1],   pw1[2]=PKW(P0,12),pw1[3]=PKW(P0,14), pw1); \
    VRD(2); SBAR(); GAPA(C0=__builtin_amdgcn_mfma_f32_32x32x16_bf16(kf[4],qr[2],C0,0,0,0),   P1[2],P1[3],P1[4],P1[5],     pw2[0]=PKW(P1,0), pw2[1]=PKW(P1,2), pw2); \
    VRD(6); SBAR(); GAPA(C1=__builtin_amdgcn_mfma_f32_32x32x16_bf16(kf[5],qr[2],C1,0,0,0),   P1[6],P1[7],P1[8],P1[9],     pw2[2]=PKW(P1,4), pw2[3]=PKW(P1,6), pw2); \
    VRD(3); SBAR(); GAPA(C0=__builtin_amdgcn_mfma_f32_32x32x16_bf16(kf[6],qr[3],C0,0,0,0),   P1[10],P1[11],P1[12],P1[13], pw3[0]=PKW(P1,8), pw3[1]=PKW(P1,10), pw3); \
    VRD(7); SBAR(); GAPA(C1=__builtin_amdgcn_mfma_f32_32x32x16_bf16(kf[7],qr[3],C1,0,0,0),   P1[14],P1[15],0.f,0.f,       pw3[2]=PKW(P1,12),pw3[3]=PKW(P1,14), pw3); \
    l_reg+=sacc; \
    if(GK){DMA_K((t)+3,sl_cur);DMA_G((t)+3,(((t)+3)&3)*256);} if(GV){DMA_V((t)+1,sl_next);} \
    CMASK(C0,C1,t); \
    { float a=MX3(C0[0],C0[1],C1[0]),b=MX3(C0[2],C0[3],C1[1]); a=MX3(a,C1[2],C1[3]); \
      _Pragma("unroll") for(int r=4;r<16;r+=4){a=MX3(a,C0[r],C0[r+1]);b=MX3(b,C0[r+2],C0[r+3]);a=MX3(a,C1[r],C1[r+1]);b=MX3(b,C1[r+2],C1[r+3]);} \
      float rm=__builtin_fmaxf(a,b); { auto rr=__builtin_amdgcn_permlane32_swap(__float_as_uint(rm),__float_as_uint(rm),false,false); rm=__builtin_fmaxf(__uint_as_float(rr[0]),__uint_as_float(rr[1])); } \
      resc=false; \
      if(__builtin_expect(__any(rm>(float)THRL),0)){ const float dl=__builtin_fmaxf(rm,0.f); mhat+=dl; \
        _Pragma("unroll") for(int r=0;r<16;++r){C0[r]-=dl;C1[r]-=dl;} \
        const float f=__builtin_amdgcn_exp2f(-dl); l_reg*=f; if(hi==0)wsf[r32]=f; resc=true; } } \
    SBAR(); \
    GAPB(o[0]=__builtin_amdgcn_mfma_f32_32x32x16_bf16(PAF(0),VFR(0),o[0],0,0,0), C0,0); \
    GAPB(o[1]=__builtin_amdgcn_mfma_f32_32x32x16_bf16(PAF(0),VFR(4),o[1],0,0,0), C0,4); \
    KRD(GL,0); GAPB(o[0]=__builtin_amdgcn_mfma_f32_32x32x16_bf16(PAF(1),VFR(1),o[0],0,0,0), C0,8); \
    KRD(GL,1); GAPB(o[1]=__builtin_amdgcn_mfma_f32_32x32x16_bf16(PAF(1),VFR(5),o[1],0,0,0), C0,12); \
    KRD(GL,2); GAPB(o[0]=__builtin_amdgcn_mfma_f32_32x32x16_bf16(PAF(2),VFR(2),o[0],0,0,0), C1,0); \
    KRD(GL,3); GAPB(o[1]=__builtin_amdgcn_mfma_f32_32x32x16_bf16(PAF(2),VFR(6),o[1],0,0,0), C1,4); \
    GAPB(o[0]=__builtin_amdgcn_mfma_f32_32x32x16_bf16(PAF(3),VFR(3),o[0],0,0,0), C1,8); \
    GAPB(o[1]=__builtin_amdgcn_mfma_f32_32x32x16_bf16(PAF(3),VFR(7),o[1],0,0,0), C1,12); \
    if(GL){ CINIT(P0,P1,(((t)+1)&3)*256); } \
    }while(0)
  int t=1;
  #undef CMASK
  #define CMASK(P0,P1,t) do{}while(0)
  for(;t+5<NT;t+=2){
    STEP(pB0,pB1,pA0,pA1,t,true,true,true);     WAIT_BARG(2,3); RESC(); ROT();
    STEP(pA0,pA1,pB0,pB1,t+1,true,true,true);   WAIT_BARG(2,3); RESC(); ROT();
  }
  #undef CMASK
  #define CMASK(P0,P1,t) do{int jb_=(t)-(NT-4); if(jb_>=0)cmask(P0,P1,jb_,qrel,hi);}while(0)
  #define ENDW(tt) do{ if((tt)+3<NT){WAIT_BARG(2,3);} else if((tt)+2<NT){WAIT_BAR(1);} else {WAIT_BAR(0);} }while(0)
  for(;t+1<NT;t+=2){
    STEP(pB0,pB1,pA0,pA1,t,(t+3<NT),(t+1<NT),(t+1<NT));       ENDW(t);   RESC(); ROT();
    STEP(pA0,pA1,pB0,pB1,t+1,(t+4<NT),(t+2<NT),(t+2<NT));     ENDW(t+1); RESC(); ROT();
  }
  STEP(pB0,pB1,pA0,pA1,NT-1,false,false,false); RESC();
  { float sacc=pB0[0]+pB0[1]; _Pragma("unroll") for(int r=2;r<16;++r)sacc+=pB0[r]; _Pragma("unroll") for(int r=0;r<16;++r)sacc+=pB1[r]; l_reg+=sacc;
    pw0=(u32x4){PKW(pB0,0),PKW(pB0,2),PKW(pB0,4),PKW(pB0,6)};pw1=(u32x4){PKW(pB0,8),PKW(pB0,10),PKW(pB0,12),PKW(pB0,14)};pw2=(u32x4){PKW(pB1,0),PKW(pB1,2),PKW(pB1,4),PKW(pB1,6)};pw3=(u32x4){PKW(pB1,8),PKW(pB1,10),PKW(pB1,12),PKW(pB1,14)};
    SBAR(); pv(o,vb0+sl_cur,PAF(0),PAF(1),PAF(2),PAF(3)); }
  #undef PKW
  #undef PAF
  #undef VFR
  #undef PIN
  #undef MX3
  #undef GAPA
  #undef GAPB
  #undef EX
  #undef VRD
  #undef KRD
  #undef STEP
  #undef ENDW
  {auto rr=__builtin_amdgcn_permlane32_swap(__float_as_uint(l_reg),__float_as_uint(l_reg),false,false);l_reg=__uint_as_float(rr[0])+__uint_as_float(rr[1]);}
  if(hi==0)wsf[32+r32]=l_reg;asm volatile("s_waitcnt lgkmcnt(0)":::"memory");
  float rli[16];
  #pragma unroll
  for(int r=0;r<16;++r)rli[r]=__builtin_amdgcn_rcpf(wsf[32+crow(r,hi)]);
  { float*stg=(float*)(shm+LDS_OST)+wid*2048;
    #pragma unroll
    for(int r=0;r<16;++r){const int orow=crow(r,hi);
      #pragma unroll
      for(int d0=0;d0<2;++d0)stg[orow*64+d0*32+r32]=o[d0][r]*rli[r];}
    asm volatile("s_waitcnt lgkmcnt(0)":::"memory");
    bf16*Yw=Y+(rowbase+q0+wid*QBLK)*1024+512+h*D;
    #pragma unroll
    for(int i=0;i<4;++i){const int row=i*8+(lane>>3),ch=lane&7;
      const float4 a=*(const float4*)(stg+row*64+ch*8), c=*(const float4*)(stg+row*64+ch*8+4);
      float ss=(a.x*a.x+a.y*a.y)+(a.z*a.z+a.w*a.w)+(c.x*c.x+c.y*c.y)+(c.z*c.z+c.w*c.w);
      ss+=__shfl_xor(ss,1);ss+=__shfl_xor(ss,2);ss+=__shfl_xor(ss,4);
      const float rs=rsqrtf(ss*(1.f/64)+1e-6f);
      const float4 g0=*(const float4*)(out_g+h*64+ch*8), g1=*(const float4*)(out_g+h*64+ch*8+4);
      u32x4 w; w.x=cvtpk_s(a.x*rs*g0.x,a.y*rs*g0.y); w.y=cvtpk_s(a.z*rs*g0.z,a.w*rs*g0.w); w.z=cvtpk_s(c.x*rs*g1.x,c.y*rs*g1.y); w.w=cvtpk_s(c.z*rs*g1.z,c.w*rs*g1.w);
      ATTN_STORE16(Yw+(long)row*1024+ch*8,w);} }
  asm volatile("s_waitcnt lgkmcnt(0)\n\ts_barrier":::"memory");
  #undef DMA_K
  #undef DMA_V
  #undef DMA_G
  #undef WAIT_BARG
  #undef CINIT
  #undef CMASK
  #undef START
  #undef RESC
  #undef ROT
}
constexpr int ATTN_LDS_BYTES=LDS_BYTES;
#undef SBAR
#undef WAIT_BAR
}

namespace peer {
typedef short bf16x8 __attribute__((ext_vector_type(8)));
typedef float f32x16 __attribute__((ext_vector_type(16)));
__device__ __forceinline__ unsigned umax(unsigned a, unsigned b) { return a > b ? a : b; }
__device__ __forceinline__ unsigned umin(unsigned a, unsigned b) { return a < b ? a : b; }
__device__ __forceinline__ unsigned f2ord(float f) { const unsigned u = __float_as_uint(f); return u ^ ((u >> 31) ? 0xffffffffu : 0x80000000u); }
__device__ __forceinline__ float ord2f(unsigned k) { const unsigned u = k ^ ((k >> 31) ? 0x80000000u : 0xffffffffu); return __uint_as_float(u); }
__device__ __forceinline__ void sort16(unsigned* a) {
#define PEER_CE(i, j) { const unsigned hi_ = umax(a[i], a[j]), lo_ = umin(a[i], a[j]); a[i] = hi_; a[j] = lo_; }
    PEER_CE(0, 13) PEER_CE(1, 12) PEER_CE(2, 15) PEER_CE(3, 14) PEER_CE(4, 8) PEER_CE(5, 6) PEER_CE(7, 11) PEER_CE(9, 10)
    PEER_CE(0, 5) PEER_CE(1, 7) PEER_CE(2, 9) PEER_CE(3, 4) PEER_CE(6, 13) PEER_CE(8, 14) PEER_CE(10, 15) PEER_CE(11, 12)
    PEER_CE(0, 1) PEER_CE(2, 3) PEER_CE(4, 5) PEER_CE(6, 8) PEER_CE(7, 9) PEER_CE(10, 11) PEER_CE(12, 13) PEER_CE(14, 15)
    PEER_CE(0, 2) PEER_CE(1, 3) PEER_CE(4, 10) PEER_CE(5, 11) PEER_CE(6, 7) PEER_CE(8, 9) PEER_CE(12, 14) PEER_CE(13, 15)
    PEER_CE(1, 2) PEER_CE(3, 12) PEER_CE(4, 6) PEER_CE(5, 7) PEER_CE(8, 10) PEER_CE(9, 11) PEER_CE(13, 14)
    PEER_CE(1, 4) PEER_CE(2, 6) PEER_CE(5, 8) PEER_CE(7, 10) PEER_CE(9, 13) PEER_CE(11, 14)
    PEER_CE(2, 4) PEER_CE(3, 6) PEER_CE(9, 12) PEER_CE(11, 13)
    PEER_CE(3, 5) PEER_CE(6, 8) PEER_CE(7, 9) PEER_CE(10, 12)
    PEER_CE(3, 4) PEER_CE(5, 6) PEER_CE(7, 8) PEER_CE(9, 10) PEER_CE(11, 12)
    PEER_CE(6, 7) PEER_CE(8, 9)
#undef PEER_CE
}
__device__ __forceinline__ void merge16(unsigned* a) {
#pragma unroll
    for (int j = 8; j > 0; j >>= 1)
#pragma unroll
        for (int i = 0; i < 16; ++i) { const int l = i ^ j; if (l > i) { const unsigned hi_ = umax(a[i], a[l]), lo_ = umin(a[i], a[l]); a[i] = hi_; a[l] = lo_; } }
}
__device__ __forceinline__ void top16_of_two(unsigned* a, const unsigned* b) {
#pragma unroll
    for (int i = 0; i < 16; ++i) a[i] = umax(a[i], b[15 - i]);
    merge16(a);
}
__device__ __forceinline__ void top16_of_64(unsigned* k) {
    sort16(k); sort16(k + 16); sort16(k + 32); sort16(k + 48);
    top16_of_two(k, k + 16); top16_of_two(k + 32, k + 48); top16_of_two(k, k + 32);
}

constexpr int T_SUBK = 0, T_SCR = 65536;
__device__ __forceinline__ void topk256(int h, int t0, const bf16_t* QV, const bf16_t* SUBK, unsigned short* IDX, float* GATE, char* shm, bool stage) {
    const int lane = lane_id(), r32 = lane & 31, hi = lane >> 5; const int wid = wave_id(); const int tid = wid * 64 + lane;
    __syncthreads();
    if (stage) {
        const uint4* src = (const uint4*)(SUBK + (size_t)h * 2 * NKEYS * DHALF);
#pragma unroll
        for (int q = 0; q < 8; ++q) { const int ci = tid + q * NTHR, n = ci >> 4, ch = ci & 15;
            *(uint4*)(shm + T_SUBK + n * 256 + ((ch ^ (n & 15)) << 4)) = src[ci]; }
    }
    __syncthreads();
    unsigned* lsk = (unsigned*)(shm + T_SCR) + wid * 2048;
    const int tw = t0 + wid * 32;
#pragma unroll
    for (int p = 0; p < 2; ++p) {
        f32x16 acc[4]; acc[0] = f32x16{}; acc[1] = f32x16{}; acc[2] = f32x16{}; acc[3] = f32x16{};
        const unsigned qoff = (unsigned)(((tw + r32) * NQ + h * 256 + p * 128 + 8 * hi) * 2);
        const __amdgpu_buffer_rsrc_t qrs = __builtin_amdgcn_make_buffer_rsrc((void*)QV, 0, 0x7fffffff, 0x00020000);
        bf16x8 bq[8];
#pragma unroll
        for (int ks = 0; ks < 8; ++ks) bq[ks] = __builtin_bit_cast(bf16x8, __builtin_amdgcn_raw_buffer_load_b128(qrs, qoff + 32 * ks, 0,   16));
        const char* kb = shm + T_SUBK + p * 32768 + r32 * 256;
#pragma unroll
        for (int ks = 0; ks < 8; ++ks) {
#pragma unroll
            for (int nb = 0; nb < 4; ++nb) { const bf16x8 ak = *reinterpret_cast<const bf16x8*>(kb + nb * 8192 + (((2 * ks + hi) ^ (r32 & 15)) << 4));
                acc[nb] = __builtin_amdgcn_mfma_f32_32x32x16_bf16(ak, bq[ks], acc[nb], 0, 0, 0); }
        }
        unsigned key[64];
#pragma unroll
        for (int nb = 0; nb < 4; ++nb)
#pragma unroll
            for (int r = 0; r < 16; ++r) { const int n = 32 * nb + (r & 3) + 8 * (r >> 2) + 4 * hi; key[16 * nb + r] = (f2ord(acc[nb][r]) & ~127u) | (unsigned)(127 - n); }
        top16_of_64(key);
        unsigned part[16];
#pragma unroll
        for (int i = 0; i < 16; ++i) part[i] = (unsigned)__shfl_xor((int)key[i], 32);
        top16_of_two(key, part);
#pragma unroll
        for (int i = 0; i < 16; ++i) lsk[(p * 16 + i) * 64 + lane] = key[i];
    }
    WAVE_LDS_FENCE();
    unsigned ck[32];
    {
        float s0h[8], s1[16];
#pragma unroll
        for (int i = 0; i < 8; ++i) s0h[i] = ord2f(lsk[(2 * i + hi) * 64 + lane] & ~127u);
#pragma unroll
        for (int i = 0; i < 16; ++i) s1[i] = ord2f(lsk[(16 + i) * 64 + lane] & ~127u);
        int n = 0;
#pragma unroll
        for (int ah = 0; ah < 8; ++ah)
#pragma unroll
            for (int b = 0; b < 16; ++b) if ((2 * ah + 1) * (b + 1) <= 16) { ck[n] = (f2ord(s0h[ah] + s1[b]) & ~255u) | (unsigned)(255 - ((2 * ah + hi) * 16 + b)); ++n; }
        ck[30] = 0u; ck[31] = 0u;
    }
    sort16(ck); sort16(ck + 16); top16_of_two(ck, ck + 16);
    {
        unsigned part[16];
#pragma unroll
        for (int i = 0; i < 16; ++i) part[i] = (unsigned)__shfl_xor((int)ck[i], 32);
        top16_of_two(ck, part);
    }
    float sc[16]; float sum = 0.f;
#pragma unroll
    for (int i = 0; i < 16; ++i) { sc[i] = ord2f(ck[i] & ~255u); }
    const float mx = sc[0];
#pragma unroll
    for (int i = 0; i < 16; ++i) { sc[i] = __expf(sc[i] - mx); sum += sc[i]; }
    const float inv = 1.0f / sum;
    unsigned short* gidx = IDX + (size_t)(tw + r32) * 128 + 2 * h + hi; float* ggate = GATE + (size_t)(tw + r32) * 128 + h * 16 + 8 * hi;
    int oi[8]; float og[8];
#pragma unroll
    for (int i = 0; i < 16; ++i) {
        const int pos = 255 - (int)(ck[i] & 255u), ia = 127 - (int)(lsk[(pos >> 4) * 64 + lane] & 127u), ib = 127 - (int)(lsk[(16 + (pos & 15)) * 64 + lane] & 127u);
        if ((i >> 3) == 0) { if (hi == 0) { oi[i & 7] = ia * NKEYS + ib; og[i & 7] = sc[i] * inv; } }
        else { if (hi == 1) { oi[i & 7] = ia * NKEYS + ib; og[i & 7] = sc[i] * inv; } }
    }
#pragma unroll
    for (int e = 0; e < 8; ++e) gidx[16 * e] = (unsigned short)oi[e];
    *(float4*)ggate = make_float4(og[0], og[1], og[2], og[3]); *(float4*)(ggate + 4) = make_float4(og[4], og[5], og[6], og[7]);
    WAVE_LDS_FENCE();
}

__device__ __forceinline__ float gelu_as(float v) {
    const float av = fabsf(v), t = __builtin_amdgcn_rcpf(av * 0.2316418882f + 1.0f);
    float q = t * 0.5307027145f + (-0.7265760135f); q = q * t + 0.7107068705f; q = q * t + (-0.142248368f); q = q * t + 0.127414796f; q = q * t;
    const float e = __builtin_amdgcn_exp2f((v * v) * (-0.72134752044f));
    const float m = v * (q * e);
    return v < 0.f ? m : v - m;
}
typedef float f32x2 __attribute__((ext_vector_type(2)));
#ifndef TAB_U4
#define TAB_U4 1
#endif
#ifndef TAB_V4
#define TAB_V4 1
#endif
constexpr bool U4 = TAB_U4 != 0, V4 = TAB_V4 != 0;
constexpr float U_SCALE = U4 ? 64.f : 256.f, V_SCALE = V4 ? 5.65685425f : 16.f;
constexpr size_t SLICE_BYTES = (size_t)NEXP * 128;
__device__ __forceinline__ uint4 ld16_sc1(const void* p) { uint4 r; asm volatile("global_load_dwordx4 %0, %1, off sc1\n\ts_waitcnt vmcnt(0)" : "=&v"(r) : "v"(p) : "memory"); return r; }
}


namespace peer {
typedef int v8i __attribute__((ext_vector_type(8)));
typedef int v4i __attribute__((ext_vector_type(4)));
typedef int v2i __attribute__((ext_vector_type(2)));
typedef float v4f __attribute__((ext_vector_type(4)));
constexpr int G_RING = 0, G_WA = 133120, G_IDXB = G_WA + 16384, G_ZERO = G_IDXB + 2048, G_END = G_ZERO + 64;
constexpr int ONE_E8M0 = 0x7f7f7f7f;
constexpr float XS = 16.f, WSC = 32.f, LO = 16.f;

__device__ __forceinline__ void dma16s(unsigned voff, const void* sbase, unsigned ldsdst) {
    unsigned keep;
    asm volatile("s_mov_b32 %0, m0\n\ts_mov_b32 m0, %3\n\ts_nop 0\n\tglobal_load_lds_dwordx4 %1, %2\n\ts_mov_b32 m0, %0" : "=&s"(keep) : "v"(voff), "s"(sbase), "s"(ldsdst) : "memory");
}
__device__ __forceinline__ void dma4s(unsigned voff, const void* sbase, unsigned ldsdst) {
    unsigned keep;
    asm volatile("s_mov_b32 %0, m0\n\ts_mov_b32 m0, %3\n\ts_nop 0\n\tglobal_load_lds_dword %1, %2\n\ts_mov_b32 m0, %0" : "=&s"(keep) : "v"(voff), "s"(sbase), "s"(ldsdst) : "memory");
}
__device__ __forceinline__ int pk4_fp8(float a, float b, float c, float d) { int w = __builtin_amdgcn_cvt_pk_fp8_f32(a, b, 0, false); return __builtin_amdgcn_cvt_pk_fp8_f32(c, d, w, true); }
__device__ __forceinline__ float clamp_fp8(float v) { return __builtin_amdgcn_fmed3f(v, -448.f, 448.f); }
__device__ __forceinline__ void split4_fp8(float a, float b, float c, float d, int& hi, int& lo) {
    a = clamp_fp8(a); b = clamp_fp8(b); c = clamp_fp8(c); d = clamp_fp8(d);
    hi = pk4_fp8(a, b, c, d);
    const f32x2 h01 = __builtin_amdgcn_cvt_pk_f32_fp8(hi, false), h23 = __builtin_amdgcn_cvt_pk_f32_fp8(hi, true);
    lo = pk4_fp8((a - h01[0]) * LO, (b - h01[1]) * LO, (c - h23[0]) * LO, (d - h23[1]) * LO);
}
__device__ __forceinline__ unsigned sgpr(unsigned v) { return (unsigned)__builtin_amdgcn_readfirstlane((int)v); }
__device__ __forceinline__ const unsigned char* sgpr_ptr(const void* p) { const unsigned long long v = (unsigned long long)p; const unsigned lo = sgpr((unsigned)v), hi = sgpr((unsigned)(v >> 32)); return (const unsigned char*)(((unsigned long long)hi << 32) | lo); }
#define LDS_V4I(addr) (*(const LAS v4i*)(unsigned)(addr))
__device__ __forceinline__ v2i tr4(unsigned addr) { return __builtin_amdgcn_ds_read_tr4_b64_v2i32((LAS v2i*)(unsigned)addr); }
__device__ __forceinline__ v2i tr8(unsigned addr) { return __builtin_amdgcn_ds_read_tr8_b64_v2i32((LAS v2i*)(unsigned)addr); }

#define ISSUE8(BASE, SLOT, W, XC) do { asm volatile("s_waitcnt lgkmcnt(0)" ::: "memory");     \
        _Pragma("unroll") for (int jj = 0; jj < 8; ++jj) { const unsigned w_ = (unsigned)(W)[jj >> 1]; const unsigned e_ = (jj & 1) ? (w_ >> 16) : (w_ & 0xffffu); \
        dma16s((e_ << 7) + ((XC) ? c1 : c0), (BASE), (SLOT) + 1024u * jj); } } while (0)


template <bool UF4, bool VF4>
__device__ __forceinline__ void gather_mx(int t0w, const bf16_t* XG, const float* SSQ, const float* ADA, const unsigned char* EU, const unsigned char* EV,
                                          const unsigned short* IDXT, const float* GATE, const float* final_g, const float* norm2_g, float* out) {
    int lane = lane_id(); int wid = wave_id();
    t0w = __builtin_amdgcn_readfirstlane(t0w);
    asm volatile("" : "+v"(lane), "+s"(wid), "+s"(t0w));
    const int n = lane & 15, kc = lane >> 4, g = lane >> 3, q = lane & 7;
    const int b = t0w / SEQ;
    const unsigned ring = (unsigned)(G_RING + wid * 16384), idxb = (unsigned)(G_IDXB + wid * 256), wa = (unsigned)(G_WA + wid * 2048);
    if (lane < 16) *(LAS unsigned*)(unsigned)(G_ZERO + 4 * lane) = 0u;
    const unsigned c0 = (unsigned)(16 * (q ^ (g >> 1))), c1 = c0 ^ 64u;
    const unsigned char* idxrow = sgpr_ptr(IDXT + (size_t)t0w * 128);
    const unsigned ring_s = sgpr((unsigned)(G_RING + wid * 16384)), idxb_s = sgpr((unsigned)(G_IDXB + wid * 256));
    v4f acc[8];
    {
        v8i AX[8];
        {
            const int ti = n >> 1; const bool lo = (n & 1) != 0;
            const float4 s4 = *(const float4*)(SSQ + (size_t)(t0w + ti) * 4);
            const float rsx = rsqrtf(((s4.x + s4.y) + (s4.z + s4.w)) * (1.f / DM) + EPS) * XS;
            const int cA = UF4 ? 16 * kc : 32 * kc, cB = UF4 ? 64 + 16 * kc : 32 * kc + 16;
            const bf16_t* xr = XG + (size_t)(t0w + ti) * DM; const float* shp = ADA + b * 6 * DM + 3 * DM;
#define AX_LOAD(XW, S0, S1, SB) do { _Pragma("unroll") for (int k = 0; k < 4; ++k) { const int co = 128 * (SB) + ((k < 2) ? cA + 8 * k : cB + 8 * (k - 2)); \
                XW[k] = *(const uint4*)(xr + co); S0[k] = *(const float4*)(shp + co); S1[k] = *(const float4*)(shp + co + 4); } } while (0)
            uint4 xa[4]; float4 s0a[4], s1a[4];
            AX_LOAD(xa, s0a, s1a, 0);
#pragma unroll 1
            for (int sb = 0; sb < 8; ++sb) {
                uint4 xb[4]; float4 s0b[4], s1b[4];
                AX_LOAD(xb, s0b, s1b, (sb + 1) & 7);
                v8i ax;
#pragma unroll
                for (int k = 0; k < 4; ++k) {
                    const uint4 xw = xa[k]; const float4 s0 = s0a[k], s1 = s1a[k];
                    const float v0 = __uint_as_float(xw.x << 16) * rsx + s0.x * XS, v1 = __uint_as_float(xw.x & 0xffff0000u) * rsx + s0.y * XS;
                    const float v2 = __uint_as_float(xw.y << 16) * rsx + s0.z * XS, v3 = __uint_as_float(xw.y & 0xffff0000u) * rsx + s0.w * XS;
                    const float v4 = __uint_as_float(xw.z << 16) * rsx + s1.x * XS, v5 = __uint_as_float(xw.z & 0xffff0000u) * rsx + s1.y * XS;
                    const float v6 = __uint_as_float(xw.w << 16) * rsx + s1.z * XS, v7 = __uint_as_float(xw.w & 0xffff0000u) * rsx + s1.w * XS;
                    int h0, l0, h1, l1; split4_fp8(v0, v1, v2, v3, h0, l0); split4_fp8(v4, v5, v6, v7, h1, l1);
                    ax[2 * k] = lo ? l0 : h0; ax[2 * k + 1] = lo ? l1 : h1;
                }
                *(LAS v4i*)(unsigned)(ring + sb * 2048 + lane * 32) = (v4i){ax[0], ax[1], ax[2], ax[3]};
                *(LAS v4i*)(unsigned)(ring + sb * 2048 + lane * 32 + 16) = (v4i){ax[4], ax[5], ax[6], ax[7]};
#pragma unroll
                for (int k = 0; k < 4; ++k) { xa[k] = xb[k]; s0a[k] = s0b[k]; s1a[k] = s1b[k]; }
            }
#undef AX_LOAD
            WAVE_LDS_FENCE();
#pragma unroll
            for (int sb = 0; sb < 8; ++sb) { const v4i a0 = LDS_V4I(ring + sb * 2048 + lane * 32), a1 = LDS_V4I(ring + sb * 2048 + lane * 32 + 16); AX[sb] = (v8i){a0.x, a0.y, a0.z, a0.w, a1.x, a1.y, a1.z, a1.w}; }
            WAVE_LDS_FENCE();
        }
#pragma unroll
        for (int m = 0; m < 8; ++m) acc[m] = (v4f){0.f, 0.f, 0.f, 0.f};
        const unsigned aU0 = ring + (unsigned)(n * 128 + 16 * (kc ^ (n >> 1))), aU1 = aU0 ^ 64u;
        v4i ia, ib;
        dma4s(4u * lane, idxrow, idxb_s);
        asm volatile("s_waitcnt vmcnt(0)" ::: "memory");
        ia = LDS_V4I(idxb + 32 * g); ib = LDS_V4I(idxb + 32 * g + 16);
        ISSUE8(sgpr_ptr(EU), ring_s, ia, (jj & 1));
#pragma unroll
        for (int sl = 0; sl < (UF4 ? 4 : 8); ++sl) {
            const unsigned char* Ub = sgpr_ptr(EU + (size_t)sl * SLICE_BYTES); const unsigned char* Un = sgpr_ptr(EU + (size_t)((sl + 1) & (UF4 ? 3 : 7)) * SLICE_BYTES);
#pragma unroll 1
            for (int i = 0; i < 8; ++i) {
                dma4s(4u * lane, idxrow + ((i + 1) & 7) * 256, idxb_s);
                ISSUE8(Ub, ring_s + 8192u, ib, (jj & 1));
                asm volatile("s_waitcnt vmcnt(8)" ::: "memory");
                v8i A, A2;
                { const bool mine = (n >> 1) == i;
#pragma unroll
                  for (int k = 0; k < 8; ++k) { A[k] = mine ? AX[UF4 ? 2 * sl : sl][k] : 0; A2[k] = (UF4 && mine) ? AX[UF4 ? 2 * sl + 1 : 0][k] : 0; } }
#define U_MFMA(ACC, B0, B1) do { if (UF4) { const v8i Ba_ = {B0.x, B0.y, B0.z, B0.w, 0, 0, 0, 0}, Bb_ = {B1.x, B1.y, B1.z, B1.w, 0, 0, 0, 0}; \
            ACC = __builtin_amdgcn_mfma_scale_f32_16x16x128_f8f6f4(A, Ba_, ACC, 0, 4, 0, ONE_E8M0, 0, ONE_E8M0); ACC = __builtin_amdgcn_mfma_scale_f32_16x16x128_f8f6f4(A2, Bb_, ACC, 0, 4, 0, ONE_E8M0, 0, ONE_E8M0); } \
        else { const v8i B_ = {B0.x, B0.y, B0.z, B0.w, B1.x, B1.y, B1.z, B1.w}; ACC = __builtin_amdgcn_mfma_scale_f32_16x16x128_f8f6f4(A, B_, ACC, 0, 0, 0, 0, 0, 0); } } while (0)
#pragma unroll
                for (int m = 0; m < 4; ++m) { const v4i b0 = LDS_V4I(aU0 + 2048 * m), b1 = LDS_V4I(aU1 + 2048 * m); U_MFMA(acc[m], b0, b1); }
                ia = LDS_V4I(idxb + 32 * g); ib = LDS_V4I(idxb + 32 * g + 16);
                { const unsigned char* Ux = (i == 7) ? Un : Ub; ISSUE8(Ux, ring_s, ia, (jj & 1)); }
                asm volatile("s_waitcnt vmcnt(8)" ::: "memory");
#pragma unroll
                for (int m = 0; m < 4; ++m) { const v4i b0 = LDS_V4I(aU0 + 8192 + 2048 * m), b1 = LDS_V4I(aU1 + 8192 + 2048 * m); U_MFMA(acc[4 + m], b0, b1); }
#undef U_MFMA
            }
        }
        asm volatile("s_waitcnt vmcnt(0)" ::: "memory");
    }
    asm volatile("" : "+v"(lane) :: "memory");
    {
        const int n2 = lane & 15, rg = lane >> 4;
#pragma unroll
        for (int tt = 0; tt < 2; ++tt) {
            const int ti = 2 * rg + tt; const float* gp = GATE + (size_t)(t0w + ti) * 128 + n2;
#pragma unroll
            for (int m = 0; m < 8; ++m) {
                const float a = (acc[m][2 * tt] + acc[m][2 * tt + 1] * (1.f / LO)) * (1.f / (XS * U_SCALE));
                const float w = clamp_fp8(gp[16 * m] * gelu_as(a) * WSC);
                const int hi = __builtin_amdgcn_cvt_pk_fp8_f32(w, w, 0, false);
                const float wh = __builtin_amdgcn_cvt_pk_f32_fp8(hi, false)[0];
                const int lo = __builtin_amdgcn_cvt_pk_fp8_f32((w - wh) * LO, 0.f, 0, false);
                *(LAS unsigned char*)(unsigned)(wa + (2 * ti) * 128 + 16 * m + n2) = (unsigned char)(hi & 0xff);
                *(LAS unsigned char*)(unsigned)(wa + (2 * ti + 1) * 128 + 16 * m + n2) = (unsigned char)(lo & 0xff);
            }
        }
    }
    WAVE_LDS_FENCE();
    asm volatile("" : "+v"(lane) :: "memory");
    float ss0 = 0.f, ss1 = 0.f;
    constexpr int NSPILL = VF4 ? 0 : 2;
    uint2 X2K[((VF4 ? 4 : 8) - NSPILL) * 2 * (VF4 ? 4 : 2)];
    {
        constexpr int NSV = VF4 ? 4 : 8, NCB = VF4 ? 16 : 8, SLW = VF4 ? 256 : 128;
        const int n2 = lane & 15, kc2 = lane >> 4, kk = kc2 & 1, g2 = lane >> 3;
        unsigned tV[8];
#pragma unroll
        for (int c = 0; c < 8; ++c) tV[c] = VF4 ? ring + (unsigned)((32 * (kc2 >> 1) + n2) * 128 + 16 * (c ^ (n2 >> 1)))
                                                : ring + (unsigned)((32 * kk + (n2 >> 1)) * 128 + 8 * (n2 & 1) + 16 * (c ^ ((n2 >> 2) ^ (4 * kk))));
        const unsigned aW = VF4 ? wa + (unsigned)(n2 * 128 + 16 * kc2) : wa + (unsigned)(n2 * 128 + 32 * kk);
        v4i ia, ib;
        dma4s(4u * lane, idxrow, idxb_s);
        asm volatile("s_waitcnt vmcnt(0)" ::: "memory");
        ia = LDS_V4I(idxb + 32 * g2); ib = LDS_V4I(idxb + 32 * g2 + 16);
#define VXC (VF4 ? (jj & 1) : (jj >= 4))
        ISSUE8(sgpr_ptr(EV), ring_s, ia, VXC);
        const float* gate2 = ADA + b * 6 * DM + 5 * DM + 4 * n2;
        float* orow = out + (size_t)(t0w + 2 * kc2) * DM + 4 * n2; const bf16_t* xgrow = XG + (size_t)(t0w + 2 * kc2) * DM + 4 * n2;
#define V_CONSUME(SLOTOFF) do { _Pragma("unroll") for (int cb = 0; cb < NCB; ++cb) { \
            if (VF4) { const v2i b0 = tr4(tV[cb >> 1] + 8 * (cb & 1) + (SLOTOFF)), b1 = tr4(tV[cb >> 1] + 8 * (cb & 1) + (SLOTOFF) + 2048); \
                const v8i B = {b0.x, b0.y, b1.x, b1.y, 0, 0, 0, 0}; C[cb] = __builtin_amdgcn_mfma_scale_f32_16x16x128_f8f6f4(A, B, C[cb], 0, 4, 0, ONE_E8M0, 0, ONE_E8M0); } \
            else { const v2i b0 = tr8(tV[cb & 7] + (SLOTOFF)), b1 = tr8(tV[cb & 7] + (SLOTOFF) + 1024), b2 = tr8(tV[cb & 7] + (SLOTOFF) + 2048), b3 = tr8(tV[cb & 7] + (SLOTOFF) + 3072); \
                const v8i B = {b0.x, b0.y, b1.x, b1.y, b2.x, b2.y, b3.x, b3.y}; C[cb] = __builtin_amdgcn_mfma_scale_f32_16x16x128_f8f6f4(A, B, C[cb], 0, 0, 0, 0, 0, 0); } \
            if ((cb & 1) == 1) __builtin_amdgcn_sched_barrier(0);     } } while (0)
#pragma unroll 1
        for (int sl = 0; sl < NSV; ++sl) {
            const unsigned char* Vb = sgpr_ptr(EV + (size_t)sl * SLICE_BYTES); const unsigned char* Vn = sgpr_ptr(EV + (size_t)((sl + 1) & (NSV - 1)) * SLICE_BYTES);
            v4f C[NCB];
#pragma unroll
            for (int cb = 0; cb < NCB; ++cb) C[cb] = (v4f){0.f, 0.f, 0.f, 0.f};
#pragma unroll 1
            for (int i = 0; i < 8; ++i) {
                const bool mine = ((n2 >> 1) == i) && (kc2 < 2);
                const unsigned aA = mine ? aW : (unsigned)G_ZERO;
                dma4s(4u * lane, idxrow + ((i + 1) & 7) * 256, idxb_s);
                ISSUE8(Vb, ring_s + 8192u, ib, VXC);
                asm volatile("s_waitcnt vmcnt(8)" ::: "memory");
                { const v4i a0 = LDS_V4I(aA), a1 = LDS_V4I(aA + (VF4 ? 32 : 16)); const v8i A = {a0.x, a0.y, a0.z, a0.w, a1.x, a1.y, a1.z, a1.w};
                  V_CONSUME(0); }
                ia = LDS_V4I(idxb + 32 * g2); ib = LDS_V4I(idxb + 32 * g2 + 16);
                { const unsigned char* Vx = (i == 7) ? Vn : Vb; ISSUE8(Vx, ring_s, ia, VXC); }
                asm volatile("s_waitcnt vmcnt(8)" ::: "memory");
                { const v4i a0 = LDS_V4I(aA + (mine ? 64 : 0)), a1 = LDS_V4I(aA + (mine ? (VF4 ? 96 : 80) : (VF4 ? 32 : 16))); const v8i A = {a0.x, a0.y, a0.z, a0.w, a1.x, a1.y, a1.z, a1.w};
                  V_CONSUME(8192); }
            }
#pragma unroll
            for (int tt = 0; tt < 2; ++tt)
#pragma unroll
                for (int cg = 0; cg < NCB / 4; ++cg) {
                    float* p = orow + (size_t)tt * DM + SLW * sl + 64 * cg;
                    const uint2 xw = *(const uint2*)(xgrow + (size_t)tt * DM + SLW * sl + 64 * cg);
                    const float4 gn = *(const float4*)(norm2_g + 4 * n2 + SLW * sl + 64 * cg), s2 = *(const float4*)(gate2 - DM + SLW * sl + 64 * cg);
                    float4 x1; x1.x = __uint_as_float(xw.x << 16) * __builtin_amdgcn_rcpf(gn.x * (1.f + s2.x)); x1.y = __uint_as_float(xw.x & 0xffff0000u) * __builtin_amdgcn_rcpf(gn.y * (1.f + s2.y));
                    x1.z = __uint_as_float(xw.y << 16) * __builtin_amdgcn_rcpf(gn.z * (1.f + s2.z)); x1.w = __uint_as_float(xw.y & 0xffff0000u) * __builtin_amdgcn_rcpf(gn.w * (1.f + s2.w));
                    const float4 gt = *(const float4*)(gate2 + SLW * sl + 64 * cg);
                    constexpr float SC = 1.f / (WSC * V_SCALE);
                    float4 x2;
                    x2.x = x1.x + gt.x * ((C[4 * cg + 0][2 * tt] + C[4 * cg + 0][2 * tt + 1] * (1.f / LO)) * SC);
                    x2.y = x1.y + gt.y * ((C[4 * cg + 1][2 * tt] + C[4 * cg + 1][2 * tt + 1] * (1.f / LO)) * SC);
                    x2.z = x1.z + gt.z * ((C[4 * cg + 2][2 * tt] + C[4 * cg + 2][2 * tt + 1] * (1.f / LO)) * SC);
                    x2.w = x1.w + gt.w * ((C[4 * cg + 3][2 * tt] + C[4 * cg + 3][2 * tt + 1] * (1.f / LO)) * SC);
                    const float sq = (x2.x * x2.x + x2.y * x2.y) + (x2.z * x2.z + x2.w * x2.w);
                    if (tt == 0) ss0 += sq; else ss1 += sq;
                    const uint2 pk = make_uint2(pg8::cvt_pk_bf16(x2.x, x2.y), pg8::cvt_pk_bf16(x2.z, x2.w));
                    if (sl < NSPILL) *(float4*)p = x2;
#pragma unroll
                    for (int k = NSPILL; k < NSV; ++k) if (sl == k) X2K[((k - NSPILL) * 2 + tt) * (NCB / 4) + cg] = pk;
                    if (cg & 1) __builtin_amdgcn_sched_barrier(0);
                }
        }
#undef V_CONSUME
#undef VXC
        asm volatile("s_waitcnt vmcnt(0)" ::: "memory");
    }
#pragma unroll
    for (int o = 1; o < 16; o <<= 1) { ss0 += __shfl_xor(ss0, o); ss1 += __shfl_xor(ss1, o); }
    asm volatile("" : "+v"(lane) :: "memory");
    {
        constexpr int NSV = VF4 ? 4 : 8, NCG = VF4 ? 4 : 2, SLW = VF4 ? 256 : 128;
        const int n2 = lane & 15, rg = lane >> 4;
        const float r0 = rsqrtf(ss0 * (1.f / DM) + EPS), r1 = rsqrtf(ss1 * (1.f / DM) + EPS);
        float* orow = out + (size_t)(t0w + 2 * rg) * DM + 4 * n2; const float* fgp = final_g + 4 * n2;
#pragma unroll
        for (int sl = 0; sl < NSV; ++sl)
#pragma unroll
            for (int cg = 0; cg < NCG; ++cg) {
                const float4 fg = *(const float4*)(fgp + SLW * sl + 64 * cg);
#pragma unroll
                for (int tt = 0; tt < 2; ++tt) {
                    const float rs = tt ? r1 : r0; float4 o; float* p = orow + (size_t)tt * DM + SLW * sl + 64 * cg;
                    if (sl >= NSPILL) { const uint2 w = X2K[((sl - NSPILL) * 2 + tt) * NCG + cg];
                        o.x = __uint_as_float(w.x << 16) * rs * fg.x; o.y = __uint_as_float(w.x & 0xffff0000u) * rs * fg.y;
                        o.z = __uint_as_float(w.y << 16) * rs * fg.z; o.w = __uint_as_float(w.y & 0xffff0000u) * rs * fg.w; }
                    else { const uint4 raw = ld16_sc1(p);
                        o.x = __uint_as_float(raw.x) * rs * fg.x; o.y = __uint_as_float(raw.y) * rs * fg.y; o.z = __uint_as_float(raw.z) * rs * fg.z; o.w = __uint_as_float(raw.w) * rs * fg.w; }
                    __builtin_nontemporal_store((pg8::f32x4){o.x, o.y, o.z, o.w}, (pg8::f32x4*)p);
                }
            }
    }
    WAVE_LDS_FENCE();
}
}

using pg8::bf16x8; using pg8::f32x4;
#define XB_TMO      128
#define XB_XCNT(j)  (256  + 64 * (j))
#define XB_XSUB(j)  (1280 + 64 * (j))
#define XB_XGEN(j)  (2304 + 64 * (j))
#define XB_TOP      3328
#define XB_TOPGEN   3392
#define XCD_BAR_WORDS 3456
#define XB_SPIN_CAP (1u << 18)
__device__ __forceinline__ unsigned xb_ld(unsigned* p)              { return __hip_atomic_load(p, __ATOMIC_RELAXED, __HIP_MEMORY_SCOPE_AGENT); }
__device__ __forceinline__ unsigned xb_add(unsigned* p, unsigned v) { return __hip_atomic_fetch_add(p, v, __ATOMIC_RELAXED, __HIP_MEMORY_SCOPE_AGENT); }
__device__ __forceinline__ unsigned xb_xcc_id() { return (unsigned)__builtin_amdgcn_s_getreg((3 << 11) | 20) & 0xFu; }
#define XB_SPIN(cond, bar) do { unsigned _sp = 0; while (cond) { __builtin_amdgcn_s_sleep(1); \
    if ((++_sp & 255u) == 0u) { if (xb_ld(&(bar)[XB_TMO])) break; if (_sp > XB_SPIN_CAP) { atomicAdd(&(bar)[XB_TMO], 1u); break; } } } } while (0)
struct XcdBarrier { unsigned* bar; unsigned x; volatile LAS unsigned* st; };
__device__ __forceinline__ XcdBarrier xcd_barrier_post(unsigned* bar, volatile LAS unsigned* st) {
    XcdBarrier b; b.bar = bar; b.x = xb_xcc_id(); b.st = st;
    if (TIDX == 0) (void)xb_add(&bar[XB_XCNT(b.x)], 1u);
    return b;
}
__device__ __forceinline__ void xcd_barrier_complete(unsigned* bar, unsigned x, unsigned& nloc, unsigned& nx) {
    const unsigned G = gridDim.x * gridDim.y * gridDim.z;
    unsigned sum, cnt, mine, sp = 0u;
    for (;;) {
        sum = 0u; cnt = 0u; mine = 0u;
#pragma unroll
        for (unsigned j = 0; j < 16; ++j) { const unsigned c = xb_ld(&bar[XB_XCNT(j)]); sum += c; cnt += (c > 0u) ? 1u : 0u; mine = (j == x) ? c : mine; }
        if (sum == G) break;
        __builtin_amdgcn_s_sleep(1);
        if ((++sp & 255u) == 0u) { if (xb_ld(&bar[XB_TMO])) break; if (sp > XB_SPIN_CAP) { atomicAdd(&bar[XB_TMO], 1u); break; } }
    }
    nloc = mine > 0u ? mine : 1u; nx = cnt > 0u ? cnt : 1u;
}
__device__ __forceinline__ void xcd_barrier(const XcdBarrier& b) {
    asm volatile("s_waitcnt vmcnt(0)" ::: "memory");
    __syncthreads();
    if (TIDX == 0) {
        unsigned* bar = b.bar;
        __builtin_amdgcn_s_waitcnt(0);
        unsigned nloc = b.st[0], nx = b.st[1];
        if (nloc == 0u) { xcd_barrier_complete(bar, b.x, nloc, nx); b.st[0] = nloc; b.st[1] = nx; }
        const unsigned old = xb_add(&bar[XB_XSUB(b.x)], 1u);
        const unsigned gen = old / nloc;
        if (old + 1u == (gen + 1u) * nloc) {
            __builtin_amdgcn_fence(__ATOMIC_RELEASE, "agent");
            asm volatile("s_waitcnt vmcnt(0)" ::: "memory");
            (void)xb_add(&bar[XB_TOP], 1u);
            XB_SPIN(xb_ld(&bar[XB_TOP]) < (gen + 1u) * nx, bar);
            __builtin_amdgcn_fence(__ATOMIC_ACQUIRE, "agent");
            xb_add(&bar[XB_XGEN(b.x)], 1u);
            asm volatile("s_waitcnt vmcnt(0)" ::: "memory");
        } else {
            __builtin_amdgcn_fence(__ATOMIC_ACQUIRE, "agent");
            XB_SPIN(xb_ld(&bar[XB_XGEN(b.x)]) == gen, bar);
            asm volatile("s_waitcnt vmcnt(0)" ::: "memory");
        }
    }
    __syncthreads();
}
__device__ unsigned g_bar[XCD_BAR_WORDS + 64];
constexpr int LDS_BYTES = 155648, LDSCTL_OFF = 131072, MISC_OFF = LDSCTL_OFF + 320;

__device__ __forceinline__ void gemv8_task(float* lds, const float* W, int ldw, int n0, const float* bias, float* out, int ldo, int tid) {
    const int wave = tid >> 6, lane = tid & 63;
    float acc[8];
#pragma unroll
    for (int b = 0; b < 8; ++b) acc[b] = 0.f;
    const float* wp = W + (size_t)(wave * 128) * ldw + n0 + lane;
    const float* As = lds + wave * 128;
#pragma unroll 1
    for (int k = 0; k < 128; k += 16) {
        float wv[16];
#pragma unroll
        for (int i = 0; i < 16; ++i) wv[i] = wp[(size_t)(k + i) * ldw];
#pragma unroll
        for (int i = 0; i < 16; ++i)
#pragma unroll
            for (int b = 0; b < 8; ++b) acc[b] = fmaf(As[b * 1024 + k + i], wv[i], acc[b]);
    }
    float* red = lds + 8192;
#pragma unroll
    for (int b = 0; b < 8; ++b) red[(wave * 8 + b) * 64 + lane] = acc[b];
    __syncthreads();
    { const int b = tid >> 6; float s = 0.f;
#pragma unroll
      for (int w = 0; w < 8; ++w) s += red[(w * 8 + b) * 64 + lane];
      out[b * ldo + n0 + lane] = s + (bias ? bias[n0 + lane] : 0.f); }
    __syncthreads();
}
__device__ __forceinline__ void gemv8_task32(float* lds, const float* W, int ldw, int n0, const float* bias, float* out, int ldo, int tid, bool wt = false) {
    const int wave = tid >> 6, lane = tid & 63, col = lane & 31, kh = lane >> 5;
    float acc[8];
#pragma unroll
    for (int b = 0; b < 8; ++b) acc[b] = 0.f;
    const int kbase = wave * 128 + kh * 64;
    const float* wp = W + (size_t)kbase * ldw + n0 + col;
    const float* As = lds + kbase;
#pragma unroll 1
    for (int k = 0; k < 64; k += 16) {
        float wv[16];
#pragma unroll
        for (int i = 0; i < 16; ++i) wv[i] = __builtin_nontemporal_load(wp + (size_t)(k + i) * ldw);
#pragma unroll
        for (int i = 0; i < 16; ++i)
#pragma unroll
            for (int b = 0; b < 8; ++b) acc[b] = fmaf(As[b * 1024 + k + i], wv[i], acc[b]);
    }
    float* red = lds + 8192;
#pragma unroll
    for (int b = 0; b < 8; ++b) { acc[b] += __shfl_xor(acc[b], 32); if (kh == 0) red[(wave * 8 + b) * 32 + col] = acc[b]; }
    __syncthreads();
    if (tid < 256) { const int b = tid >> 5, c = tid & 31; float s = 0.f;
#pragma unroll
      for (int w = 0; w < 8; ++w) s += red[(w * 8 + b) * 32 + c];
      const float r_ = s + (bias ? bias[n0 + c] : 0.f);
      if (wt) __hip_atomic_store(&out[b * ldo + n0 + c], r_, __ATOMIC_RELAXED, __HIP_MEMORY_SCOPE_AGENT); else out[b * ldo + n0 + c] = r_; }
    __syncthreads();
}
__device__ __forceinline__ void transpose_item(const float* W, int K, int ldw, int nblk, bf16_t* WT, float* scr, int item, int lane) {
    const int kb = item / nblk, nb = item % nblk, k0 = 64 * kb, n0 = 32 * nb;
#pragma unroll 8
    for (int i = 0; i < 32; ++i) { const int kk = 2 * i + (lane >> 5); scr[kk * 33 + (lane & 31)] = __builtin_nontemporal_load(W + (size_t)(k0 + kk) * ldw + n0 + (lane & 31)); }
    WAVE_LDS_FENCE();
    const int c = lane & 7;
#pragma unroll
    for (int j = 0; j < 4; ++j) { const int n = (lane >> 3) + 8 * j; const float* s = scr + (8 * c) * 33 + n;
        uint4 o; o.x = pk2(s[0 * 33], s[1 * 33]); o.y = pk2(s[2 * 33], s[3 * 33]); o.z = pk2(s[4 * 33], s[5 * 33]); o.w = pk2(s[6 * 33], s[7 * 33]);
        *(uint4*)(WT + (size_t)(n0 + n) * K + k0 + 8 * c) = o; }
    WAVE_LDS_FENCE();
}
__device__ __forceinline__ void cvt512(const float* src, bf16_t* dst, int lane) {
    const float4 a = *(const float4*)(src + 8 * lane), b = *(const float4*)(src + 8 * lane + 4);
    uint4 o; o.x = pk2(a.x, a.y); o.y = pk2(a.z, a.w); o.z = pk2(b.x, b.y); o.w = pk2(b.z, b.w);
    *(uint4*)(dst + 8 * lane) = o;
}

#ifndef PROBE_REP
#define PROBE_REP -1
#endif
#define PHASE_IDS() int lane = lane_id(); asm volatile("" : "+v"(lane)); const int wave = wave_id(); const int tid = wave * 64 + lane; const int gw = blockIdx.x * NWAVE + wave; (void)tid; (void)gw
#define REP(k) for (int rep_ = 0; rep_ < ((PROBE_REP) == (k) ? 2 : 1); ++rep_)
struct QueryOrder {
    int c;
    __device__ __forceinline__ bool next(int i, pg8::Unit& u) const { if (i >= 2) return false; const int x = c & 7, k = c >> 3; u.pn = k & 7; u.pm = 8 * x + 2 * (k >> 3) + i; return true; }
    __device__ __forceinline__ void a_ready(const pg8::Unit&) const {}
    __device__ __forceinline__ void done(const pg8::Unit&) const {}
};
__global__ void __launch_bounds__(NTHR, 2) fwd_kernel(Args a) {
    extern __shared__ __attribute__((aligned(16))) unsigned char lds_raw[];
    float* lds = (float*)lds_raw;
    unsigned char* ws = a.ws;
    float* ADA = (float*)(ws + WS_ADA); float* SQB = (float*)(ws + WS_SQB); float* FL = (float*)(ws + WS_FL); float* GQ = (float*)(ws + WS_GQ); float* SSQ = (float*)(ws + WS_SSQ);
    bf16_t* WIN = (bf16_t*)(ws + WS_WIN); bf16_t* WOUT = (bf16_t*)(ws + WS_WOUT); bf16_t* WQ = (bf16_t*)(ws + WS_WQ); bf16_t* SUBK = (bf16_t*)(ws + WS_SUBK); bf16_t* SGWB = (bf16_t*)(ws + WS_SGW);
    float* GT = (float*)(ws + WS_GX); unsigned char* EU = ws + WS_EU; unsigned char* EV = ws + WS_EV; bf16_t* HB = (bf16_t*)(ws + WS_HB);
    bf16_t* ZU = (bf16_t*)(ws + WS_ZU); bf16_t* ZV = (bf16_t*)(ws + WS_ZV); bf16_t* Q = (bf16_t*)(ws + WS_Q); bf16_t* K = (bf16_t*)(ws + WS_K); bf16_t* V = (bf16_t*)(ws + WS_V);
    bf16_t* XG = (bf16_t*)(ws + WS_XG); bf16_t* QV = (bf16_t*)(ws + WS_QV); unsigned short* IDX = (unsigned short*)(ws + WS_IDX); float* GATE = (float*)(ws + WS_GATE);
    for (int u = threadIdx.x; u < (LDS_BYTES - LDSCTL_OFF) / 4; u += NTHR) ((LAS unsigned*)((LAS unsigned char*)lds_raw + LDSCTL_OFF))[u] = 0u;
    __syncthreads();
    if ((threadIdx.x & 63) == 0) *(LAS int*)(unsigned)(WTAB_OFF + 4 * hw_slot()) = (int)(threadIdx.x >> 6);
    __syncthreads();
    const int lane = lane_id(), wave = wave_id(), tid = wave * 64 + lane;
    const int gw = blockIdx.x * NWAVE + wave, ngw = gridDim.x * NWAVE;
    XcdBarrier bar = xcd_barrier_post(g_bar, (volatile LAS unsigned*)((LAS unsigned char*)lds_raw + MISC_OFF) + 8);
#ifndef TS_SEL
#define TS_SEL -2
#endif
    unsigned long long ts_[8]; ts_[0] = 0ull;
    int ts_n = 0;
#define GRID_BAR() do { xcd_barrier(bar); if ((TS_SEL) > -2) ts_[++ts_n] = __builtin_amdgcn_s_memrealtime(); } while (0)
    if ((TS_SEL) > -2) ts_[0] = __builtin_amdgcn_s_memrealtime();

    REP(0) {
        PHASE_IDS();
        if (blockIdx.x < 192) {
            for (int i = tid; i < NB * DM; i += NTHR) { const float cv = a.c[i]; lds[i] = cv / (1.f + expf(-cv)); }
            __syncthreads();
            gemv8_task32(lds, a.w_ada, 6 * DM, blockIdx.x * 32, a.b_ada, ADA, 6 * DM, tid, blockIdx.x < 64);
            if (blockIdx.x < 64) {
                asm volatile("s_waitcnt vmcnt(0)" ::: "memory"); __syncthreads();
                if (tid == 0) (void)xb_add(&g_bar[XCD_BAR_WORDS + 40], 1u);
            }
        }
        float* scr = lds + 12288 + wave * 2112;
        constexpr int I_IN = 16 * 80, I_OUT = 16 * 32, I_Q = 16 * 64;
        for (int rnd = 0; rnd < 3; ++rnd) {
            int it;
            if (blockIdx.x >= 192) { const int w2 = gw - 192 * NWAVE; it = (rnd < 2) ? w2 + 512 * rnd : ((w2 < 256) ? 1024 + w2 : -1); }
            else it = (rnd == 0) ? 1280 + gw : -1;
            if (it < 0) continue;
            int r = it;
            if (r < I_IN) { transpose_item(a.w_in, DM, INC, 80, WIN, scr, r, lane); continue; } r -= I_IN;
            if (r < I_OUT) { transpose_item(a.w_out, DM, DM, 32, WOUT, scr, r, lane); continue; } r -= I_OUT;
            transpose_item(a.w_query, DM, NQ, 64, WQ, scr, r, lane);
        }
        for (int it = gw; it < 512; it += ngw) cvt512(a.sub_keys + (size_t)it * 512, SUBK + (size_t)it * 512, lane);
        for (int it = gw; it < 256; it += ngw) {
            const int e0 = it * 512 + 8 * lane, t = (e0 >> 7) & 127, s0 = e0 & 127;
            const float4 p = *(const float4*)(a.sg_w + e0), q = *(const float4*)(a.sg_w + e0 + 4);
            const float v[8] = {p.x, p.y, p.z, p.w, q.x, q.y, q.z, q.w}; float m[8];
#pragma unroll
            for (int i = 0; i < 8; ++i) m[i] = (s0 + i <= t) ? v[i] : 0.f;
            uint4 o; o.x = pk2(m[0], m[1]); o.y = pk2(m[2], m[3]); o.z = pk2(m[4], m[5]); o.w = pk2(m[6], m[7]);
            *(uint4*)(SGWB + e0) = o;
        }
    }
    REP(1) {
        PHASE_IDS();
        __syncthreads();
        for (int i = tid; i < 8 * DM; i += NTHR) { const int k = i >> 3, j = i & 7; lds[j * DM + k] = a.w_in[(size_t)k * INC + NPROJ + j]; }
        if (tid == 0) { XB_SPIN(xb_ld(&g_bar[XCD_BAR_WORDS + 40]) < 64u, g_bar); __builtin_amdgcn_fence(__ATOMIC_ACQUIRE, "agent"); asm volatile("s_waitcnt vmcnt(0)" ::: "memory"); }
        __syncthreads();
        for (int t0 = gw * 8; t0 < NT; t0 += ngw * 8) {
            const int b = t0 / SEQ; const float* shift = ADA + b * 6 * DM; const float* scale = shift + DM;
            float4 mm[4], sh[4];
#pragma unroll
            for (int j = 0; j < 4; ++j) { const int c = 256 * j + 4 * lane; const float4 gg = *(const float4*)(a.norm1_g + c), sc = *(const float4*)(scale + c); sh[j] = *(const float4*)(shift + c);
                mm[j].x = gg.x * (1.f + sc.x); mm[j].y = gg.y * (1.f + sc.y); mm[j].z = gg.z * (1.f + sc.z); mm[j].w = gg.w * (1.f + sc.w); }
#pragma unroll 1
            for (int hf = 0; hf < 2; ++hf) {
                float4 v[4][4];
#pragma unroll
                for (int r = 0; r < 4; ++r)
#pragma unroll
                    for (int j = 0; j < 4; ++j) { const pg8::f32x4 nt_ = __builtin_nontemporal_load((const pg8::f32x4*)(a.x + (size_t)(t0 + 4 * hf + r) * DM + 256 * j + 4 * lane)); v[r][j] = make_float4(nt_[0], nt_[1], nt_[2], nt_[3]); }
#pragma unroll
                for (int r = 0; r < 4; ++r) {
                    const int t = t0 + 4 * hf + r; float s = 0.f;
#pragma unroll
                    for (int j = 0; j < 4; ++j) s += v[r][j].x * v[r][j].x + v[r][j].y * v[r][j].y + v[r][j].z * v[r][j].z + v[r][j].w * v[r][j].w;
                    const float rstd = rsqrtf(wave_sum(s) * (1.f / DM) + EPS);
#pragma unroll
                    for (int j = 0; j < 4; ++j) {
                        float4& w = v[r][j];
                        w.x = w.x * rstd * mm[j].x + sh[j].x; w.y = w.y * rstd * mm[j].y + sh[j].y; w.z = w.z * rstd * mm[j].z + sh[j].z; w.w = w.w * rstd * mm[j].w + sh[j].w;
                        uint2 o; o.x = pk2(w.x, w.y); o.y = pk2(w.z, w.w);
                        *(uint2*)(HB + (size_t)t * DM + 256 * j + 4 * lane) = o;
                    }
                }
                float d[4][8];
#pragma unroll
                for (int j8 = 0; j8 < 8; ++j8) {
#pragma unroll
                    for (int r = 0; r < 4; ++r) d[r][j8] = 0.f;
#pragma unroll
                    for (int j = 0; j < 4; ++j) { const float4 w = *(const float4*)(lds + j8 * DM + 256 * j + 4 * lane);
#pragma unroll
                        for (int r = 0; r < 4; ++r) d[r][j8] += v[r][j].x * w.x + v[r][j].y * w.y + v[r][j].z * w.z + v[r][j].w * w.w; }
                    __builtin_amdgcn_sched_barrier(0);
                }
                const int hd = 4 * (lane >> 5) + 2 * ((lane >> 4) & 1) + ((lane >> 3) & 1); const float bfh = a.b_f[hd];
#pragma unroll
                for (int r = 0; r < 4; ++r) {
                    float e4[4], e2[2];
#pragma unroll
                    for (int k = 0; k < 4; ++k) { const bool up = (lane & 32) != 0; const float mine = up ? d[r][k + 4] : d[r][k], oth = up ? d[r][k] : d[r][k + 4]; e4[k] = mine + __shfl_xor(oth, 32); }
#pragma unroll
                    for (int k = 0; k < 2; ++k) { const bool up = (lane & 16) != 0; const float mine = up ? e4[k + 2] : e4[k], oth = up ? e4[k] : e4[k + 2]; e2[k] = mine + __shfl_xor(oth, 16); }
                    float fl; { const bool up = (lane & 8) != 0; const float mine = up ? e2[1] : e2[0], oth = up ? e2[0] : e2[1]; fl = mine + __shfl_xor(oth, 8); }
                    fl += __shfl_xor(fl, 4); fl += __shfl_xor(fl, 2); fl += __shfl_xor(fl, 1);
                    if ((lane & 7) == 0) FL[(size_t)(t0 + 4 * hf + r) * 8 + hd] = log_sigmoid(fl + bfh);
                }
            }
        }
    }
    GRID_BAR();
    REP(2) {
        PHASE_IDS();
        if (gw < NB * NH) {
            const int b = gw >> 3, h = gw & 7; float v[32]; float run = 0.f;
#pragma unroll
            for (int i = 0; i < 32; ++i) { run += FL[((size_t)b * SEQ + 32 * lane + i) * 8 + h]; v[i] = run; }
            float incl = run;
#pragma unroll
            for (int o = 1; o < 64; o <<= 1) { const float n = __shfl_up(incl, o); if (lane >= o) incl += n; }
            const float excl = incl - run;
#pragma unroll
            for (int i = 0; i < 32; ++i) {
                GT[((size_t)b * NH + h) * SEQ + 32 * lane + i] = -(excl + v[i]) * LOG2E;
            }
        }
        pg8::Gemm g{HB, WIN, NT, NPROJ, DM}; pg8::StaticOrder S; S.init(NT, NPROJ, gridDim.x, (int)blockIdx.x);
        pg8::EpiProj E{ZU};
        pg8::gemm_phase<pg8::EpiProj, pg8::StaticOrder, true, true>((PG8_LAS unsigned char*)lds_raw, g, S, E);
        const int nfull = (NT / 256) * (NPROJ / 256) % gridDim.x;
        {
            const bool tailblk = (int)blockIdx.x >= nfull;
            if (tailblk && (int)blockIdx.x - nfull < 32) {
                __syncthreads();
                for (int i = tid; i < NB * DM; i += NTHR) lds[i] = ADA[(i >> 10) * 6 * DM + 3 * DM + (i & 1023)];
                __syncthreads();
                gemv8_task(lds, a.w_query, NQ, ((int)blockIdx.x - nfull) * 64, nullptr, SQB, NQ, tid);
            }
            const int wq = ((int)blockIdx.x - (tailblk ? nfull : 0)) * NWAVE + wave; const bool sq = tailblk && wq < 32 * NWAVE;
            const int nconv = !tailblk ? nfull * NWAVE : sq ? 32 * NWAVE : (gridDim.x - nfull - 32) * NWAVE;
            const int wbase = !tailblk ? 28672 + wq : sq ? wq : 4096 + (wq - 32 * NWAVE), wend = !tailblk ? 2 * 16384 : sq ? 4096 : 28672;
            for (int it0 = wbase; it0 < wend; it0 += 4 * nconv) {
                float4 f[4][4];
#pragma unroll
                for (int q = 0; q < 4; ++q) { const int it = it0 + q * nconv; const bool isv = it >= 16384; const int r = isv ? it - 16384 : it;
                    const float* src = (isv ? a.expert_v : a.expert_u) + (size_t)r * DM + 16 * lane;
#pragma unroll
                    for (int k = 0; k < 4; ++k) f[q][k] = *(const float4*)(src + 4 * k); }
#pragma unroll
                for (int q = 0; q < 4; ++q) { const int it = it0 + q * nconv; const bool isv = it >= 16384; const int r = isv ? it - 16384 : it; const float sc = isv ? peer::V_SCALE : peer::U_SCALE;
                    const int cs = lane & 7;
                    if (!isv) {
                        if (peer::U4) {
                            unsigned w0 = 0u, w1 = 0u;
                            w0 = __builtin_amdgcn_cvt_scalef32_pk_fp4_f32(w0, f[q][0].x * sc, f[q][0].y * sc, 1.0f, 0); w0 = __builtin_amdgcn_cvt_scalef32_pk_fp4_f32(w0, f[q][0].z * sc, f[q][0].w * sc, 1.0f, 1);
                            w0 = __builtin_amdgcn_cvt_scalef32_pk_fp4_f32(w0, f[q][1].x * sc, f[q][1].y * sc, 1.0f, 2); w0 = __builtin_amdgcn_cvt_scalef32_pk_fp4_f32(w0, f[q][1].z * sc, f[q][1].w * sc, 1.0f, 3);
                            w1 = __builtin_amdgcn_cvt_scalef32_pk_fp4_f32(w1, f[q][2].x * sc, f[q][2].y * sc, 1.0f, 0); w1 = __builtin_amdgcn_cvt_scalef32_pk_fp4_f32(w1, f[q][2].z * sc, f[q][2].w * sc, 1.0f, 1);
                            w1 = __builtin_amdgcn_cvt_scalef32_pk_fp4_f32(w1, f[q][3].x * sc, f[q][3].y * sc, 1.0f, 2); w1 = __builtin_amdgcn_cvt_scalef32_pk_fp4_f32(w1, f[q][3].z * sc, f[q][3].w * sc, 1.0f, 3);
                            *(uint2*)(EU + (size_t)(lane >> 4) * peer::SLICE_BYTES + (size_t)r * 128 + 8 * (lane & 15)) = make_uint2(w0, w1);
                        } else {
                            unsigned char* dst = EU + (size_t)(lane >> 3) * peer::SLICE_BYTES + (size_t)r * 128 + 16 * ((cs >> 1) + 4 * (cs & 1));
                            uint4 o; unsigned* ow = (unsigned*)&o;
#pragma unroll
                            for (int k = 0; k < 4; ++k) { int w = __builtin_amdgcn_cvt_pk_fp8_f32(f[q][k].x * sc, f[q][k].y * sc, 0, false); w = __builtin_amdgcn_cvt_pk_fp8_f32(f[q][k].z * sc, f[q][k].w * sc, w, true); ow[k] = (unsigned)w; }
                            *(uint4*)dst = o;
                        }
                    } else if (peer::V4) {
                        const int c4 = lane & 15;
                        unsigned char* dst = EV + (size_t)(lane >> 4) * peer::SLICE_BYTES + (size_t)r * 128 + 32 * (c4 >> 2) + 2 * (c4 & 3);
                        unsigned w0 = 0u, w1 = 0u, w2 = 0u, w3 = 0u;
                        w0 = __builtin_amdgcn_cvt_scalef32_pk_fp4_f32(w0, f[q][0].x * sc, f[q][1].x * sc, 1.0f, 0); w0 = __builtin_amdgcn_cvt_scalef32_pk_fp4_f32(w0, f[q][2].x * sc, f[q][3].x * sc, 1.0f, 1);
                        w1 = __builtin_amdgcn_cvt_scalef32_pk_fp4_f32(w1, f[q][0].y * sc, f[q][1].y * sc, 1.0f, 0); w1 = __builtin_amdgcn_cvt_scalef32_pk_fp4_f32(w1, f[q][2].y * sc, f[q][3].y * sc, 1.0f, 1);
                        w2 = __builtin_amdgcn_cvt_scalef32_pk_fp4_f32(w2, f[q][0].z * sc, f[q][1].z * sc, 1.0f, 0); w2 = __builtin_amdgcn_cvt_scalef32_pk_fp4_f32(w2, f[q][2].z * sc, f[q][3].z * sc, 1.0f, 1);
                        w3 = __builtin_amdgcn_cvt_scalef32_pk_fp4_f32(w3, f[q][0].w * sc, f[q][1].w * sc, 1.0f, 0); w3 = __builtin_amdgcn_cvt_scalef32_pk_fp4_f32(w3, f[q][2].w * sc, f[q][3].w * sc, 1.0f, 1);
                        *(unsigned short*)(dst) = (unsigned short)w0; *(unsigned short*)(dst + 8) = (unsigned short)w1; *(unsigned short*)(dst + 16) = (unsigned short)w2; *(unsigned short*)(dst + 24) = (unsigned short)w3;
                    } else {
                        unsigned char* dst = EV + (size_t)(lane >> 3) * peer::SLICE_BYTES + (size_t)r * 128 + 64 * (cs >> 2) + 4 * (cs & 3);
                        int w0 = __builtin_amdgcn_cvt_pk_fp8_f32(f[q][0].x * sc, f[q][1].x * sc, 0, false); w0 = __builtin_amdgcn_cvt_pk_fp8_f32(f[q][2].x * sc, f[q][3].x * sc, w0, true);
                        int w1 = __builtin_amdgcn_cvt_pk_fp8_f32(f[q][0].y * sc, f[q][1].y * sc, 0, false); w1 = __builtin_amdgcn_cvt_pk_fp8_f32(f[q][2].y * sc, f[q][3].y * sc, w1, true);
                        int w2 = __builtin_amdgcn_cvt_pk_fp8_f32(f[q][0].z * sc, f[q][1].z * sc, 0, false); w2 = __builtin_amdgcn_cvt_pk_fp8_f32(f[q][2].z * sc, f[q][3].z * sc, w2, true);
                        int w3 = __builtin_amdgcn_cvt_pk_fp8_f32(f[q][0].w * sc, f[q][1].w * sc, 0, false); w3 = __builtin_amdgcn_cvt_pk_fp8_f32(f[q][2].w * sc, f[q][3].w * sc, w3, true);
                        *(int*)(dst) = w0; *(int*)(dst + 16) = w1; *(int*)(dst + 32) = w2; *(int*)(dst + 48) = w3;
                    } }
            }
        }
    }
    GRID_BAR();
    REP(3) {
        PHASE_IDS();
        char* shm = (char*)lds_raw;
        for (int pt = blockIdx.x; pt < NB * (SEQ / CHUNK) * NH / 2; pt += gridDim.x)
            mixer::sgu_pair(2 * pt, ZU, ZV, SGWB, a.sg_ln_g, a.sg_ln_b, a.sg_b, a.out_g_sg, HB, shm);
        __syncthreads();
        const int G = gridDim.x, vcu = (G % 8 == 0) ? (blockIdx.x % 8) * (G / 8) + blockIdx.x / 8 : blockIdx.x;
        for (int pr = vcu; pr < NB * NH * 4; pr += G) {
            const int bh = pr >> 2, s = pr & 3;
            attn2::attn_unit<8>(bh >> 3, bh & 7, 7 - s, Q, K, V, GT, a.out_g_fox, HB, shm);
            attn2::attn_unit<8>(bh >> 3, bh & 7, s, Q, K, V, GT, a.out_g_fox, HB, shm);
        }
    }
    GRID_BAR();
    REP(4) {
        PHASE_IDS();
        pg8::Gemm g{HB, WOUT, NT, DM, DM}; pg8::StaticOrder S; S.init(NT, DM, gridDim.x, (int)blockIdx.x);
        pg8::EpiOut E{a.x, ADA, a.norm2_g, a.out, XG, SSQ};
        pg8::gemm_phase<pg8::EpiOut, pg8::StaticOrder, false, true>((PG8_LAS unsigned char*)lds_raw, g, S, E);
    }
    GRID_BAR();
    REP(5) {
        PHASE_IDS();
        pg8::Gemm g{XG, WQ, NT, NQ, DM}; QueryOrder S; S.c = (int)blockIdx.x;
        pg8::EpiQuery E{SSQ, SQB, QV};
        pg8::gemm_phase<pg8::EpiQuery, QueryOrder, true, true>((PG8_LAS unsigned char*)lds_raw, g, S, E);
        asm volatile("s_waitcnt vmcnt(0)" ::: "memory"); __syncthreads();
        pg8::Unit u;
        for (int r7 = 0; r7 < ((PROBE_REP) == 7 ? 2 : 1); ++r7)
        for (int i = 0; S.next(i, u); ++i) peer::topk256(u.pn, u.pm * 256, QV, SUBK, IDX, GATE, (char*)lds_raw, i == 0);
    }
    GRID_BAR();
    REP(6) {
        PHASE_IDS();
        char* shm = (char*)lds_raw;
        if (blockIdx.x < NT / 64) {
            __syncthreads();
            peer::gather_mx<peer::U4, peer::V4>((int)blockIdx.x * 64 + wave * 8, XG, SSQ, ADA, EU, EV, IDX, GATE, a.final_g, a.norm2_g, a.out);
        }
    }
    {
        volatile LAS unsigned* lastf = (volatile LAS unsigned*)((LAS unsigned char*)lds_raw + MISC_OFF) + 12;
        __syncthreads();
        if (tid == 0) *lastf = (xb_add(&g_bar[XCD_BAR_WORDS + 32], 1u) == gridDim.x - 1) ? 1u : 0u;
        __syncthreads();
        if (*lastf) for (int i = tid; i < XCD_BAR_WORDS + 64; i += NTHR) __hip_atomic_store(&g_bar[i], 0u, __ATOMIC_RELAXED, __HIP_MEMORY_SCOPE_AGENT);
    }
    if ((TS_SEL) > -2) {
        GRID_BAR();
        if (blockIdx.x == 0 && tid == 0) a.out[0] = ((TS_SEL) < 0) ? 200.f : 2.f * 0.01f * (float)(ts_[(TS_SEL) + 1] - ts_[0]);
    }
}

extern "C" void kernel_launch(void* const* d_in, const int* in_sizes, int n_in, void* d_out, int out_size, void* d_ws, size_t ws_size, hipStream_t stream) {
    if (n_in != 20 || ws_size < WS_END) { fprintf(stderr, "kernel_launch: unexpected n_in %d or ws_size %zu\n", n_in, ws_size); return; }
    Args a{};
    const float** p = (const float**)&a;
    for (int i = 0; i < 20; ++i) p[i] = (const float*)d_in[i];
    a.out = (float*)d_out; a.ws = (unsigned char*)d_ws;
    static int grid = 0;
    if (grid == 0) {
        int dev = 0, cus = 0, per_cu = 0;
        (void)hipGetDevice(&dev); (void)hipDeviceGetAttribute(&cus, hipDeviceAttributeMultiprocessorCount, dev);
        (void)hipFuncSetAttribute((const void*)fwd_kernel, hipFuncAttributeMaxDynamicSharedMemorySize, LDS_BYTES);
        (void)hipOccupancyMaxActiveBlocksPerMultiprocessor(&per_cu, (const void*)fwd_kernel, NTHR, LDS_BYTES);
        (void)hipGetLastError();
        if (per_cu < 1 || cus != 256) { fprintf(stderr, "kernel_launch: occupancy query says %d blocks/CU, %d CUs (built for one block on each of 256 CUs)\n", per_cu, cus); grid = -1; }
        else grid = cus;
    }
    if (grid < 0) return;
    a.ph_lo = 0; a.ph_hi = 10;
    hipLaunchKernelGGL(fwd_kernel, dim3(grid), dim3(NTHR), LDS_BYTES, stream, a);
}
```
